# Optimizing an MI355X kernel written in HIP

```python
import math
import jax, jax.numpy as jnp
from jax import lax
import numpy as np

D_MODEL = 1024
BATCH = 16
SEQ = 2048
DEPTH = 2

EPS = 1e-6
D_FF = 4 * D_MODEL
CONV_CH = D_MODEL // 2
CONV_WIDTH = 31
ATTN_HEAD_DIM = 64
ATTN_HEADS = (D_MODEL // 2) // ATTN_HEAD_DIM
ATTN_WIDTH = ATTN_HEADS * ATTN_HEAD_DIM
MOBA_BLOCK = 256
MOBA_TOP_K = 3
MOBA_Q_CHUNK = 32
AB_IN_WIDTH = 2 * CONV_CH + 3 * ATTN_WIDTH
AB_OUT_WIDTH = CONV_CH + ATTN_WIDTH
LRU_WIDTH = D_MODEL
LRU_HEADS = 8
LRU_BLOCK = LRU_WIDTH // LRU_HEADS
LRU_CONV_WIDTH = 4
LRU_C = 8.0
N_EVEN = (DEPTH + 1) // 2
N_ODD = DEPTH // 2

kernel_name = "hybrid_conformer_moba_rglru_block"


def rmsnorm(x, g):
    xf = x.astype(jnp.float32)
    y = xf * lax.rsqrt(jnp.mean(xf * xf, axis=-1, keepdims=True) + EPS)
    return (y * g.astype(jnp.float32)).astype(x.dtype)


def layernorm(x, g, b):
    xf = x.astype(jnp.float32)
    mu = jnp.mean(xf, axis=-1, keepdims=True)
    var = jnp.mean(jnp.square(xf - mu), axis=-1, keepdims=True)
    y = (xf - mu) * lax.rsqrt(var + EPS)
    return (y * g.astype(jnp.float32) + b.astype(jnp.float32)).astype(x.dtype)


def causal_depthwise_conv(x, w):
    width, ch = w.shape
    return lax.conv_general_dilated(
        x, w[:, None, :].astype(x.dtype), window_strides=(1,),
        padding=[(width - 1, 0)], dimension_numbers=("NWC", "WIO", "NWC"),
        feature_group_count=ch)


def alibi_slopes(n_heads):
    return 2.0 ** (-8.0 * jnp.arange(1, n_heads + 1, dtype=jnp.float32) / n_heads)


def conformer_conv(u_val, u_gate, conv_w, ln_g, ln_b):
    z = u_val * jax.nn.sigmoid(u_gate)
    z = causal_depthwise_conv(z, conv_w)
    z = layernorm(z, ln_g, ln_b)
    return jax.nn.silu(z)


def moba_attention(q, k, v):
    b, s, h, dh = q.shape
    nb = -(-s // MOBA_BLOCK)
    sp = nb * MOBA_BLOCK
    pad = sp - s
    q, k, v = [jnp.pad(t.transpose(0, 2, 1, 3), ((0, 0), (0, 0), (0, pad), (0, 0)))
               for t in (q, k, v)]
    slopes = alibi_slopes(h)[None, :, None, None]
    scale = dh ** -0.5
    n_past = min(MOBA_TOP_K, nb - 1)
    offs = jnp.arange(MOBA_BLOCK)
    kb = k.reshape(b, h, nb, MOBA_BLOCK, dh)
    vb = v.reshape(b, h, nb, MOBA_BLOCK, dh)
    bi = jnp.arange(b)[:, None, None, None]
    hi = jnp.arange(h)[None, :, None, None]

    if n_past > 0:
        kbar = jnp.mean(kb.astype(jnp.float32), axis=3)
        gate = jnp.einsum("bhsd,bhnd->bhsn", q.astype(jnp.float32), kbar)
        qblk = jnp.arange(sp) // MOBA_BLOCK
        past = jnp.arange(nb)[None, :] < qblk[:, None]
        gate = jnp.where(past, gate, -jnp.inf)
        top_val, top_idx = lax.top_k(gate, n_past)
        top_ok = jnp.isfinite(top_val)

    def chunk(c):
        start = c * MOBA_Q_CHUNK
        t = start + jnp.arange(MOBA_Q_CHUNK)
        qc = lax.dynamic_slice_in_dim(q, start, MOBA_Q_CHUNK, axis=2)
        own0 = (start // MOBA_BLOCK) * MOBA_BLOCK
        k_own = lax.dynamic_slice_in_dim(k, own0, MOBA_BLOCK, axis=2)
        v_own = lax.dynamic_slice_in_dim(v, own0, MOBA_BLOCK, axis=2)
        dist_own = (t[:, None] - (own0 + offs)[None, :]).astype(jnp.float32)
        l_own = (jnp.einsum("bhqd,bhkd->bhqk", qc, k_own).astype(jnp.float32) * scale
                 - slopes * dist_own)
        l_own = jnp.where(dist_own >= 0, l_own, -jnp.inf)
        if n_past > 0:
            idx = lax.dynamic_slice_in_dim(top_idx, start, MOBA_Q_CHUNK, axis=2)
            ok = lax.dynamic_slice_in_dim(top_ok, start, MOBA_Q_CHUNK, axis=2)
            k_sel = kb[bi, hi, idx]
            v_sel = vb[bi, hi, idx]
            pos = idx[..., None] * MOBA_BLOCK + offs
            dist = (t[None, None, :, None, None] - pos).astype(jnp.float32)
            l_sel = (jnp.einsum("bhqd,bhqnkd->bhqnk", qc, k_sel).astype(jnp.float32) * scale
                     - slopes[..., None] * dist)
            l_sel = jnp.where(ok[..., None], l_sel, -jnp.inf)
            n_sel = n_past * MOBA_BLOCK
            logits = jnp.concatenate(
                [l_sel.reshape(b, h, MOBA_Q_CHUNK, n_sel), l_own], axis=-1)
            p = jax.nn.softmax(logits, axis=-1).astype(v.dtype)
            p_sel = p[..., :n_sel].reshape(b, h, MOBA_Q_CHUNK, n_past, MOBA_BLOCK)
            p_own = p[..., n_sel:]
            o = (jnp.einsum("bhqnk,bhqnkd->bhqd", p_sel, v_sel)
                 + jnp.einsum("bhqk,bhkd->bhqd", p_own, v_own))
        else:
            p_own = jax.nn.softmax(l_own, axis=-1).astype(v.dtype)
            o = jnp.einsum("bhqk,bhkd->bhqd", p_own, v_own)
        return o

    out = lax.map(chunk, jnp.arange(sp // MOBA_Q_CHUNK))
    out = out.transpose(1, 2, 0, 3, 4).reshape(b, h, sp, dh)[:, :, :s]
    return out.transpose(0, 2, 1, 3)


def rg_lru(x, w_r, b_r, w_i, b_i, lam):
    b, s, w = x.shape
    xb = x.reshape(b, s, LRU_HEADS, LRU_BLOCK)
    r = jax.nn.sigmoid(jnp.einsum("bshi,hij->bshj", xb, w_r) + b_r).reshape(b, s, w)
    i = jax.nn.sigmoid(jnp.einsum("bshi,hij->bshj", xb, w_i) + b_i).reshape(b, s, w)
    log_a = -LRU_C * r.astype(jnp.float32) * jax.nn.softplus(-lam.astype(jnp.float32))
    a = jnp.exp(log_a)
    mult = jnp.sqrt(-jnp.expm1(2.0 * log_a))
    bx = mult * (i * x).astype(jnp.float32)

    def combine(e1, e2):
        a1, b1 = e1
        a2, b2 = e2
        return a1 * a2, a2 * b1 + b2

    _, hseq = lax.associative_scan(combine, (a, bx), axis=1)
    return hseq.astype(x.dtype)


def mixer_ab(h, w_in, conv_w, ln_g, ln_b, w_out):
    b, s, _ = h.shape
    u = h @ w_in
    u_val, u_gate, q, k, v = jnp.split(
        u, np.cumsum([CONV_CH, CONV_CH, ATTN_WIDTH, ATTN_WIDTH]).tolist(), axis=-1)
    ya = conformer_conv(u_val, u_gate, conv_w, ln_g, ln_b)
    shp = (b, s, ATTN_HEADS, ATTN_HEAD_DIM)
    yb = moba_attention(q.reshape(shp), k.reshape(shp), v.reshape(shp)).reshape(b, s, ATTN_WIDTH)
    return jnp.concatenate([ya, yb], axis=-1) @ w_out


def mixer_c(h, w_in, conv_w, conv_b, w_r, b_r, w_i, b_i, lam, w_out):
    u = h @ w_in
    gate, xr = jnp.split(u, 2, axis=-1)
    xr = causal_depthwise_conv(xr, conv_w) + conv_b
    y = rg_lru(xr, w_r, b_r, w_i, b_i, lam) * jax.nn.gelu(gate)
    return y @ w_out


def sq_relu_mlp(h, w_up, w_down):
    return jnp.square(jax.nn.relu(h @ w_up)) @ w_down


def setup_inputs(seed: int = 0) -> dict:
    key = jax.random.key(seed)
    ks = iter(jax.random.split(key, 32))
    f32 = jnp.float32

    def nrm(shape, fan_in):
        return jax.random.normal(next(ks), shape, f32) * (fan_in ** -0.5)

    def gain(shape):
        return 1.0 + 0.02 * jax.random.normal(next(ks), shape, f32)

    def bias(shape):
        return 0.01 * jax.random.normal(next(ks), shape, f32)

    x = jax.random.normal(next(ks), (BATCH, SEQ, D_MODEL), f32)
    a_c = jax.random.uniform(next(ks), (N_ODD, LRU_WIDTH), f32, 0.9, 0.999)
    a_base = a_c ** (1.0 / LRU_C)
    lam = jnp.log(a_base) - jnp.log1p(-a_base)
    return {
        "x": x,
        "mix_norm": gain((DEPTH, D_MODEL)),
        "mlp_norm": gain((DEPTH, D_MODEL)),
        "w_up": nrm((DEPTH, D_MODEL, D_FF), D_MODEL),
        "w_down": nrm((DEPTH, D_FF, D_MODEL), D_FF),
        "ab_w_in": nrm((N_EVEN, D_MODEL, AB_IN_WIDTH), D_MODEL),
        "ab_conv_w": nrm((N_EVEN, CONV_WIDTH, CONV_CH), CONV_WIDTH),
        "ab_ln_g": gain((N_EVEN, CONV_CH)),
        "ab_ln_b": bias((N_EVEN, CONV_CH)),
        "ab_w_out": nrm((N_EVEN, AB_OUT_WIDTH, D_MODEL), AB_OUT_WIDTH),
        "c_w_in": nrm((N_ODD, D_MODEL, 2 * LRU_WIDTH), D_MODEL),
        "c_conv_w": nrm((N_ODD, LRU_CONV_WIDTH, LRU_WIDTH), LRU_CONV_WIDTH),
        "c_conv_b": bias((N_ODD, LRU_WIDTH)),
        "c_w_r": nrm((N_ODD, LRU_HEADS, LRU_BLOCK, LRU_BLOCK), LRU_BLOCK),
        "c_b_r": bias((N_ODD, LRU_HEADS, LRU_BLOCK)),
        "c_w_i": nrm((N_ODD, LRU_HEADS, LRU_BLOCK, LRU_BLOCK), LRU_BLOCK),
        "c_b_i": bias((N_ODD, LRU_HEADS, LRU_BLOCK)),
        "c_lambda": lam,
        "c_w_out": nrm((N_ODD, LRU_WIDTH, D_MODEL), LRU_WIDTH),
        "final_norm": gain((D_MODEL,)),
    }


def reference(x, mix_norm, mlp_norm, w_up, w_down, ab_w_in, ab_conv_w, ab_ln_g, ab_ln_b,
              ab_w_out, c_w_in, c_conv_w, c_conv_b, c_w_r, c_b_r, c_w_i, c_b_i, c_lambda,
              c_w_out, final_norm):
    for layer in range(DEPTH):
        j = layer // 2
        h = rmsnorm(x, mix_norm[layer])
        if layer % 2 == 0:
            y = mixer_ab(h, ab_w_in[j], ab_conv_w[j], ab_ln_g[j], ab_ln_b[j], ab_w_out[j])
        else:
            y = mixer_c(h, c_w_in[j], c_conv_w[j], c_conv_b[j], c_w_r[j], c_b_r[j],
                        c_w_i[j], c_b_i[j], c_lambda[j], c_w_out[j])
        x = x + y
        x = x + sq_relu_mlp(rmsnorm(x, mlp_norm[layer]), w_up[layer], w_down[layer])
    return rmsnorm(x, final_norm)
```

```cpp
#include <hip/hip_runtime.h>
#include <hip/hip_bf16.h>
#include <cstdio>
#include <cstdint>
#include <cmath>
namespace pg8 {
#define PG8_LAS __attribute__((address_space(3)))
typedef unsigned short bf16_t;
typedef short bf16x8 __attribute__((ext_vector_type(8)));
typedef float f32x4 __attribute__((ext_vector_type(4)));
typedef unsigned u32x4 __attribute__((ext_vector_type(4)));
constexpr int BM = 256, BK = 64, HALF = 128, HTB = HALF * BK * 2  , STAGE_BYTES = 8 * HTB, NXCD = 8, WGM = 8;

__host__ __device__ __forceinline__ int lds_byte(int r, int c) { const int st = (r >> 4) * 2 + (c >> 5), rr = r & 15, cc = c & 31, ob = rr * 64 + cc * 2; return st * 1024 + (ob ^ (((ob >> 9) & 1) << 5)); }
__host__ __device__ __forceinline__ void stage_rc(int b, int& R, int& C) { const int st = b / 1024, sb = b % 1024, swz = sb ^ (((sb >> 9) & 1) << 5); R = (st >> 1) * 16 + swz / 64; C = (st & 1) * 32 + (swz % 64) / 2; }
__host__ __device__ __forceinline__ int perm32(int rho) { const int n = rho >> 4, i = rho & 15; return 8 * (i >> 2) + 4 * n + (i & 3); }

struct Unit { int pm, pn; };
struct Gemm { const bf16_t* A; const bf16_t* Bt; int M, N, K; };

struct StaticOrder {
    int nM, nN, nwg, G, c;
    __host__ __device__ void init(int M, int N, int G_, int c_) { nM = M / BM; nN = N / BM; nwg = nM * nN; G = G_; c = c_; }
    __host__ __device__ bool next(int i, Unit& u) const {
        const long L = (long)i * G + c; if (L >= nwg) return false;
        int wgid = (int)L; { const int q = nwg / NXCD, r = nwg % NXCD, xcd = wgid % NXCD, off = wgid / NXCD; wgid = (xcd < r ? xcd * (q + 1) : r * (q + 1) + (xcd - r) * q) + off; }
        const int nig = WGM * nN, gid = wgid / nig, fm = gid * WGM, gsz = (nM - fm) < WGM ? (nM - fm) : WGM;
        u.pm = fm + ((wgid % nig) % gsz); u.pn = (wgid % nig) / gsz; return true;
    }
    __device__ __forceinline__ void a_ready(const Unit&) const {}
    __device__ __forceinline__ void done(const Unit&) const {}
};
__device__ __forceinline__ unsigned cvt_pk_bf16(float lo, float hi) { unsigned r; asm volatile("v_cvt_pk_bf16_f32 %0, %1, %2" : "=v"(r) : "v"(lo), "v"(hi)); return r; }
typedef float f32x2 __attribute__((ext_vector_type(2)));
typedef unsigned u32x2 __attribute__((ext_vector_type(2)));
__device__ __forceinline__ float row_rstd(const float* ss, int row) {
    const f32x4* p = (const f32x4*)(ss + (size_t)row * 16);
    const f32x4 a = p[0], b = p[1], c = p[2], d = p[3];
    const float s = (((a[0] + a[1]) + (a[2] + a[3])) + ((b[0] + b[1]) + (b[2] + b[3]))) + (((c[0] + c[1]) + (c[2] + c[3])) + ((d[0] + d[1]) + (d[2] + d[3])));
    return 1.0f / sqrtf(s * (1.0f / 1024.0f) + 1e-6f);
}
__device__ __forceinline__ void row_scales(float (&rs)[2][4], const float* ss, int row0, float mul) {
#pragma unroll
    for (int ai = 0; ai < 2; ++ai)
#pragma unroll
        for (int m = 0; m < 4; ++m) { rs[ai][m] = row_rstd(ss, row0 + ai * HALF + m * 16) * mul; asm volatile("" : "+v"(rs[ai][m]) :: "memory"); __builtin_amdgcn_sched_barrier(0); }
}
__device__ __forceinline__ float fsigmoid(float x) { return __builtin_amdgcn_rcpf(1.0f + __builtin_amdgcn_exp2f(-1.4426950408889634f * x)); }
__device__ __forceinline__ u32x4 pack8(const f32x4& v0, const f32x4& v1) { u32x4 w; w.x = cvt_pk_bf16(v0[0], v0[1]); w.y = cvt_pk_bf16(v0[2], v0[3]); w.z = cvt_pk_bf16(v1[0], v1[1]); w.w = cvt_pk_bf16(v1[2], v1[3]); return w; }

struct EpiInAB {
    static constexpr bool PERM = true, AFTER_DRAIN = false;
    bf16_t* Z; bf16_t* QKV; const float* ss; float qscale;
    __device__ __forceinline__ void operator()(const f32x4 (&acc)[2][2][4][2], const Unit& u, int wr, int wc, int fr, int fq) const {
        const int row0 = u.pm * BM + wr * 64 + fr, cw = wc * 32 + 8 * fq;
        float rsv[2][4]; row_scales(rsv, ss, row0, (u.pn == 4 || u.pn == 5) ? qscale : 1.0f);
        if (u.pn < 4) {
#pragma unroll
            for (int ai = 0; ai < 2; ++ai)
#pragma unroll
                for (int m = 0; m < 4; ++m) { const int row = row0 + ai * HALF + m * 16; const float rs = rsv[ai][m];
                    f32x4 z0, z1;
#pragma unroll
                    for (int j = 0; j < 4; ++j) { z0[j] = (acc[ai][0][m][0][j] * rs) * fsigmoid(acc[ai][1][m][0][j] * rs); z1[j] = (acc[ai][0][m][1][j] * rs) * fsigmoid(acc[ai][1][m][1][j] * rs); }
                    *(u32x4*)(Z + (size_t)row * 512 + u.pn * 128 + cw) = pack8(z0, z1); __builtin_amdgcn_sched_barrier(0); }
        } else {
            const int t = (u.pn - 4) >> 1; bf16_t* dst = QKV + (size_t)t * ((size_t)32768 * 512);
            const int cb = ((u.pn - 4) & 1) * 256 + cw;
#pragma unroll
            for (int ai = 0; ai < 2; ++ai)
#pragma unroll
                for (int m = 0; m < 4; ++m) { const int row = row0 + ai * HALF + m * 16; const float rs = rsv[ai][m];
#pragma unroll
                    for (int bj = 0; bj < 2; ++bj) { const f32x4 v0 = acc[ai][bj][m][0] * rs, v1 = acc[ai][bj][m][1] * rs;
                        *(u32x4*)(dst + (size_t)row * 512 + cb + bj * HALF) = pack8(v0, v1); } __builtin_amdgcn_sched_barrier(0); }
        }
    }
};
struct EpiUp {
    static constexpr bool PERM = true, AFTER_DRAIN = false;
    bf16_t* H; const float* ss;
    __device__ __forceinline__ void operator()(const f32x4 (&acc)[2][2][4][2], const Unit& u, int wr, int wc, int fr, int fq) const {
        const int row0 = u.pm * BM + wr * 64 + fr, col0 = u.pn * BM + wc * 32 + 8 * fq;
        float rsv[2][4]; row_scales(rsv, ss, row0, 1.0f);
#pragma unroll
        for (int ai = 0; ai < 2; ++ai)
#pragma unroll
            for (int m = 0; m < 4; ++m) { const int row = row0 + ai * HALF + m * 16; const float rs = rsv[ai][m];
#pragma unroll
                for (int bj = 0; bj < 2; ++bj) { f32x4 v0 = acc[ai][bj][m][0] * rs, v1 = acc[ai][bj][m][1] * rs;
#pragma unroll
                    for (int j = 0; j < 4; ++j) { const float a = v0[j] > 0.f ? v0[j] : 0.f, b = v1[j] > 0.f ? v1[j] : 0.f; v0[j] = a * a; v1[j] = b * b; }
                    *(u32x4*)(H + (size_t)row * 4096 + col0 + bj * HALF) = pack8(v0, v1); } __builtin_amdgcn_sched_barrier(0); }
    }
};
struct EpiInC {
    static constexpr bool PERM = true, AFTER_DRAIN = false;
    bf16_t* GG; bf16_t* XR; const float* ss;
    __device__ __forceinline__ void operator()(const f32x4 (&acc)[2][2][4][2], const Unit& u, int wr, int wc, int fr, int fq) const {
        const int row0 = u.pm * BM + wr * 64 + fr, col0 = (u.pn & 3) * BM + wc * 32 + 8 * fq; const bool isg = u.pn < 4; bf16_t* dst = isg ? GG : XR;
        float rsv[2][4]; row_scales(rsv, ss, row0, 1.0f);
#pragma unroll
        for (int ai = 0; ai < 2; ++ai)
#pragma unroll
            for (int m = 0; m < 4; ++m) { const int row = row0 + ai * HALF + m * 16; const float rs = rsv[ai][m];
#pragma unroll
                for (int bj = 0; bj < 2; ++bj) { f32x4 v0 = acc[ai][bj][m][0] * rs, v1 = acc[ai][bj][m][1] * rs;
                    if (isg) {
#pragma unroll
                        for (int j = 0; j < 4; ++j) {
                            { const float x = v0[j], z = x + 0.044715f * x * x * x; v0[j] = x * __builtin_amdgcn_rcpf(1.0f + __builtin_amdgcn_exp2f(-2.3022081983f * z)); }
                            { const float x = v1[j], z = x + 0.044715f * x * x * x; v1[j] = x * __builtin_amdgcn_rcpf(1.0f + __builtin_amdgcn_exp2f(-2.3022081983f * z)); } } }
                    *(u32x4*)(dst + (size_t)row * 1024 + col0 + bj * HALF) = pack8(v0, v1); } __builtin_amdgcn_sched_barrier(0); }
    }
};
struct EpiRes {
    static constexpr bool PERM = false, AFTER_DRAIN = false;
    const float* base; float* out; bf16_t* xn; const float* g; float* ssout;
    __device__ __forceinline__ void operator()(const f32x4 (&acc)[2][2][4][2], const Unit& u, int wr, int wc, int fr, int fq) const {
        const int col0 = u.pn * BM + wc * 32 + 4 * fq;
        f32x4 gv[2][2];
#pragma unroll
        for (int bj = 0; bj < 2; ++bj)
#pragma unroll
            for (int n = 0; n < 2; ++n) gv[bj][n] = xn ? *(const f32x4*)(g + col0 + bj * HALF + n * 16) : (f32x4){0.f, 0.f, 0.f, 0.f};
#pragma unroll
        for (int ai = 0; ai < 2; ++ai)
#pragma unroll
            for (int m = 0; m < 4; ++m) { const int row = u.pm * BM + ai * HALF + wr * 64 + m * 16 + fr; const size_t off = (size_t)row * 1024 + col0; float sq = 0.f;
#pragma unroll
                for (int bj = 0; bj < 2; ++bj)
#pragma unroll
                    for (int n = 0; n < 2; ++n) { const f32x4 x = *(const f32x4*)(base + off + bj * HALF + n * 16) + acc[ai][bj][m][n];
                        *(f32x4*)(out + off + bj * HALF + n * 16) = x; sq += (x[0] * x[0] + x[1] * x[1]) + (x[2] * x[2] + x[3] * x[3]);
                        if (xn) { const f32x4 o = x * gv[bj][n]; u32x2 w; w.x = cvt_pk_bf16(o[0], o[1]); w.y = cvt_pk_bf16(o[2], o[3]); *(u32x2*)(xn + off + bj * HALF + n * 16) = w; } }
                sq += __shfl_xor(sq, 16); sq += __shfl_xor(sq, 32);
                if (fq == 0) ssout[(size_t)row * 16 + u.pn * 4 + wc] = sq;
                if (m & 1) asm volatile("" ::: "memory"); }
    }
};

template <class Epi, class Sched, bool ALIGN_EPI = false, bool SP2 = false>
__device__ __forceinline__ void gemm_phase(PG8_LAS unsigned char* lds, const Gemm g, const Sched& S, const Epi& E, const int wid) {
    const int lane = (int)__builtin_amdgcn_mbcnt_hi(~0u, __builtin_amdgcn_mbcnt_lo(~0u, 0u)), tid = wid * 64 + lane, wr = wid >> 2, wc = wid & 3, fr = lane & 15, fq = lane >> 4;
    const int K = g.K, nt = K / BK;
    unsigned voffA[2], voffB[2];
#pragma unroll
    for (int i = 0; i < 2; ++i) { int R, C; stage_rc(tid * 16 + i * 8192, R, C); const int Rb = Epi::PERM ? ((R & ~31) + perm32(R & 31)) : R;
        voffA[i] = (unsigned)(R * K + C) * 2u; voffB[i] = (unsigned)(Rb * K + C) * 2u; }
    const size_t kstep = (size_t)(BK * 2);
    const size_t hstep = (size_t)HALF * K * 2;
    const size_t tstep = 2 * hstep;
    const unsigned ldsw = (unsigned)wid * 1024u;
    const int aoff = lds_byte(wr * 64 + fr, fq * 8), boff = lds_byte(wc * 32 + fr, fq * 8);
#define PG8_SA(b, h) (((b) * 2 + (h)) * HTB)
#define PG8_SB(b, h) ((4 + (b) * 2 + (h)) * HTB)
#define PG8_STAGE(bufoff, gbase, voff) do { _Pragma("unroll") for (int _i = 0; _i < 2; ++_i) \
        __builtin_amdgcn_global_load_lds((const unsigned*)((const char*)(gbase) + (voff)[_i]), (PG8_LAS unsigned*)(lds + (bufoff) + ldsw + _i * 8192), 16, 0, 0); } while (0)
#define PG8_LDA(dst, b, h) do { _Pragma("unroll") for (int m = 0; m < 4; ++m) _Pragma("unroll") for (int k = 0; k < 2; ++k) dst[m][k] = *(const PG8_LAS bf16x8*)(lds + PG8_SA(b, h) + aoff + m * 2048 + k * 1024); } while (0)
#define PG8_LDB(dst, b, h) do { _Pragma("unroll") for (int n = 0; n < 2; ++n) _Pragma("unroll") for (int k = 0; k < 2; ++k) dst[n][k] = *(const PG8_LAS bf16x8*)(lds + PG8_SB(b, h) + boff + n * 2048 + k * 1024); } while (0)
#define PG8_MMA(ai, bj, At, Bt) do { __builtin_amdgcn_s_setprio(1); _Pragma("unroll") for (int m = 0; m < 4; ++m) _Pragma("unroll") for (int n = 0; n < 2; ++n) _Pragma("unroll") for (int k = 0; k < 2; ++k) \
        acc[ai][bj][m][n] = __builtin_amdgcn_mfma_f32_16x16x32_bf16(Bt[n][k], At[m][k], acc[ai][bj][m][n], 0, 0, 0); __builtin_amdgcn_s_setprio(0); } while (0)
#define PG8_WAIT_V(n) asm volatile("s_waitcnt vmcnt(" #n ")" ::: "memory")
#define PG8_WAIT_L(n) asm volatile("s_waitcnt lgkmcnt(" #n ")" ::: "memory")
#define PG8_BAR __builtin_amdgcn_s_barrier()
#define PG8_SCHED __builtin_amdgcn_sched_barrier(0)
    Unit cur, nxt; int ui = 0;
    if (!S.next(0, cur)) return;
    f32x4 acc[2][2][4][2];
#pragma unroll
    for (int a = 0; a < 2; ++a)
#pragma unroll
        for (int b = 0; b < 2; ++b)
#pragma unroll
            for (int m = 0; m < 4; ++m)
#pragma unroll
                for (int n = 0; n < 2; ++n) acc[a][b][m][n] = (f32x4){0.f, 0.f, 0.f, 0.f};
    bf16x8 At[4][2], B0[2][2], B1[2][2];
    const char* cA = (const char*)g.A + (size_t)cur.pm * tstep; const char* cB = (const char*)g.Bt + (size_t)cur.pn * tstep;
    S.a_ready(cur);
    if constexpr (SP2) {
        PG8_STAGE(PG8_SB(0, 0), cB, voffB); PG8_STAGE(PG8_SB(0, 1), cB + hstep, voffB); PG8_STAGE(PG8_SA(0, 0), cA, voffA); PG8_STAGE(PG8_SA(0, 1), cA + hstep, voffA);
        if (wr == 1) PG8_BAR;
        PG8_WAIT_V(2); PG8_BAR;
        PG8_STAGE(PG8_SB(1, 0), cB + kstep, voffB); PG8_STAGE(PG8_SA(1, 0), cA + kstep, voffA); PG8_STAGE(PG8_SB(1, 1), cB + hstep + kstep, voffB);
        PG8_WAIT_V(6); PG8_BAR;
    } else {
        PG8_STAGE(PG8_SB(0, 0), cB, voffB); PG8_STAGE(PG8_SA(0, 0), cA, voffA); PG8_STAGE(PG8_SB(0, 1), cB + hstep, voffB); PG8_STAGE(PG8_SA(0, 1), cA + hstep, voffA);
        if (wr == 1) PG8_BAR;
        PG8_WAIT_V(4); PG8_BAR;
        PG8_STAGE(PG8_SB(1, 0), cB + kstep, voffB); PG8_STAGE(PG8_SA(1, 0), cA + kstep, voffA); PG8_STAGE(PG8_SB(1, 1), cB + hstep + kstep, voffB);
        PG8_WAIT_V(6); PG8_BAR;
    }
    for (;;) {
        const bool has_next = S.next(ui + 1, nxt);
        const char* nA = has_next ? (const char*)g.A + (size_t)nxt.pm * tstep : cA; const char* nB = has_next ? (const char*)g.Bt + (size_t)nxt.pn * tstep : cB;
        for (int t = 0; t < nt; t += 2) {
            const bool last = (t == nt - 2);
            const char* a1 = cA + (size_t)(t + 1) * kstep;
            const char* a2 = last ? nA : cA + (size_t)(t + 2) * kstep; const char* b2 = last ? nB : cB + (size_t)(t + 2) * kstep;
            const char* a3 = a2 + kstep; const char* b3 = b2 + kstep;
            if (last && has_next) S.a_ready(nxt);
            if constexpr (SP2) {
            PG8_LDB(B0, 0, 0); PG8_LDB(B1, 0, 1); PG8_SCHED; PG8_LDA(At, 0, 0); PG8_STAGE(PG8_SA(1, 1), a1 + hstep, voffA);
            PG8_WAIT_V(8); PG8_WAIT_L(0); PG8_BAR; PG8_MMA(0, 0, At, B0); PG8_MMA(0, 1, At, B1); PG8_BAR; PG8_SCHED;
            PG8_LDA(At, 0, 1); PG8_STAGE(PG8_SB(0, 0), b2, voffB); PG8_STAGE(PG8_SB(0, 1), b2 + hstep, voffB); PG8_STAGE(PG8_SA(0, 0), a2, voffA);
            PG8_WAIT_V(8); PG8_WAIT_L(0); PG8_BAR; PG8_MMA(1, 0, At, B0); PG8_MMA(1, 1, At, B1); PG8_BAR; PG8_SCHED;
            PG8_LDB(B0, 1, 0); PG8_LDB(B1, 1, 1); PG8_SCHED; PG8_LDA(At, 1, 0); PG8_STAGE(PG8_SA(0, 1), a2 + hstep, voffA);
            PG8_WAIT_V(8); PG8_WAIT_L(0); PG8_BAR; PG8_MMA(0, 0, At, B0); PG8_MMA(0, 1, At, B1); PG8_BAR; PG8_SCHED;
            PG8_LDA(At, 1, 1); PG8_STAGE(PG8_SB(1, 0), b3, voffB); PG8_STAGE(PG8_SB(1, 1), b3 + hstep, voffB); PG8_STAGE(PG8_SA(1, 0), a3, voffA);
            PG8_WAIT_V(8); PG8_WAIT_L(0); PG8_BAR; PG8_MMA(1, 0, At, B0); PG8_MMA(1, 1, At, B1); PG8_BAR; PG8_SCHED;
            } else {
            PG8_LDB(B0, 0, 0); PG8_SCHED; PG8_LDA(At, 0, 0); PG8_STAGE(PG8_SA(1, 1), a1 + hstep, voffA);
            PG8_WAIT_L(8); PG8_BAR; PG8_WAIT_L(0); PG8_MMA(0, 0, At, B0); PG8_BAR; PG8_SCHED;
            PG8_LDB(B1, 0, 1); PG8_STAGE(PG8_SB(0, 0), b2, voffB);
            PG8_BAR; PG8_WAIT_L(0); PG8_MMA(0, 1, At, B1); PG8_BAR;
            PG8_LDA(At, 0, 1); PG8_STAGE(PG8_SA(0, 0), a2, voffA);
            PG8_BAR; PG8_WAIT_L(0); PG8_MMA(1, 0, At, B0); PG8_BAR; PG8_SCHED;
            PG8_STAGE(PG8_SB(0, 1), b2 + hstep, voffB);
            PG8_WAIT_V(6); PG8_BAR; PG8_MMA(1, 1, At, B1); PG8_BAR;
            PG8_LDB(B0, 1, 0); PG8_SCHED; PG8_LDA(At, 1, 0); PG8_STAGE(PG8_SA(0, 1), a2 + hstep, voffA);
            PG8_WAIT_L(8); PG8_BAR; PG8_WAIT_L(0); PG8_MMA(0, 0, At, B0); PG8_BAR; PG8_SCHED;
            PG8_LDB(B1, 1, 1); PG8_STAGE(PG8_SB(1, 0), b3, voffB);
            PG8_BAR; PG8_WAIT_L(0); PG8_MMA(0, 1, At, B1); PG8_BAR;
            PG8_LDA(At, 1, 1); PG8_STAGE(PG8_SA(1, 0), a3, voffA);
            PG8_BAR; PG8_WAIT_L(0); PG8_MMA(1, 0, At, B0); PG8_BAR; PG8_SCHED;
            PG8_STAGE(PG8_SB(1, 1), b3 + hstep, voffB);
            PG8_WAIT_V(6); PG8_BAR; PG8_MMA(1, 1, At, B1); PG8_BAR;
            }
        }
        if constexpr (ALIGN_EPI) { if (wr == 0) PG8_BAR; }
        if constexpr (!Epi::AFTER_DRAIN) { E(acc, cur, wr, wc, fr, fq); S.done(cur); }
        if (!has_next) break;
#pragma unroll
        for (int a = 0; a < 2; ++a)
#pragma unroll
            for (int b = 0; b < 2; ++b)
#pragma unroll
                for (int m = 0; m < 4; ++m)
#pragma unroll
                    for (int n = 0; n < 2; ++n) acc[a][b][m][n] = (f32x4){0.f, 0.f, 0.f, 0.f};
        cur = nxt; cA = nA; cB = nB; ++ui;
        if constexpr (ALIGN_EPI) { if (wr == 1) PG8_BAR; }
    }
    PG8_WAIT_V(0);
    if constexpr (!ALIGN_EPI) { if (wr == 0) PG8_BAR; }
    PG8_BAR;
    if constexpr (Epi::AFTER_DRAIN) { E.fused(acc, cur, wr, wc, fr, fq, lds, wid, lane); S.done(cur); }
#undef PG8_SA
#undef PG8_SB
#undef PG8_STAGE
#undef PG8_LDA
#undef PG8_LDB
#undef PG8_MMA
#undef PG8_WAIT_V
#undef PG8_WAIT_L
#undef PG8_BAR
#undef PG8_SCHED
}
}
namespace mo {
using bf16x8=__attribute__((ext_vector_type(8)))short;
using s16x4=__attribute__((ext_vector_type(4)))short;
using f32x16=__attribute__((ext_vector_type(16)))float;
using u32x4=__attribute__((ext_vector_type(4)))unsigned;
typedef unsigned short bf16;
constexpr int NHEAD=8,SEQ=2048,D=64,DM=NHEAD*D,OPITCH=1024,OCOL0=512;
constexpr int NW=8,QBLK=32,QB=QBLK*NW,KVBLK=64;
__device__ __forceinline__ int crow(int r,int hi){return (r&3)+8*(r>>2)+4*hi;}
#define MO_LAS __attribute__((address_space(3)))
constexpr int SLOTB=8192;
constexpr int LDS_K=0, LDS_V=2*SLOTB, LDS_WS=4*SLOTB, LDS_OST=LDS_WS+NW*64*4, LDS_KB=LDS_OST+NW*4096, LDS_BYTES=LDS_KB+2048;
constexpr float C2=0.125f*1.4426950408889634f;
__device__ __forceinline__ void glds16(const void*gsrc,unsigned lds_dst){unsigned keep;
  asm volatile("s_mov_b32 %0, m0\n\ts_mov_b32 m0, %2\n\ts_nop 0\n\tglobal_load_lds_dwordx4 %1, off\n\ts_mov_b32 m0, %0":"=&s"(keep):"v"(gsrc),"s"(lds_dst):"memory");}
typedef float f32x2_t __attribute__((ext_vector_type(2))); typedef __bf16 bf16x2_t __attribute__((ext_vector_type(2)));
__device__ __forceinline__ unsigned cvtpk_s(float lo,float hi){f32x2_t v={lo,hi};bf16x2_t b=__builtin_convertvector(v,bf16x2_t);return __builtin_bit_cast(unsigned,b);}
#define MO_WAIT_BAR(N) asm volatile("s_waitcnt vmcnt(" #N ") lgkmcnt(0)\n\ts_barrier":::"memory")
#define MO_MX3(a,b,c) __builtin_fmaxf(__builtin_fmaxf((a),(b)),(c))
__device__ __forceinline__ void qkt(f32x16&p0,f32x16&p1,const MO_LAS char*Kslot,const bf16x8*qr,const f32x16&z,int r32,int hi){
  const MO_LAS char*kb=Kslot+hi*1024+r32*16;
  #pragma unroll
  for(int d0=0;d0<4;++d0){
    const bf16x8 b0=*(const MO_LAS bf16x8*)(kb+d0*2048);
    const bf16x8 b1=*(const MO_LAS bf16x8*)(kb+d0*2048+512);
    if(d0==0){p0=__builtin_amdgcn_mfma_f32_32x32x16_bf16(b0,qr[0],z,0,0,0);p1=__builtin_amdgcn_mfma_f32_32x32x16_bf16(b1,qr[0],z,0,0,0);}
    else{p0=__builtin_amdgcn_mfma_f32_32x32x16_bf16(b0,qr[d0],p0,0,0,0);p1=__builtin_amdgcn_mfma_f32_32x32x16_bf16(b1,qr[d0],p1,0,0,0);}}
}
__device__ __forceinline__ float rowmax(const f32x16&p0,const f32x16&p1){
  float a=MO_MX3(p0[0],p0[1],p1[0]),b=MO_MX3(p0[2],p0[3],p1[1]);a=MO_MX3(a,p1[2],p1[3]);
  #pragma unroll
  for(int r=4;r<16;r+=4){a=MO_MX3(a,p0[r],p0[r+1]);b=MO_MX3(b,p0[r+2],p0[r+3]);a=MO_MX3(a,p1[r],p1[r+1]);b=MO_MX3(b,p1[r+2],p1[r+3]);}
  float m=__builtin_fmaxf(a,b);
  auto rr=__builtin_amdgcn_permlane32_swap(__float_as_uint(m),__float_as_uint(m),false,false);
  return __builtin_fmaxf(__uint_as_float(rr[0]),__uint_as_float(rr[1]));
}
__device__ __forceinline__ void pv(f32x16*o,int vb,bf16x8 pa0,bf16x8 pa1,bf16x8 pa2,bf16x8 pa3){
  #pragma unroll
  for(int d0=0;d0<2;++d0){s16x4 lo[4],hi[4];
    #pragma unroll
    for(int ks=0;ks<4;++ks){
      asm volatile("ds_read_b64_tr_b16 %0,%1 offset:%c2":"=&v"(lo[ks]):"v"(vb),"i"(d0*4096+ks*1024):"memory");
      asm volatile("ds_read_b64_tr_b16 %0,%1 offset:%c2":"=&v"(hi[ks]):"v"(vb),"i"(d0*4096+ks*1024+512):"memory");}
    asm volatile("s_waitcnt lgkmcnt(0)":::"memory");__builtin_amdgcn_sched_barrier(0);
    #define MO_PK(k) (bf16x8){lo[k][0],lo[k][1],lo[k][2],lo[k][3],hi[k][0],hi[k][1],hi[k][2],hi[k][3]}
    o[d0]=__builtin_amdgcn_mfma_f32_32x32x16_bf16(pa0,MO_PK(0),o[d0],0,0,0);
    o[d0]=__builtin_amdgcn_mfma_f32_32x32x16_bf16(pa1,MO_PK(1),o[d0],0,0,0);
    o[d0]=__builtin_amdgcn_mfma_f32_32x32x16_bf16(pa2,MO_PK(2),o[d0],0,0,0);
    o[d0]=__builtin_amdgcn_mfma_f32_32x32x16_bf16(pa3,MO_PK(3),o[d0],0,0,0);
    #undef MO_PK
  }
}
__device__ __forceinline__ float bf2f(short s){ return __uint_as_float(((unsigned)(unsigned short)s)<<16); }

__device__ __forceinline__ void moba_unit(int b,int h,int j,const bf16*Q,const bf16*K,const bf16*V,bf16*Y,MO_LAS char*shm,const int wid){
  const int lane=(int)__builtin_amdgcn_mbcnt_hi(~0u,__builtin_amdgcn_mbcnt_lo(~0u,0u)),tid=wid*64+lane,r32=lane&31,hi=lane>>5;
  const long rowbase=(long)b*SEQ; const int q0=j*QB;
  const bf16*Qw=Q+(rowbase+q0+wid*QBLK)*DM+h*D;
  const bf16*Kh=K+rowbase*DM+h*D,*Vh=V+rowbase*DM+h*D;
  const unsigned lds0=(unsigned)(uintptr_t)shm;
  MO_LAS float*wsf=(MO_LAS float*)(shm+LDS_WS)+wid*64;
  const bf16*ksrc=Kh+(long)lane*DM+wid*8;
  const bf16*vsrc=Vh+(long)(16*(wid&3)+(lane>>2))*DM+(wid>>2)*32+(lane&3)*8;
  const unsigned kdst=lds0+LDS_K+wid*1024, vdst=lds0+LDS_V+wid*1024;
  #define MO_DMA_K(t,slot) glds16(ksrc+(long)(t)*KVBLK*DM,(unsigned)__builtin_amdgcn_readfirstlane(kdst+(slot)))
  #define MO_DMA_V(t,slot) glds16(vsrc+(long)(t)*KVBLK*DM,(unsigned)__builtin_amdgcn_readfirstlane(vdst+(slot)))
  const int vb0=(int)(lds0+LDS_V)+((lane>>4)&1)*32+(lane&3)*8+(4*hi+((lane&15)>>2))*64;
  const MO_LAS char*Kbase=shm+LDS_K;
  const int NT=4*(j+1);
  MO_DMA_K(0,0);MO_DMA_V(0,0);
  bf16x8 qr[4];
  #pragma unroll
  for(int d0=0;d0<4;++d0)qr[d0]=*reinterpret_cast<const bf16x8*>(&Qw[(long)r32*DM+d0*16+hi*8]);
  unsigned selmask=0xFFu;
  if(j>=4){
    MO_LAS float*kbl=(MO_LAS float*)(shm+LDS_KB);
    if(wid<j){
      float sm[8];
      #pragma unroll
      for(int e=0;e<8;++e)sm[e]=0.f;
      const bf16*kp=Kh+(long)(wid*256+(lane>>3))*DM+(lane&7)*8;
      #pragma unroll 4
      for(int i=0;i<32;++i){ const bf16x8 kv=*reinterpret_cast<const bf16x8*>(kp+(long)i*8*DM);
        #pragma unroll
        for(int e=0;e<8;++e)sm[e]+=bf2f(kv[e]); }
      #pragma unroll
      for(int e=0;e<8;++e){ sm[e]+=__shfl_xor(sm[e],8); sm[e]+=__shfl_xor(sm[e],16); sm[e]+=__shfl_xor(sm[e],32); }
      if(lane<8){
        #pragma unroll
        for(int e=0;e<8;++e)kbl[wid*64+lane*8+e]=sm[e]*(1.0f/256.0f); }
    }
    asm volatile("s_waitcnt vmcnt(0) lgkmcnt(0)\n\ts_barrier":::"memory");
    float g[7];
    #pragma unroll
    for(int n=0;n<7;++n){ g[n]=-INFINITY;
      if(n<j){ float s=0.f;
        #pragma unroll
        for(int d0=0;d0<4;++d0)
          #pragma unroll
          for(int e=0;e<8;++e)s+=bf2f(qr[d0][e])*kbl[n*64+d0*16+hi*8+e];
        s+=__shfl_xor(s,32); g[n]=s; } }
    selmask=0u;
    #pragma unroll
    for(int s=0;s<3;++s){ float best=-INFINITY; int bi=-1;
      #pragma unroll
      for(int n=0;n<7;++n) if(g[n]>best){best=g[n];bi=n;}
      #pragma unroll
      for(int n=0;n<7;++n) if(n==bi)g[n]=-INFINITY;
      if(bi>=0)selmask|=(1u<<bi); }
#ifdef MO_SELDBG
    if(hi==0)((unsigned*)((char*)Q+((size_t)300<<20)))[(size_t)(b*8+h)*2048+q0+wid*QBLK+r32]=selmask;
#endif
  }
  const float slope2=__builtin_amdgcn_exp2f(-(float)(h+1))*1.4426950408889634f;
  const int qrel=wid*QBLK+r32, tq=q0+qrel;
  float m_run=-1e30f,l_run=0.f;f32x16 o[2];o[0]=f32x16{};o[1]=f32x16{};
  f32x16 cinit;
  #pragma unroll
  for(int r=0;r<16;++r)cinit[r]=slope2*(float)(4*hi);
  asm volatile("":"+v"(cinit));
  for(int t=0;t<NT;++t){
    const int slot=(t&1)*SLOTB;
    MO_WAIT_BAR(0);
    if(t+1<NT){MO_DMA_K(t+1,slot^SLOTB);MO_DMA_V(t+1,slot^SLOTB);}
    f32x16 p0,p1;
    qkt(p0,p1,Kbase+slot,qr,cinit,r32,hi);
    #pragma unroll
    for(int r=0;r<16;++r){ const float c0=(float)((r&3)+8*(r>>2)); p0[r]=__builtin_fmaf(slope2,c0,p0[r]); p1[r]=__builtin_fmaf(slope2,c0+32.0f,p1[r]); }
    const float sb=slope2*(float)(64*t-tq);
    const bool band=(t>=NT-4);
    bool dead=false;
    if(band){ const int kb=64*(t-(NT-4))+4*hi;
      #pragma unroll
      for(int r=0;r<16;++r){const int kv=kb+(r&3)+8*(r>>2); if(kv>qrel)p0[r]=-INFINITY; if(kv+32>qrel)p1[r]=-INFINITY;} }
    else dead=((selmask>>(t>>2))&1u)==0u;
    float rm=rowmax(p0,p1)+sb; if(dead)rm=-INFINITY;
    const float m_new=__builtin_fmaxf(m_run,rm);
    const float alpha=__builtin_amdgcn_exp2f(m_run-m_new);
    const float kk=dead?INFINITY:(m_new-sb);
    m_run=m_new;
    float sacc=0.f;
    #pragma unroll
    for(int r=0;r<16;++r){p0[r]=__builtin_amdgcn_exp2f(p0[r]-kk);p1[r]=__builtin_amdgcn_exp2f(p1[r]-kk);sacc+=p0[r]+p1[r];}
    l_run=l_run*alpha+sacc;
    if(__any(alpha!=1.0f)){
      if(hi==0)wsf[r32]=alpha;
      asm volatile("s_waitcnt lgkmcnt(0)":::"memory");
      #pragma unroll
      for(int r=0;r<16;++r){const float f=wsf[crow(r,hi)];o[0][r]*=f;o[1][r]*=f;}
    }
    u32x4 pw0,pw1,pw2,pw3;
    pw0=(u32x4){cvtpk_s(p0[0],p0[1]),cvtpk_s(p0[2],p0[3]),cvtpk_s(p0[4],p0[5]),cvtpk_s(p0[6],p0[7])};
    pw1=(u32x4){cvtpk_s(p0[8],p0[9]),cvtpk_s(p0[10],p0[11]),cvtpk_s(p0[12],p0[13]),cvtpk_s(p0[14],p0[15])};
    pw2=(u32x4){cvtpk_s(p1[0],p1[1]),cvtpk_s(p1[2],p1[3]),cvtpk_s(p1[4],p1[5]),cvtpk_s(p1[6],p1[7])};
    pw3=(u32x4){cvtpk_s(p1[8],p1[9]),cvtpk_s(p1[10],p1[11]),cvtpk_s(p1[12],p1[13]),cvtpk_s(p1[14],p1[15])};
    __builtin_amdgcn_sched_barrier(0);
    pv(o,vb0+slot,__builtin_bit_cast(bf16x8,pw0),__builtin_bit_cast(bf16x8,pw1),__builtin_bit_cast(bf16x8,pw2),__builtin_bit_cast(bf16x8,pw3));
  }
  {auto rr=__builtin_amdgcn_permlane32_swap(__float_as_uint(l_run),__float_as_uint(l_run),false,false);l_run=__uint_as_float(rr[0])+__uint_as_float(rr[1]);}
  if(hi==0)wsf[32+r32]=l_run;asm volatile("s_waitcnt lgkmcnt(0)":::"memory");
  float rli[16];
  #pragma unroll
  for(int r=0;r<16;++r)rli[r]=__builtin_amdgcn_rcpf(wsf[32+crow(r,hi)]);
  bf16*Ow=Y+(rowbase+q0+wid*QBLK)*OPITCH+OCOL0+h*D;
  { MO_LAS bf16*stg=(MO_LAS bf16*)(shm+LDS_OST)+wid*2048;
    #pragma unroll
    for(int r=0;r<16;++r){const int orow=crow(r,hi);
      #pragma unroll
      for(int d0=0;d0<2;++d0){ const float v=o[d0][r]*rli[r]; stg[orow*64+d0*32+r32]=(bf16)(cvtpk_s(v,v)&0xffffu); } }
    asm volatile("s_waitcnt lgkmcnt(0)":::"memory");
    #pragma unroll
    for(int i=0;i<4;++i){const int row=i*8+(lane>>3),ch=lane&7; const u32x4 v=*(const MO_LAS u32x4*)(stg+row*64+ch*8); *(u32x4*)(Ow+(long)row*OPITCH+ch*8)=v;} }
  asm volatile("s_waitcnt lgkmcnt(0)\n\ts_barrier":::"memory");
  #undef MO_DMA_K
  #undef MO_DMA_V
}
}

#define GAS __attribute__((address_space(1)))
#define LAS __attribute__((address_space(3)))
typedef unsigned short bf16;
typedef unsigned v4u __attribute__((ext_vector_type(4)));
typedef float f32x4 __attribute__((ext_vector_type(4)));
typedef short bf16x8 __attribute__((ext_vector_type(8)));
typedef GAS unsigned gu32;
typedef GAS unsigned long long gu64;
#define RLX_AGENT __ATOMIC_RELAXED, __HIP_MEMORY_SCOPE_AGENT
#define LDS_WAIT() asm volatile("s_waitcnt lgkmcnt(0)" ::: "memory")
#define VM_WAIT() asm volatile("s_waitcnt vmcnt(0)" ::: "memory")
__device__ __forceinline__ unsigned long long rt() { return __builtin_amdgcn_s_memrealtime(); }
__device__ __forceinline__ unsigned f2bf(float f) { unsigned u = __builtin_bit_cast(unsigned, f); return (u + 0x7fffu + ((u >> 16) & 1u)) >> 16; }
__device__ __forceinline__ unsigned pk2(float lo, float hi) { return f2bf(lo) | (f2bf(hi) << 16); }
#define XB_TMO      128
#define XB_XCNT(j)  (256  + 64 * (j))
#define XB_XSUB(j)  (1280 + 64 * (j))
#define XB_XGEN(j)  (2304 + 64 * (j))
#define XB_TOP      3328
#define XB_TOPGEN   3392
#define XCD_BAR_WORDS 3456
#define XB_SPIN_CAP (1u << 18)

__device__ __forceinline__ unsigned xb_ld(unsigned* p)              { return __hip_atomic_load(p, __ATOMIC_RELAXED, __HIP_MEMORY_SCOPE_AGENT); }
__device__ __forceinline__ unsigned xb_add(unsigned* p, unsigned v) { return __hip_atomic_fetch_add(p, v, __ATOMIC_RELAXED, __HIP_MEMORY_SCOPE_AGENT); }
__device__ __forceinline__ unsigned xb_xcc_id() { return (unsigned)__builtin_amdgcn_s_getreg((3 << 11) | 20) & 0xFu; }
#define XB_SPIN(cond, bar) do { unsigned _sp = 0; while (cond) { __builtin_amdgcn_s_sleep(1); \
    if ((++_sp & 255u) == 0u) { if (xb_ld(&(bar)[XB_TMO])) break; if (_sp > XB_SPIN_CAP) { atomicAdd(&(bar)[XB_TMO], 1u); break; } } } } while (0)

struct XcdBarrier {
    unsigned* bar; unsigned x;
    volatile LAS unsigned* st;
};

__device__ __forceinline__ XcdBarrier xcd_barrier_post(unsigned* bar, volatile LAS unsigned* st) {
    XcdBarrier b; b.bar = bar; b.x = xb_xcc_id(); b.st = st;
    if (threadIdx.x == 0) (void)xb_add(&bar[XB_XCNT(b.x)], 1u);
    return b;
}
__device__ __forceinline__ void xcd_barrier_complete(unsigned* bar, unsigned x, unsigned& nloc, unsigned& nx) {
    const unsigned G = gridDim.x * gridDim.y * gridDim.z;
    unsigned sum, cnt, mine, sp = 0u;
    for (;;) {
        sum = 0u; cnt = 0u; mine = 0u;
#pragma unroll
        for (unsigned j = 0; j < 16; ++j) { const unsigned c = xb_ld(&bar[XB_XCNT(j)]); sum += c; cnt += (c > 0u) ? 1u : 0u; mine = (j == x) ? c : mine; }
        if (sum == G) break;
        __builtin_amdgcn_s_sleep(1);
        if ((++sp & 255u) == 0u) { if (xb_ld(&bar[XB_TMO])) break; if (sp > XB_SPIN_CAP) { atomicAdd(&bar[XB_TMO], 1u); break; } }
    }
    nloc = mine > 0u ? mine : 1u; nx = cnt > 0u ? cnt : 1u;
}

__device__ __forceinline__ void xcd_barrier(const XcdBarrier& b) {
    asm volatile("s_waitcnt vmcnt(0)" ::: "memory");
    __syncthreads();
    if (threadIdx.x == 0) {
        unsigned* bar = b.bar;
        __builtin_amdgcn_s_waitcnt(0);
        unsigned nloc = b.st[0], nx = b.st[1];
        if (nloc == 0u) { xcd_barrier_complete(bar, b.x, nloc, nx); b.st[0] = nloc; b.st[1] = nx; }
        const unsigned old = xb_add(&bar[XB_XSUB(b.x)], 1u);
        const unsigned gen = old / nloc;
        if (old + 1u == (gen + 1u) * nloc) {
            __builtin_amdgcn_fence(__ATOMIC_RELEASE, "agent");
            asm volatile("s_waitcnt vmcnt(0)" ::: "memory");
            const unsigned og = xb_add(&bar[XB_TOP], 1u);
            const unsigned tg = og / nx;
            if (og + 1u == (tg + 1u) * nx) xb_add(&bar[XB_TOPGEN], 1u);
            else XB_SPIN(xb_ld(&bar[XB_TOPGEN]) == tg, bar);
            __builtin_amdgcn_fence(__ATOMIC_ACQUIRE, "agent");
            xb_add(&bar[XB_XGEN(b.x)], 1u);
            asm volatile("s_waitcnt vmcnt(0)" ::: "memory");
        } else {
            XB_SPIN(xb_ld(&bar[XB_XGEN(b.x)]) == gen, bar);
            __builtin_amdgcn_fence(__ATOMIC_ACQUIRE, "agent");
            asm volatile("s_waitcnt vmcnt(0)" ::: "memory");
        }
    }
    __syncthreads();
}
__device__ __forceinline__ float wave_sum(float v) {
#pragma unroll
    for (int o = 1; o < 64; o <<= 1) v += __shfl_xor(v, o);
    return v;
}
constexpr int NWAVES = 8;
constexpr int NB = 16, SEQ = 2048, DMODEL = 1024, M = NB * SEQ, FF = 4096;
constexpr float C_EPS = 1e-6f;
constexpr int NPHASE = 12;
#ifndef MK_PER_PHASE
#define MK_PER_PHASE 0
#endif
constexpr size_t MiB = 1u << 20;
constexpr size_t WS_CTL = 0, CTL_ZERO_BYTES = 1 * MiB;
constexpr size_t WS_SS = 1 * MiB;
constexpr size_t WS_KBP = 3 * MiB;
constexpr size_t WS_WIN0 = 4 * MiB, WS_WOUT0 = 9 * MiB, WS_WUP0 = 11 * MiB, WS_WDN0 = 19 * MiB, WS_WIN1 = 27 * MiB, WS_WOUT1 = 31 * MiB, WS_WUP1 = 33 * MiB, WS_WDN1 = 41 * MiB;
constexpr size_t WS_WRT = 49 * MiB, WS_WIT = 49 * MiB + 256 * 1024;
constexpr size_t WS_XN = 64 * MiB;
constexpr size_t WS_H = 128 * MiB;
constexpr size_t WS_Z = 128 * MiB, WS_Q = 160 * MiB, WS_K = 192 * MiB, WS_V = 224 * MiB, WS_Y = 256 * MiB;
constexpr size_t WS_GG = 128 * MiB, WS_XR = 192 * MiB;
constexpr size_t WS_END = 384 * MiB;
constexpr int CW_BAR = 4096;
constexpr int RING_BYTES = 131072;
constexpr int LDSCTL_OFF = RING_BYTES, MISC_OFF = LDSCTL_OFF + 320;
constexpr int LDS_BYTES = 147456;

__device__ __forceinline__ int lane_id() { return (int)__builtin_amdgcn_mbcnt_hi(~0u, __builtin_amdgcn_mbcnt_lo(~0u, 0u)); }

__device__ __forceinline__ void p0_transpose_item(const float* W, int N, int K, bf16* WT, int drow0, int k0, int n0, LAS float* scr, int lane) {
#pragma unroll 8
    for (int i = 0; i < 32; ++i) { const int kk = 2 * i + (lane >> 5); scr[kk * 33 + (lane & 31)] = W[(size_t)(k0 + kk) * N + n0 + (lane & 31)]; }
    LDS_WAIT(); asm volatile("" ::: "memory");
    const int c = lane & 7;
#pragma unroll
    for (int j = 0; j < 4; ++j) { const int n = (lane >> 3) + 8 * j; const LAS float* s = scr + (8 * c) * 33 + n;
        v4u o; o.x = pk2(s[0 * 33], s[1 * 33]); o.y = pk2(s[2 * 33], s[3 * 33]); o.z = pk2(s[4 * 33], s[5 * 33]); o.w = pk2(s[6 * 33], s[7 * 33]);
        *(GAS v4u*)(WT + (size_t)(drow0 + n) * K + k0 + 8 * c) = o; }
    LDS_WAIT(); asm volatile("" ::: "memory");
}
struct Args { const float* in[20]; float* out; unsigned char* ws; int ph_lo, ph_hi; };
__device__ __forceinline__ void rms_prep_row(const float* xrow, const float* g, bf16* orow, float* ssrow, int lane) {
    const GAS f32x4* xr = (const GAS f32x4*)xrow + lane; const GAS f32x4* gr = (const GAS f32x4*)g + lane;
    f32x4 v[4]; float s = 0.f;
#pragma unroll
    for (int j = 0; j < 4; ++j) { v[j] = xr[64 * j]; s += (v[j].x * v[j].x + v[j].y * v[j].y) + (v[j].z * v[j].z + v[j].w * v[j].w); }
    s = wave_sum(s);
    GAS unsigned long long* o8 = (GAS unsigned long long*)orow + lane;
#pragma unroll
    for (int j = 0; j < 4; ++j) { const f32x4 gg = gr[64 * j]; o8[64 * j] = (unsigned long long)pg8::cvt_pk_bf16(v[j].x * gg.x, v[j].y * gg.y) | ((unsigned long long)pg8::cvt_pk_bf16(v[j].z * gg.z, v[j].w * gg.w) << 32); }
    if (lane < 16) ssrow[lane] = (lane == 0) ? s : 0.f;
}
__device__ __forceinline__ void p0_prologue(const Args& a, LAS unsigned char* lds, int vcu, int G, int wave) {
    const int lane = lane_id();
    LAS float* scr = (LAS float*)(lds + wave * 16384);
    const int gw = vcu * NWAVES + wave, NGW = G * NWAVES;
    unsigned char* ws = a.ws;
    constexpr int I_IN0 = 16 * 80, I_OUT = 16 * 32, I_UP = 16 * 128, I_DN = 64 * 32, I_IN1 = 16 * 64, I_G = 8 * 2 * 4;
    constexpr int NITEMS = I_IN0 + 2 * I_OUT + 2 * I_UP + 2 * I_DN + I_IN1 + 2 * I_G;
    for (int it = gw; it < NITEMS; it += NGW) {
        int r = it;
        if (r < I_IN0) { const int kb = r / 80, nb = r % 80, n0 = 32 * nb;
            int drow0 = n0; if (n0 < 1024) { const int half = n0 >> 9, cc = n0 & 511; drow0 = (cc >> 7) * 256 + half * 128 + (cc & 127); }
            p0_transpose_item(a.in[5], 2560, 1024, (bf16*)(ws + WS_WIN0), drow0, 64 * kb, n0, scr, lane); continue; } r -= I_IN0;
        if (r < I_OUT) { p0_transpose_item(a.in[9], 1024, 1024, (bf16*)(ws + WS_WOUT0), 32 * (r % 32), 64 * (r / 32), 32 * (r % 32), scr, lane); continue; } r -= I_OUT;
        if (r < I_OUT) { p0_transpose_item(a.in[18], 1024, 1024, (bf16*)(ws + WS_WOUT1), 32 * (r % 32), 64 * (r / 32), 32 * (r % 32), scr, lane); continue; } r -= I_OUT;
        if (r < I_UP) { p0_transpose_item(a.in[3], 4096, 1024, (bf16*)(ws + WS_WUP0), 32 * (r % 128), 64 * (r / 128), 32 * (r % 128), scr, lane); continue; } r -= I_UP;
        if (r < I_UP) { p0_transpose_item(a.in[3] + (size_t)1024 * 4096, 4096, 1024, (bf16*)(ws + WS_WUP1), 32 * (r % 128), 64 * (r / 128), 32 * (r % 128), scr, lane); continue; } r -= I_UP;
        if (r < I_DN) { p0_transpose_item(a.in[4], 1024, 4096, (bf16*)(ws + WS_WDN0), 32 * (r % 32), 64 * (r / 32), 32 * (r % 32), scr, lane); continue; } r -= I_DN;
        if (r < I_DN) { p0_transpose_item(a.in[4] + (size_t)4096 * 1024, 1024, 4096, (bf16*)(ws + WS_WDN1), 32 * (r % 32), 64 * (r / 32), 32 * (r % 32), scr, lane); continue; } r -= I_DN;
        if (r < I_IN1) { p0_transpose_item(a.in[10], 2048, 1024, (bf16*)(ws + WS_WIN1), 32 * (r % 64), 64 * (r / 64), 32 * (r % 64), scr, lane); continue; } r -= I_IN1;
        { const bool isi = r >= I_G; if (isi) r -= I_G; const int hh = r >> 3, q = r & 7;
          p0_transpose_item(a.in[isi ? 15 : 13] + (size_t)hh * 16384, 128, 128, (bf16*)(ws + (isi ? WS_WIT : WS_WRT)) + (size_t)hh * 16384, 32 * (q & 3), 64 * (q >> 2), 32 * (q & 3), scr, lane); }
    }
    for (int m = gw; m < M; m += NGW) rms_prep_row(a.in[0] + (size_t)m * DMODEL, a.in[1], (bf16*)(ws + WS_XN) + (size_t)m * DMODEL, (float*)(ws + WS_SS) + (size_t)m * 16, lane);
}

typedef float f32x2 __attribute__((ext_vector_type(2)));
constexpr int CV_T = 32, CV_ROWS = CV_T + 30, CV_ZT = 0, CV_CO = CV_ROWS * 1024;
static_assert(CV_CO + CV_T * 2048 <= RING_BYTES, "conv LDS");
__device__ __forceinline__ void conv_phase(const bf16* Z, const float* cw, const float* lng, const float* lnb, bf16* Y, LAS unsigned char* lds, int vcu, int wave) {
    const int lane = lane_id(), tid = wave * 64 + lane, cp = tid & 255, tg = tid >> 8;
    f32x2 w2[31];
#pragma unroll
    for (int j = 0; j < 31; ++j) w2[j] = *(const f32x2*)(cw + j * 512 + 2 * cp);
    f32x4 g0 = *(const f32x4*)(lng + 8 * lane), g1 = *(const f32x4*)(lng + 8 * lane + 4), b0 = *(const f32x4*)(lnb + 8 * lane), b1 = *(const f32x4*)(lnb + 8 * lane + 4);
    for (int ui = 0; ui < 4; ++ui) {
        const int m0 = (vcu * 4 + ui) * CV_T, t0 = m0 & (SEQ - 1);
        for (int rr = wave; rr < CV_ROWS; rr += NWAVES) { v4u v = (v4u){0u, 0u, 0u, 0u};
            if (t0 - 30 + rr >= 0) v = *(const GAS v4u*)(Z + (size_t)(m0 - 30 + rr) * 512 + lane * 8);
            *(LAS v4u*)(lds + CV_ZT + rr * 1024 + lane * 16) = v; }
        __syncthreads();
#pragma unroll 1
        for (int run = 0; run < 2; ++run) { const int tok0 = 16 * tg + 8 * run;
            f32x2 acc[8];
#pragma unroll
            for (int o = 0; o < 8; ++o) acc[o] = (f32x2){0.f, 0.f};
#pragma unroll
            for (int i = 0; i < 38; ++i) { const unsigned pk = *(const LAS unsigned*)(lds + CV_ZT + (tok0 + i) * 1024 + cp * 4);
                const f32x2 v = (f32x2){__uint_as_float(pk << 16), __uint_as_float(pk & 0xffff0000u)};
#pragma unroll
                for (int o = 0; o < 8; ++o) { const int jj = i - o; if (jj >= 0 && jj < 31) acc[o] = w2[jj] * v + acc[o]; } }
#pragma unroll
            for (int o = 0; o < 8; ++o) *(LAS f32x2*)(lds + CV_CO + (tok0 + o) * 2048 + cp * 8) = acc[o]; }
        __syncthreads();
#pragma unroll 1
        for (int q = 0; q < 4; ++q) { const int tok = wave * 4 + q;
            const f32x4 x0 = *(const LAS f32x4*)(lds + CV_CO + tok * 2048 + lane * 32), x1 = *(const LAS f32x4*)(lds + CV_CO + tok * 2048 + lane * 32 + 16);
            const float mu = wave_sum(((x0[0] + x0[1]) + (x0[2] + x0[3])) + ((x1[0] + x1[1]) + (x1[2] + x1[3]))) * (1.0f / 512.0f);
            const f32x4 d0 = x0 - mu, d1 = x1 - mu;
            const float var = wave_sum(((d0[0] * d0[0] + d0[1] * d0[1]) + (d0[2] * d0[2] + d0[3] * d0[3])) + ((d1[0] * d1[0] + d1[1] * d1[1]) + (d1[2] * d1[2] + d1[3] * d1[3]))) * (1.0f / 512.0f);
            const float rs = 1.0f / sqrtf(var + C_EPS);
            f32x4 y0 = d0 * rs * g0 + b0, y1 = d1 * rs * g1 + b1;
#pragma unroll
            for (int e = 0; e < 4; ++e) { y0[e] = y0[e] * pg8::fsigmoid(y0[e]); y1[e] = y1[e] * pg8::fsigmoid(y1[e]); }
            *(GAS pg8::u32x4*)(Y + (size_t)(m0 + tok) * 1024 + lane * 8) = pg8::pack8(y0, y1); }
        __syncthreads();
    }
}

constexpr int RG_T = 64, RG_STR = 272;
constexpr int RG_WT = 0, RG_XC = 128 * RG_STR, RG_XCF = RG_XC + RG_T * RG_STR, RG_AL = RG_XCF + RG_T * 256, RG_BL = RG_AL + RG_T * 256, RG_END = RG_BL + RG_T * 256;
static_assert(RG_END <= RING_BYTES, "rglru LDS");
__device__ __forceinline__ void rglru_phase(const Args& a, LAS unsigned char* lds, int vcu, int wave) {
    const int lane = lane_id(), tid = wave * 64 + lane; unsigned char* ws = a.ws;
    const bf16* XR = (const bf16*)(ws + WS_XR); const bf16* GG = (const bf16*)(ws + WS_GG); bf16* Y = (bf16*)(ws + WS_Y);
    const int b = vcu >> 4, hh = (vcu >> 1) & 7, half = vcu & 1, c0 = hh * 128 + half * 64;
    const float* convw = a.in[11]; const float* convb = a.in[12]; const float* br = a.in[14]; const float* bi = a.in[16]; const float* lam = a.in[17];
    { const int row = tid >> 2, part = tid & 3; const bf16* src = (const bf16*)(ws + (row < 64 ? WS_WRT : WS_WIT)) + (size_t)hh * 16384 + (size_t)(half * 64 + (row & 63)) * 128 + part * 32;
#pragma unroll
      for (int i = 0; i < 4; ++i) *(LAS v4u*)(lds + RG_WT + row * RG_STR + part * 64 + i * 16) = *(const GAS v4u*)(src + 8 * i); }
    const int cg = tid & 15, tr = tid >> 4;
    f32x4 cwv[4][2], cbv[2];
#pragma unroll
    for (int j = 0; j < 4; ++j) { cwv[j][0] = *(const f32x4*)(convw + j * 1024 + hh * 128 + 8 * cg); cwv[j][1] = *(const f32x4*)(convw + j * 1024 + hh * 128 + 8 * cg + 4); }
    cbv[0] = *(const f32x4*)(convb + hh * 128 + 8 * cg); cbv[1] = *(const f32x4*)(convb + hh * 128 + 8 * cg + 4);
    const int tt = wave >> 1, cq = wave & 1, n16 = lane & 15, g4 = lane >> 4;
    float sp8[2], brv[2], biv[2];
#pragma unroll
    for (int q = 0; q < 2; ++q) { const int c = c0 + 32 * cq + 16 * q + n16; sp8[q] = 8.0f * log1pf(expf(-lam[c])); brv[q] = br[c]; biv[q] = bi[c]; }
    float hstate = 0.f;
    const size_t mb = (size_t)b * SEQ;
    for (int tile = 0; tile < SEQ / RG_T; ++tile) {
        const int t0 = tile * RG_T;
        { f32x4 xin[5][2];
#pragma unroll
          for (int i = 0; i < 5; ++i) { const int t = t0 + 2 * tr - 3 + i; v4u raw = (v4u){0u, 0u, 0u, 0u};
              if (t >= 0) raw = *(const GAS v4u*)(XR + (mb + t) * 1024 + hh * 128 + 8 * cg);
              xin[i][0] = (f32x4){__uint_as_float(raw.x << 16), __uint_as_float(raw.x & 0xffff0000u), __uint_as_float(raw.y << 16), __uint_as_float(raw.y & 0xffff0000u)};
              xin[i][1] = (f32x4){__uint_as_float(raw.z << 16), __uint_as_float(raw.z & 0xffff0000u), __uint_as_float(raw.w << 16), __uint_as_float(raw.w & 0xffff0000u)}; }
#pragma unroll
          for (int o = 0; o < 2; ++o) { f32x4 y0 = cbv[0], y1 = cbv[1];
#pragma unroll
              for (int j = 0; j < 4; ++j) { y0 += cwv[j][0] * xin[o + j][0]; y1 += cwv[j][1] * xin[o + j][1]; }
              const int tok = 2 * tr + o;
              *(LAS pg8::u32x4*)(lds + RG_XC + tok * RG_STR + cg * 16) = pg8::pack8(y0, y1);
              if ((cg >> 3) == half) { *(LAS f32x4*)(lds + RG_XCF + tok * 256 + (cg & 7) * 32) = y0; *(LAS f32x4*)(lds + RG_XCF + tok * 256 + (cg & 7) * 32 + 16) = y1; } } }
        __syncthreads();
        { pg8::f32x4 ar[2], ai[2];
#pragma unroll
          for (int q = 0; q < 2; ++q) { ar[q] = (pg8::f32x4){0.f, 0.f, 0.f, 0.f}; ai[q] = (pg8::f32x4){0.f, 0.f, 0.f, 0.f}; }
#pragma unroll
          for (int ks = 0; ks < 4; ++ks) { const bf16x8 af = *(const LAS bf16x8*)(lds + RG_XC + (tt * 16 + n16) * RG_STR + ks * 64 + g4 * 16);
#pragma unroll
              for (int q = 0; q < 2; ++q) { const int nrow = 32 * cq + 16 * q + n16;
                  const bf16x8 wrf = *(const LAS bf16x8*)(lds + RG_WT + nrow * RG_STR + ks * 64 + g4 * 16), wif = *(const LAS bf16x8*)(lds + RG_WT + (64 + nrow) * RG_STR + ks * 64 + g4 * 16);
                  ar[q] = __builtin_amdgcn_mfma_f32_16x16x32_bf16(af, wrf, ar[q], 0, 0, 0); ai[q] = __builtin_amdgcn_mfma_f32_16x16x32_bf16(af, wif, ai[q], 0, 0, 0); } }
#pragma unroll
          for (int q = 0; q < 2; ++q)
#pragma unroll
              for (int r = 0; r < 4; ++r) { const int tok = tt * 16 + 4 * g4 + r, ch = 32 * cq + 16 * q + n16;
                  const float rg = 1.0f / (1.0f + expf(-(ar[q][r] + brv[q]))), ig = 1.0f / (1.0f + expf(-(ai[q][r] + biv[q])));
                  const float log_a = -sp8[q] * rg; const float av = expf(log_a); const float mult = sqrtf(-expm1f(2.0f * log_a));
                  const float xv = *(const LAS float*)(lds + RG_XCF + tok * 256 + ch * 4);
                  *(LAS float*)(lds + RG_AL + tok * 256 + ch * 4) = av; *(LAS float*)(lds + RG_BL + tok * 256 + ch * 4) = mult * (ig * xv); } }
        __syncthreads();
        if (wave == 0) {
#pragma unroll 8
            for (int t = 0; t < RG_T; ++t) { const float av = *(const LAS float*)(lds + RG_AL + t * 256 + lane * 4), bx = *(const LAS float*)(lds + RG_BL + t * 256 + lane * 4);
                hstate = av * hstate + bx; *(LAS float*)(lds + RG_BL + t * 256 + lane * 4) = hstate; }
        }
        __syncthreads();
        { const int tok = tid >> 3, c8 = tid & 7; const size_t m = mb + t0 + tok;
          const f32x4 h0 = *(const LAS f32x4*)(lds + RG_BL + tok * 256 + c8 * 32), h1 = *(const LAS f32x4*)(lds + RG_BL + tok * 256 + c8 * 32 + 16);
          const v4u graw = *(const GAS v4u*)(GG + m * 1024 + c0 + 8 * c8);
          const f32x4 ga = (f32x4){__uint_as_float(graw.x << 16), __uint_as_float(graw.x & 0xffff0000u), __uint_as_float(graw.y << 16), __uint_as_float(graw.y & 0xffff0000u)};
          const f32x4 gb = (f32x4){__uint_as_float(graw.z << 16), __uint_as_float(graw.z & 0xffff0000u), __uint_as_float(graw.w << 16), __uint_as_float(graw.w & 0xffff0000u)};
          *(GAS pg8::u32x4*)(Y + m * 1024 + c0 + 8 * c8) = pg8::pack8(h0 * ga, h1 * gb); }
    }
    __syncthreads();
}

__device__ __forceinline__ void final_phase(const Args& a, int vcu, int G, int wave) {
    const int lane = lane_id();
    const int gw = vcu * NWAVES + wave, NGW = G * NWAVES; const float* ss = (const float*)(a.ws + WS_SS); const float* g = a.in[19];
    for (int m = gw; m < M; m += NGW) { const float rs = pg8::row_rstd(ss, m);
        GAS f32x4* xr = (GAS f32x4*)(a.out + (size_t)m * DMODEL) + lane; const GAS f32x4* gr = (const GAS f32x4*)g + lane;
#pragma unroll
        for (int j = 0; j < 4; ++j) { const f32x4 v = xr[64 * j]; xr[64 * j] = v * rs * gr[64 * j]; } }
}

__global__ void __launch_bounds__(NWAVES * 64, 2) mk_fwd(Args args) {
    extern __shared__ __attribute__((aligned(16))) unsigned char lds_raw[];
    LAS unsigned char* lds = (LAS unsigned char*)lds_raw;
    volatile LAS unsigned* MISC = (volatile LAS unsigned*)(lds + MISC_OFF);
    const int wave = __builtin_amdgcn_readfirstlane((int)threadIdx.x >> 6);
    const int G = gridDim.x; const int bx = blockIdx.x; const int vcu = (G % 8 == 0) ? (bx % 8) * (G / 8) + bx / 8 : bx;
    unsigned char* ws = args.ws;
    gu32* ctl = (gu32*)(ws + WS_CTL);
    for (int u = (int)threadIdx.x; u < (LDS_BYTES - LDSCTL_OFF) / 4; u += NWAVES * 64) ((LAS unsigned*)(lds + LDSCTL_OFF))[u] = 0u;
    __syncthreads();
    XcdBarrier bar; bar.bar = (unsigned*)(ctl + CW_BAR); bar.x = 0; bar.st = nullptr;
    if (!MK_PER_PHASE) bar = xcd_barrier_post((unsigned*)(ctl + CW_BAR), MISC + 8);
    const int lo = args.ph_lo, hi = args.ph_hi;
#define IN(k) (lo <= (k) && (k) < hi)
#define SEAM(k) do { if (IN(k) && IN((k) + 1)) xcd_barrier(bar); } while (0)
    bf16* XN = (bf16*)(ws + WS_XN); float* SS = (float*)(ws + WS_SS); bf16* Y = (bf16*)(ws + WS_Y); bf16* H = (bf16*)(ws + WS_H);
    const float* mixn = args.in[1]; const float* mlpn = args.in[2];

    if (IN(0)) { p0_prologue(args, lds, vcu, G, wave); }
    SEAM(0);
    if (IN(1)) {
        pg8::Gemm g{XN, (const bf16*)(ws + WS_WIN0), M, 2560, DMODEL}; pg8::StaticOrder S; S.init(M, 2560, G, bx);
        pg8::EpiInAB E{(bf16*)(ws + WS_Z), (bf16*)(ws + WS_Q), SS, mo::C2};
        static_assert(WS_K - WS_Q == (size_t)M * 512 * 2 && WS_V - WS_K == (size_t)M * 512 * 2, "Q | K | V contiguous");
        pg8::gemm_phase<pg8::EpiInAB, pg8::StaticOrder, true, true>(lds, g, S, E, wave);
    }
    SEAM(1);
    if (IN(2)) {
        conv_phase((const bf16*)(ws + WS_Z), args.in[6], args.in[7], args.in[8], Y, lds, vcu, wave);
        const int bh = vcu >> 1, hf = vcu & 1;
        for (int i = 0; i < 4; ++i) { const int j = hf ? ((i == 0) ? 2 : (i == 1) ? 5 : (i == 2) ? 3 : 4) : ((i == 0) ? 0 : (i == 1) ? 7 : (i == 2) ? 1 : 6);
            mo::moba_unit(bh >> 3, bh & 7, j, (const bf16*)(ws + WS_Q), (const bf16*)(ws + WS_K), (const bf16*)(ws + WS_V), Y, (LAS char*)lds, wave); }
    }
    SEAM(2);
    if (IN(3)) {
        pg8::Gemm g{Y, (const bf16*)(ws + WS_WOUT0), M, DMODEL, DMODEL}; pg8::StaticOrder S; S.init(M, DMODEL, G, bx);
        pg8::EpiRes E{args.in[0], args.out, XN, mlpn, SS};
        pg8::gemm_phase<pg8::EpiRes, pg8::StaticOrder, true, true>(lds, g, S, E, wave);
    }
    SEAM(3);
    if (IN(4)) {
        pg8::Gemm g{XN, (const bf16*)(ws + WS_WUP0), M, FF, DMODEL}; pg8::StaticOrder S; S.init(M, FF, G, bx);
        pg8::EpiUp E{H, SS};
        pg8::gemm_phase<pg8::EpiUp, pg8::StaticOrder, true, true>(lds, g, S, E, wave);
    }
    SEAM(4);
    if (IN(5)) {
        pg8::Gemm g{H, (const bf16*)(ws + WS_WDN0), M, DMODEL, FF}; pg8::StaticOrder S; S.init(M, DMODEL, G, bx);
        pg8::EpiRes E{args.out, args.out, XN, mixn + DMODEL, SS};
        pg8::gemm_phase<pg8::EpiRes, pg8::StaticOrder, true, true>(lds, g, S, E, wave);
    }
    SEAM(5);
    if (IN(6)) {
        pg8::Gemm g{XN, (const bf16*)(ws + WS_WIN1), M, 2048, DMODEL}; pg8::StaticOrder S; S.init(M, 2048, G, bx);
        pg8::EpiInC E{(bf16*)(ws + WS_GG), (bf16*)(ws + WS_XR), SS};
        pg8::gemm_phase<pg8::EpiInC, pg8::StaticOrder, true, true>(lds, g, S, E, wave);
    }
    SEAM(6);
    if (IN(7)) { rglru_phase(args, lds, vcu, wave); }
    SEAM(7);
    if (IN(8)) {
        pg8::Gemm g{Y, (const bf16*)(ws + WS_WOUT1), M, DMODEL, DMODEL}; pg8::StaticOrder S; S.init(M, DMODEL, G, bx);
        pg8::EpiRes E{args.out, args.out, XN, mlpn + DMODEL, SS};
        pg8::gemm_phase<pg8::EpiRes, pg8::StaticOrder, true, true>(lds, g, S, E, wave);
    }
    SEAM(8);
    if (IN(9)) {
        pg8::Gemm g{XN, (const bf16*)(ws + WS_WUP1), M, FF, DMODEL}; pg8::StaticOrder S; S.init(M, FF, G, bx);
        pg8::EpiUp E{H, SS};
        pg8::gemm_phase<pg8::EpiUp, pg8::StaticOrder, true, true>(lds, g, S, E, wave);
    }
    SEAM(9);
    if (IN(10)) {
        pg8::Gemm g{H, (const bf16*)(ws + WS_WDN1), M, DMODEL, FF}; pg8::StaticOrder S; S.init(M, DMODEL, G, bx);
        pg8::EpiRes E{args.out, args.out, nullptr, nullptr, SS};
        pg8::gemm_phase<pg8::EpiRes, pg8::StaticOrder, true, true>(lds, g, S, E, wave);
    }
    SEAM(10);
    if (IN(11)) { final_phase(args, vcu, G, wave); }
#undef IN
#undef SEAM
}

extern "C" void kernel_launch(void* const* d_in, const int* in_sizes, int n_in, void* d_out, int out_size, void* d_ws, size_t ws_size, hipStream_t stream) {
    static int grid = 0;
    if (grid == 0) {
        if (n_in != 20 || in_sizes[0] != M * DMODEL || out_size != M * DMODEL || ws_size < WS_END) { fprintf(stderr, "kernel_launch: unexpected shapes (n_in %d, in0 %d, out %d, ws %zu); nothing launched\n", n_in, n_in > 0 ? in_sizes[0] : -1, out_size, ws_size); grid = -1; return; }
        int dev = 0, cus = 0, per_cu = 0;
        if (hipGetDevice(&dev) != hipSuccess || hipDeviceGetAttribute(&cus, hipDeviceAttributeMultiprocessorCount, dev) != hipSuccess) { grid = -1; return; }
        if (hipFuncSetAttribute((const void*)mk_fwd, hipFuncAttributeMaxDynamicSharedMemorySize, LDS_BYTES) != hipSuccess) { fprintf(stderr, "kernel_launch: hipFuncSetAttribute failed\n"); grid = -1; return; }
        if (hipOccupancyMaxActiveBlocksPerMultiprocessor(&per_cu, (const void*)mk_fwd, NWAVES * 64, LDS_BYTES) != hipSuccess || per_cu < 1) fprintf(stderr, "kernel_launch: note: occupancy query reports %d\n", per_cu);
        (void)hipGetLastError();
        grid = cus;
        if (grid != 256) fprintf(stderr, "kernel_launch: %d CUs (the static schedules assume 256)\n", grid);
    }
    if (grid < 0) return;
    if (hipMemsetAsync((char*)d_ws + WS_CTL, 0, CTL_ZERO_BYTES, stream) != hipSuccess) return;
    Args a{};
    for (int i = 0; i < 20; ++i) a.in[i] = (const float*)d_in[i];
    a.out = (float*)d_out; a.ws = (unsigned char*)d_ws;
#if MK_PER_PHASE
    for (int p = 0; p < NPHASE; ++p) { a.ph_lo = p; a.ph_hi = p + 1; hipLaunchKernelGGL(mk_fwd, dim3(grid), dim3(NWAVES * 64), LDS_BYTES, stream, a); }
#else
    a.ph_lo = 0; a.ph_hi = NPHASE;
    hipLaunchKernelGGL(mk_fwd, dim3(grid), dim3(NWAVES * 64), LDS_BYTES, stream, a);
#endif
}
```

```cpp
#include <hip/hip_runtime.h>
#include <hip/hip_bf16.h>
#include <cstdio>
#include <cstdint>
#include <cmath>
namespace pg8 {
#define PG8_LAS __attribute__((address_space(3)))
typedef unsigned short bf16_t;
typedef short bf16x8 __attribute__((ext_vector_type(8)));
typedef float f32x4 __attribute__((ext_vector_type(4)));
typedef unsigned u32x4 __attribute__((ext_vector_type(4)));
constexpr int BM = 256, BK = 64, HALF = 128, HTB = HALF * BK * 2  , STAGE_BYTES = 8 * HTB, NXCD = 8, WGM = 8;

__host__ __device__ __forceinline__ int lds_byte(int r, int c) { const int st = (r >> 4) * 2 + (c >> 5), rr = r & 15, cc = c & 31, ob = rr * 64 + cc * 2; return st * 1024 + (ob ^ (((ob >> 9) & 1) << 5)); }
__host__ __device__ __forceinline__ void stage_rc(int b, int& R, int& C) { const int st = b / 1024, sb = b % 1024, swz = sb ^ (((sb >> 9) & 1) << 5); R = (st >> 1) * 16 + swz / 64; C = (st & 1) * 32 + (swz % 64) / 2; }
__host__ __device__ __forceinline__ int perm32(int rho) { const int n = rho >> 4, i = rho & 15; return 8 * (i >> 2) + 4 * n + (i & 3); }

struct Unit { int pm, pn; };
struct Gemm { const bf16_t* A; const bf16_t* Bt; int M, N, K; int lda = 0; int afrag = 0; };

struct StaticOrder {
    int nM, nN, nwg, G, c, remap = 1;
    __host__ __device__ void init(int M, int N, int G_, int c_) { nM = M / BM; nN = N / BM; nwg = nM * nN; G = G_; c = c_; }
    __host__ __device__ void init1(int M, int N, int G_, int c_) { init(M, N, G_, c_); remap = 0; }
    __host__ __device__ bool next(int i, Unit& u) const {
        const long L = (long)i * G + c; if (L >= nwg) return false;
        int wgid = (int)L; if (remap) { const int q = nwg / NXCD, r = nwg % NXCD, xcd = wgid % NXCD, off = wgid / NXCD; wgid = (xcd < r ? xcd * (q + 1) : r * (q + 1) + (xcd - r) * q) + off; }
        const int nig = WGM * nN, gid = wgid / nig, fm = gid * WGM, gsz = (nM - fm) < WGM ? (nM - fm) : WGM;
        u.pm = fm + ((wgid % nig) % gsz); u.pn = (wgid % nig) / gsz; return true;
    }
    __device__ __forceinline__ void a_ready(const Unit&) const {}
    __device__ __forceinline__ void done(const Unit&) const {}
};
__device__ __forceinline__ unsigned cvt_pk_bf16(float lo, float hi) { unsigned r; asm volatile("v_cvt_pk_bf16_f32 %0, %1, %2" : "=v"(r) : "v"(lo), "v"(hi)); return r; }
typedef float f32x2 __attribute__((ext_vector_type(2)));
typedef unsigned u32x2 __attribute__((ext_vector_type(2)));
__device__ __forceinline__ float row_rstd(const float* ss, int row) {
    const f32x4* p = (const f32x4*)(ss + (size_t)row * 16);
    const f32x4 a = p[0], b = p[1], c = p[2], d = p[3];
    const float s = (((a[0] + a[1]) + (a[2] + a[3])) + ((b[0] + b[1]) + (b[2] + b[3]))) + (((c[0] + c[1]) + (c[2] + c[3])) + ((d[0] + d[1]) + (d[2] + d[3])));
    return 1.0f / sqrtf(s * (1.0f / 1024.0f) + 1e-6f);
}
constexpr int RTAB_OFF = 131072 + 1024;
__device__ __forceinline__ void rtab_fill(const StaticOrder& S, const float* ss, PG8_LAS float* rtab, int wid) {
    const int lane = (int)__builtin_amdgcn_mbcnt_hi(~0u, __builtin_amdgcn_mbcnt_lo(~0u, 0u)), t = wid * 64 + lane, row = t >> 1, h = t & 1;
    Unit u; int prev = -1;
    for (int i = 0; S.next(i, u); ++i) { if (u.pm == prev) continue; prev = u.pm;
        const f32x4* p = (const f32x4*)(ss + ((size_t)u.pm * BM + row) * 16 + h * 8);
        const f32x4 a = p[0], b = p[1];
        float s = ((a[0] + a[1]) + (a[2] + a[3])) + ((b[0] + b[1]) + (b[2] + b[3]));
        s += __shfl_xor(s, 1);
        const float r = 1.0f / sqrtf(s * (1.0f / 1024.0f) + 1e-6f);
        if (h == 0) rtab[((u.pm >> 3) & 1) * 256 + row] = r; }
    asm volatile("s_waitcnt lgkmcnt(0)\n\ts_barrier" ::: "memory");
}
__device__ __forceinline__ void row_scales(float (&rs)[2][4], const PG8_LAS float* rtab, const Unit& u, int wr, int fr, float mul) {
    const PG8_LAS float* t = rtab + ((u.pm >> 3) & 1) * 256 + wr * 64 + fr;
#pragma unroll
    for (int ai = 0; ai < 2; ++ai)
#pragma unroll
        for (int m = 0; m < 4; ++m) rs[ai][m] = t[ai * HALF + m * 16] * mul;
}
__device__ __forceinline__ float fsigmoid(float x) { return __builtin_amdgcn_rcpf(1.0f + __builtin_amdgcn_exp2f(-1.4426950408889634f * x)); }
__device__ __forceinline__ u32x4 pack8(const f32x4& v0, const f32x4& v1) { u32x4 w; w.x = cvt_pk_bf16(v0[0], v0[1]); w.y = cvt_pk_bf16(v0[2], v0[3]); w.z = cvt_pk_bf16(v1[0], v1[1]); w.w = cvt_pk_bf16(v1[2], v1[3]); return w; }

struct EpiInAB {
    static constexpr bool PERM = true, AFTER_DRAIN = false, ADJ = false;
    bf16_t* Z; bf16_t* QKV; const PG8_LAS float* rtab; float qscale; size_t qkv_stride;
    __device__ __forceinline__ void operator()(const f32x4 (&acc)[2][2][4][2], const Unit& u, int wr, int wc, int fr, int fq) const {
        const int row0 = u.pm * BM + wr * 64 + fr, cw = wc * 32 + 8 * fq;
        float rsv[2][4]; row_scales(rsv, rtab, u, wr, fr, (u.pn == 4 || u.pn == 5) ? qscale : 1.0f);
        if (u.pn < 4) {
#pragma unroll
            for (int ai = 0; ai < 2; ++ai)
#pragma unroll
                for (int m = 0; m < 4; ++m) { const int row = row0 + ai * HALF + m * 16; const float rs = rsv[ai][m];
                    f32x4 z0, z1;
#pragma unroll
                    for (int j = 0; j < 4; ++j) { z0[j] = (acc[ai][0][m][0][j] * rs) * fsigmoid(acc[ai][1][m][0][j] * rs); z1[j] = (acc[ai][0][m][1][j] * rs) * fsigmoid(acc[ai][1][m][1][j] * rs); }
                    *(u32x4*)(Z + (size_t)row * 512 + u.pn * 128 + cw) = pack8(z0, z1); __builtin_amdgcn_sched_barrier(0); }
        } else {
            const int t = (u.pn - 4) >> 1; bf16_t* dst = QKV + (size_t)t * qkv_stride;
            const int cb = ((u.pn - 4) & 1) * 256 + cw;
#pragma unroll
            for (int ai = 0; ai < 2; ++ai)
#pragma unroll
                for (int m = 0; m < 4; ++m) { const int row = row0 + ai * HALF + m * 16; const float rs = rsv[ai][m];
#pragma unroll
                    for (int bj = 0; bj < 2; ++bj) { const f32x4 v0 = acc[ai][bj][m][0] * rs, v1 = acc[ai][bj][m][1] * rs;
                        *(u32x4*)(dst + (size_t)row * 512 + cb + bj * HALF) = pack8(v0, v1); } __builtin_amdgcn_sched_barrier(0); }
        }
    }
};
__device__ __forceinline__ float irelu(float x) { const int i = __float_as_int(x); return __int_as_float(i > 0 ? i : 0); }
struct EpiUp {
    static constexpr bool PERM = true, AFTER_DRAIN = false, ADJ = true;
    bf16_t* H; const PG8_LAS float* rtab;
    static constexpr int FFT = 4096 / 64;
    __device__ __forceinline__ void operator()(const f32x4 (&acc)[2][2][4][2], const Unit& u, int wr, int wc, int fr, int fq) const {
        const int fo = (fr * 64 + fq * 16) ^ ((fr >> 3) << 5);
        float rsv[2][4]; row_scales(rsv, rtab, u, wr, fr, 1.0f);
#pragma unroll
        for (int ai = 0; ai < 2; ++ai)
#pragma unroll
            for (int m = 0; m < 4; ++m) { const float rs2 = rsv[ai][m] * rsv[ai][m];
                const f32x2 r2 = (f32x2){rs2, rs2};
#pragma unroll
                for (int bj = 0; bj < 2; ++bj) { f32x4 v0, v1;
#pragma unroll
                    for (int j = 0; j < 4; j += 2) {
                        const float x0 = acc[ai][bj][m][0][j], x1 = acc[ai][bj][m][0][j + 1], x2 = acc[ai][bj][m][1][j], x3 = acc[ai][bj][m][1][j + 1];
                        f32x2 a = (f32x2){irelu(x0), irelu(x1)}, b = (f32x2){irelu(x2), irelu(x3)};
                        a = (a * a) * r2; b = (b * b) * r2; v0[j] = a[0]; v0[j + 1] = a[1]; v1[j] = b[0]; v1[j + 1] = b[1]; }
                    *(u32x4*)((char*)H + ((((size_t)(u.pm * (FFT) + u.pn * 4 + wc) * 2 + ai) * 16 + (2 * (4 * wr + m) + bj)) << 10) + fo) = pack8(v0, v1); } __builtin_amdgcn_sched_barrier(0); }
    }
};
struct EpiInC {
    static constexpr bool PERM = true, AFTER_DRAIN = false, ADJ = true;
    bf16_t* GG; bf16_t* XR; const PG8_LAS float* rtab;
    __device__ __forceinline__ void operator()(const f32x4 (&acc)[2][2][4][2], const Unit& u, int wr, int wc, int fr, int fq) const {
        const int row0 = u.pm * BM + wr * 64 + fr, col0 = (u.pn & 3) * BM + wc * 64 + 8 * fq; const bool isg = u.pn < 4; bf16_t* dst = isg ? GG : XR;
        float rsv[2][4]; row_scales(rsv, rtab, u, wr, fr, 1.0f);
#pragma unroll
        for (int ai = 0; ai < 2; ++ai)
#pragma unroll
            for (int m = 0; m < 4; ++m) { const int row = row0 + ai * HALF + m * 16; const float rs = rsv[ai][m];
#pragma unroll
                for (int bj = 0; bj < 2; ++bj) { f32x4 v0 = acc[ai][bj][m][0] * rs, v1 = acc[ai][bj][m][1] * rs;
                    if (isg) {
                        const f32x2 c1 = (f32x2){-2.3022081983f, -2.3022081983f}, c2 = (f32x2){-0.10294324f, -0.10294324f}, one = (f32x2){1.0f, 1.0f};
#pragma unroll
                        for (int j = 0; j < 4; j += 2) {
                            f32x2 xa = (f32x2){v0[j], v0[j + 1]}, xb = (f32x2){v1[j], v1[j + 1]};
                            f32x2 ea = xa * (xa * xa * c2 + c1), eb = xb * (xb * xb * c2 + c1);
                            ea = (f32x2){__builtin_amdgcn_exp2f(ea[0]), __builtin_amdgcn_exp2f(ea[1])} + one; eb = (f32x2){__builtin_amdgcn_exp2f(eb[0]), __builtin_amdgcn_exp2f(eb[1])} + one;
                            xa = xa * (f32x2){__builtin_amdgcn_rcpf(ea[0]), __builtin_amdgcn_rcpf(ea[1])}; xb = xb * (f32x2){__builtin_amdgcn_rcpf(eb[0]), __builtin_amdgcn_rcpf(eb[1])};
                            v0[j] = xa[0]; v0[j + 1] = xa[1]; v1[j] = xb[0]; v1[j + 1] = xb[1]; } }
                    *(u32x4*)(dst + (size_t)row * 1024 + col0 + bj * 32) = pack8(v0, v1); } __builtin_amdgcn_sched_barrier(0); }
    }
};
__device__ __forceinline__ f32x4 bf4(unsigned a, unsigned b) { return (f32x4){__uint_as_float(a << 16), __uint_as_float(a & 0xffff0000u), __uint_as_float(b << 16), __uint_as_float(b & 0xffff0000u)}; }
struct EpiResB {
    static constexpr bool PERM = true, AFTER_DRAIN = false, ADJ = true;
    bf16_t* X; float* outf; float* ssout;
    __device__ __forceinline__ void operator()(const f32x4 (&acc)[2][2][4][2], const Unit& u, int wr, int wc, int fr, int fq) const {
        const int row0 = u.pm * BM + wr * 64 + fr;
        const int fo = (fr * 64 + fq * 16) ^ ((fr >> 3) << 5);
        char* xb = (char*)X + (((size_t)(u.pm * 16 + u.pn * 4 + wc) * 2) << 14) + fo;
        u32x4 raw[2][4][2];
#pragma unroll
        for (int ai = 0; ai < 2; ++ai)
#pragma unroll
            for (int m = 0; m < 4; ++m)
#pragma unroll
                for (int bj = 0; bj < 2; ++bj) raw[ai][m][bj] = *(const u32x4*)(xb + ((ai * 16 + 2 * (4 * wr + m) + bj) << 10));
#pragma unroll
        for (int ai = 0; ai < 2; ++ai)
#pragma unroll
            for (int m = 0; m < 4; ++m) { const int row = row0 + ai * HALF + m * 16; float sq = 0.f;
                f32x2 sq2 = (f32x2){0.f, 0.f};
#pragma unroll
                for (int bj = 0; bj < 2; ++bj) { const u32x4 rw = raw[ai][m][bj];
                    const f32x4 x0 = bf4(rw.x, rw.y) + acc[ai][bj][m][0], x1 = bf4(rw.z, rw.w) + acc[ai][bj][m][1];
                    const f32x2 a0 = (f32x2){x0[0], x0[1]}, a1 = (f32x2){x0[2], x0[3]}, a2 = (f32x2){x1[0], x1[1]}, a3 = (f32x2){x1[2], x1[3]};
                    sq2 = a0 * a0 + sq2; sq2 = a1 * a1 + sq2; sq2 = a2 * a2 + sq2; sq2 = a3 * a3 + sq2;
                    *(u32x4*)(xb + ((ai * 16 + 2 * (4 * wr + m) + bj) << 10)) = pack8(x0, x1); }
                sq = sq2[0] + sq2[1];
                { const auto r16 = __builtin_amdgcn_permlane16_swap(__float_as_uint(sq), __float_as_uint(sq), false, false); sq = __uint_as_float(r16[0]) + __uint_as_float(r16[1]);
                  const auto r32 = __builtin_amdgcn_permlane32_swap(__float_as_uint(sq), __float_as_uint(sq), false, false); sq = __uint_as_float(r32[0]) + __uint_as_float(r32[1]); }
                if (fq == 0) ssout[(size_t)row * 16 + u.pn * 4 + wc] = sq;
                __builtin_amdgcn_sched_barrier(0); }
    }
};

template <class Epi, class Sched, bool ALIGN_EPI = false, bool SP2 = false>
__device__ __forceinline__ void gemm_phase(PG8_LAS unsigned char* lds, const Gemm g, const Sched& S, const Epi& E, const int wid, const float* ssfill = nullptr) {
    const int lane = (int)__builtin_amdgcn_mbcnt_hi(~0u, __builtin_amdgcn_mbcnt_lo(~0u, 0u)), tid = wid * 64 + lane, wr = wid >> 2, wc = wid & 3, fr = lane & 15, fq = lane >> 4;
    const int K = g.K, nt = K / BK, lda = g.lda ? g.lda : K;
    unsigned voffA[2], voffB[2];
#pragma unroll
    for (int i = 0; i < 2; ++i) { int R, C; stage_rc(tid * 16 + i * 8192, R, C);
        const int Rb = Epi::ADJ ? ((R >> 5) * 64 + perm32(R & 31)) : Epi::PERM ? ((R & ~31) + perm32(R & 31)) : R;
        voffA[i] = g.afrag ? (unsigned)((wid + 8 * i) * 1024 + lane * 16) : (unsigned)(R * lda + C) * 2u; voffB[i] = (unsigned)(Rb * K + C) * 2u; }
    const size_t kstep = (size_t)(BK * 2);
    const size_t hstep = (size_t)HALF * K * 2;
    const size_t bhstep = Epi::ADJ ? (size_t)32 * K * 2 : hstep;
    const size_t tstep = 2 * hstep;
    const bool afrag = g.afrag != 0;
    const size_t ahstep = afrag ? (size_t)HTB : (size_t)HALF * lda * 2, akstep = afrag ? (size_t)(2 * HTB) : kstep, atstep = afrag ? (size_t)(K / BK) * 2 * HTB : 2 * (size_t)HALF * lda * 2;
    const unsigned ldsw = (unsigned)wid * 1024u;
    const int aoff = lds_byte(wr * 64 + fr, fq * 8), boff = lds_byte(wc * 32 + fr, fq * 8);
#define PG8_SA(b, h) (((b) * 2 + (h)) * HTB)
#define PG8_SB(b, h) ((4 + (b) * 2 + (h)) * HTB)
#define PG8_STAGE(bufoff, gbase, voff) do { _Pragma("unroll") for (int _i = 0; _i < 2; ++_i) \
        __builtin_amdgcn_global_load_lds((const unsigned*)((const char*)(gbase) + (voff)[_i]), (PG8_LAS unsigned*)(lds + (bufoff) + ldsw + _i * 8192), 16, 0, 0); } while (0)
#define PG8_LDA(dst, b, h) do { _Pragma("unroll") for (int m = 0; m < 4; ++m) _Pragma("unroll") for (int k = 0; k < 2; ++k) dst[m][k] = *(const PG8_LAS bf16x8*)(lds + PG8_SA(b, h) + aoff + m * 2048 + k * 1024); } while (0)
#define PG8_LDB(dst, b, h) do { _Pragma("unroll") for (int n = 0; n < 2; ++n) _Pragma("unroll") for (int k = 0; k < 2; ++k) dst[n][k] = *(const PG8_LAS bf16x8*)(lds + PG8_SB(b, h) + boff + n * 2048 + k * 1024); } while (0)
#define PG8_MMA(ai, bj, At, Bt) do { __builtin_amdgcn_s_setprio(1); _Pragma("unroll") for (int m = 0; m < 4; ++m) _Pragma("unroll") for (int n = 0; n < 2; ++n) _Pragma("unroll") for (int k = 0; k < 2; ++k) \
        acc[ai][bj][m][n] = __builtin_amdgcn_mfma_f32_16x16x32_bf16(Bt[n][k], At[m][k], acc[ai][bj][m][n], 0, 0, 0); __builtin_amdgcn_s_setprio(0); } while (0)
#define PG8_WAIT_V(n) asm volatile("s_waitcnt vmcnt(" #n ")" ::: "memory")
#define PG8_WAIT_L(n) asm volatile("s_waitcnt lgkmcnt(" #n ")" ::: "memory")
#define PG8_BAR __builtin_amdgcn_s_barrier()
#define PG8_SCHED __builtin_amdgcn_sched_barrier(0)
    Unit cur, nxt; int ui = 0;
    if (!S.next(0, cur)) return;
    f32x4 acc[2][2][4][2];
#pragma unroll
    for (int a = 0; a < 2; ++a)
#pragma unroll
        for (int b = 0; b < 2; ++b)
#pragma unroll
            for (int m = 0; m < 4; ++m)
#pragma unroll
                for (int n = 0; n < 2; ++n) acc[a][b][m][n] = (f32x4){0.f, 0.f, 0.f, 0.f};
    bf16x8 At[4][2], B0[2][2], B1[2][2];
    const char* cA = (const char*)g.A + (size_t)cur.pm * atstep; const char* cB = (const char*)g.Bt + (size_t)cur.pn * tstep;
    S.a_ready(cur);
    if constexpr (SP2) {
        PG8_STAGE(PG8_SB(0, 0), cB, voffB); PG8_STAGE(PG8_SB(0, 1), cB + bhstep, voffB); PG8_STAGE(PG8_SA(0, 0), cA, voffA); PG8_STAGE(PG8_SA(0, 1), cA + ahstep, voffA);
        if (ssfill) rtab_fill(S, ssfill, (PG8_LAS float*)(lds + RTAB_OFF), wid);
        if (wr == 1) PG8_BAR;
        PG8_WAIT_V(2); PG8_BAR;
        PG8_STAGE(PG8_SB(1, 0), cB + kstep, voffB); PG8_STAGE(PG8_SA(1, 0), cA + akstep, voffA); PG8_STAGE(PG8_SB(1, 1), cB + bhstep + kstep, voffB);
        PG8_WAIT_V(6); PG8_BAR;
    } else {
        PG8_STAGE(PG8_SB(0, 0), cB, voffB); PG8_STAGE(PG8_SA(0, 0), cA, voffA); PG8_STAGE(PG8_SB(0, 1), cB + bhstep, voffB); PG8_STAGE(PG8_SA(0, 1), cA + ahstep, voffA);
        if (wr == 1) PG8_BAR;
        PG8_WAIT_V(4); PG8_BAR;
        PG8_STAGE(PG8_SB(1, 0), cB + kstep, voffB); PG8_STAGE(PG8_SA(1, 0), cA + akstep, voffA); PG8_STAGE(PG8_SB(1, 1), cB + bhstep + kstep, voffB);
        PG8_WAIT_V(6); PG8_BAR;
    }
    for (;;) {
        const bool has_next = S.next(ui + 1, nxt);
        const char* nA = has_next ? (const char*)g.A + (size_t)nxt.pm * atstep : cA; const char* nB = has_next ? (const char*)g.Bt + (size_t)nxt.pn * tstep : cB;
        for (int t = 0; t < nt; t += 2) {
            const bool last = (t == nt - 2);
            const char* a1 = cA + (size_t)(t + 1) * akstep;
            const char* a2 = last ? nA : cA + (size_t)(t + 2) * akstep; const char* b2 = last ? nB : cB + (size_t)(t + 2) * kstep;
            const char* a3 = a2 + akstep; const char* b3 = b2 + kstep;
            if (last && has_next) S.a_ready(nxt);
            if constexpr (SP2) {
            PG8_LDB(B0, 0, 0); PG8_LDB(B1, 0, 1); PG8_SCHED; PG8_LDA(At, 0, 0); PG8_STAGE(PG8_SA(1, 1), a1 + ahstep, voffA);
            PG8_WAIT_V(8); PG8_WAIT_L(0); PG8_BAR; PG8_MMA(0, 0, At, B0); PG8_MMA(0, 1, At, B1); PG8_BAR; PG8_SCHED;
            PG8_LDA(At, 0, 1); PG8_STAGE(PG8_SB(0, 0), b2, voffB); PG8_STAGE(PG8_SB(0, 1), b2 + bhstep, voffB); PG8_STAGE(PG8_SA(0, 0), a2, voffA);
            PG8_WAIT_V(8); PG8_WAIT_L(0); PG8_BAR; PG8_MMA(1, 0, At, B0); PG8_MMA(1, 1, At, B1); PG8_BAR; PG8_SCHED;
            PG8_LDB(B0, 1, 0); PG8_LDB(B1, 1, 1); PG8_SCHED; PG8_LDA(At, 1, 0); PG8_STAGE(PG8_SA(0, 1), a2 + ahstep, voffA);
            PG8_WAIT_V(8); PG8_WAIT_L(0); PG8_BAR; PG8_MMA(0, 0, At, B0); PG8_MMA(0, 1, At, B1); PG8_BAR; PG8_SCHED;
            PG8_LDA(At, 1, 1); PG8_STAGE(PG8_SB(1, 0), b3, voffB); PG8_STAGE(PG8_SB(1, 1), b3 + bhstep, voffB); PG8_STAGE(PG8_SA(1, 0), a3, voffA);
            PG8_WAIT_V(8); PG8_WAIT_L(0); PG8_BAR; PG8_MMA(1, 0, At, B0); PG8_MMA(1, 1, At, B1); PG8_BAR; PG8_SCHED;
            } else {
            PG8_LDB(B0, 0, 0); PG8_SCHED; PG8_LDA(At, 0, 0); PG8_STAGE(PG8_SA(1, 1), a1 + ahstep, voffA);
            PG8_WAIT_L(8); PG8_BAR; PG8_WAIT_L(0); PG8_MMA(0, 0, At, B0); PG8_BAR; PG8_SCHED;
            PG8_LDB(B1, 0, 1); PG8_STAGE(PG8_SB(0, 0), b2, voffB);
            PG8_BAR; PG8_WAIT_L(0); PG8_MMA(0, 1, At, B1); PG8_BAR;
            PG8_LDA(At, 0, 1); PG8_STAGE(PG8_SA(0, 0), a2, voffA);
            PG8_BAR; PG8_WAIT_L(0); PG8_MMA(1, 0, At, B0); PG8_BAR; PG8_SCHED;
            PG8_STAGE(PG8_SB(0, 1), b2 + bhstep, voffB);
            PG8_WAIT_V(6); PG8_BAR; PG8_MMA(1, 1, At, B1); PG8_BAR;
            PG8_LDB(B0, 1, 0); PG8_SCHED; PG8_LDA(At, 1, 0); PG8_STAGE(PG8_SA(0, 1), a2 + ahstep, voffA);
            PG8_WAIT_L(8); PG8_BAR; PG8_WAIT_L(0); PG8_MMA(0, 0, At, B0); PG8_BAR; PG8_SCHED;
            PG8_LDB(B1, 1, 1); PG8_STAGE(PG8_SB(1, 0), b3, voffB);
            PG8_BAR; PG8_WAIT_L(0); PG8_MMA(0, 1, At, B1); PG8_BAR;
            PG8_LDA(At, 1, 1); PG8_STAGE(PG8_SA(1, 0), a3, voffA);
            PG8_BAR; PG8_WAIT_L(0); PG8_MMA(1, 0, At, B0); PG8_BAR; PG8_SCHED;
            PG8_STAGE(PG8_SB(1, 1), b3 + bhstep, voffB);
            PG8_WAIT_V(6); PG8_BAR; PG8_MMA(1, 1, At, B1); PG8_BAR;
            }
        }
        if constexpr (ALIGN_EPI) { if (wr == 0) PG8_BAR; }
        if constexpr (!Epi::AFTER_DRAIN) { E(acc, cur, wr, wc, fr, fq); S.done(cur); }
        if (!has_next) break;
#pragma unroll
        for (int a = 0; a < 2; ++a)
#pragma unroll
            for (int b = 0; b < 2; ++b)
#pragma unroll
                for (int m = 0; m < 4; ++m)
#pragma unroll
                    for (int n = 0; n < 2; ++n) acc[a][b][m][n] = (f32x4){0.f, 0.f, 0.f, 0.f};
        cur = nxt; cA = nA; cB = nB; ++ui;
        if constexpr (ALIGN_EPI) { if (wr == 1) PG8_BAR; }
    }
    PG8_WAIT_V(0);
    if constexpr (!ALIGN_EPI) { if (wr == 0) PG8_BAR; }
    PG8_BAR;
    if constexpr (Epi::AFTER_DRAIN) { E.fused(acc, cur, wr, wc, fr, fq, lds, wid, lane); S.done(cur); }
#undef PG8_SA
#undef PG8_SB
#undef PG8_STAGE
#undef PG8_LDA
#undef PG8_LDB
#undef PG8_MMA
#undef PG8_WAIT_V
#undef PG8_WAIT_L
#undef PG8_BAR
#undef PG8_SCHED
}
}
namespace mo {
using bf16x8=__attribute__((ext_vector_type(8)))short;
using s16x4=__attribute__((ext_vector_type(4)))short;
using f32x16=__attribute__((ext_vector_type(16)))float;
using u32x4=__attribute__((ext_vector_type(4)))unsigned;
typedef unsigned short bf16;
constexpr int NHEAD=8,SEQ=2048,D=64,DM=NHEAD*D,OPITCH=1024,OCOL0=512;
constexpr int NW=8,QBLK=32,QB=QBLK*NW,KVBLK=64;
__device__ __forceinline__ int crow(int r,int hi){return (r&3)+8*(r>>2)+4*hi;}
#define MO_LAS __attribute__((address_space(3)))
constexpr int SLOTB=8192;
constexpr int LDS_K=0, LDS_V=2*SLOTB, LDS_WS=5*SLOTB, LDS_OST=LDS_WS+NW*64*4, LDS_KB=LDS_OST+NW*4096, LDS_BYTES=LDS_KB+2048+64;
constexpr float C2=0.125f*1.4426950408889634f;
__device__ __forceinline__ void glds16(const void*gsrc,unsigned lds_dst){unsigned keep;
  asm volatile("s_mov_b32 %0, m0\n\ts_mov_b32 m0, %2\n\ts_nop 0\n\tglobal_load_lds_dwordx4 %1, off\n\ts_mov_b32 m0, %0":"=&s"(keep):"v"(gsrc),"s"(lds_dst):"memory");}
typedef float f32x2_t __attribute__((ext_vector_type(2))); typedef __bf16 bf16x2_t __attribute__((ext_vector_type(2)));
__device__ __forceinline__ unsigned cvtpk_s(float lo,float hi){f32x2_t v={lo,hi};bf16x2_t b=__builtin_convertvector(v,bf16x2_t);return __builtin_bit_cast(unsigned,b);}
#define MO_WAIT_BAR(N) asm volatile("s_waitcnt vmcnt(" #N ") lgkmcnt(0)\n\ts_barrier":::"memory")
#define MO_MX3(a,b,c) __builtin_fmaxf(__builtin_fmaxf((a),(b)),(c))
__device__ __forceinline__ void qkt(f32x16&p0,f32x16&p1,const MO_LAS char*Kslot,const bf16x8*qr,const f32x16&z,int r32,int hi){
  const MO_LAS char*kb=Kslot+hi*1024+r32*16;
  bf16x8 kf[8];
  #pragma unroll
  for(int i=0;i<8;++i)kf[i]=*(const MO_LAS bf16x8*)(kb+(i>>1)*2048+(i&1)*512);
  __builtin_amdgcn_sched_barrier(0);
  p0=__builtin_amdgcn_mfma_f32_32x32x16_bf16(kf[0],qr[0],z,0,0,0);p1=__builtin_amdgcn_mfma_f32_32x32x16_bf16(kf[1],qr[0],z,0,0,0);
  #pragma unroll
  for(int d0=1;d0<4;++d0){p0=__builtin_amdgcn_mfma_f32_32x32x16_bf16(kf[2*d0],qr[d0],p0,0,0,0);p1=__builtin_amdgcn_mfma_f32_32x32x16_bf16(kf[2*d0+1],qr[d0],p1,0,0,0);}
}
__device__ __forceinline__ float rowmax(const f32x16&p0,const f32x16&p1,float c1){
  float a=MO_MX3(p0[0],p0[1],p0[2]),b=MO_MX3(p1[0],p1[1],p1[2]);
  #pragma unroll
  for(int r=3;r<15;r+=2){a=MO_MX3(a,p0[r],p0[r+1]);b=MO_MX3(b,p1[r],p1[r+1]);}
  a=__builtin_fmaxf(a,p0[15]);b=__builtin_fmaxf(b,p1[15]);
  float m=__builtin_fmaxf(a,b+c1);
  auto rr=__builtin_amdgcn_permlane32_swap(__float_as_uint(m),__float_as_uint(m),false,false);
  return __builtin_fmaxf(__uint_as_float(rr[0]),__uint_as_float(rr[1]));
}
__device__ __forceinline__ void pv(f32x16*o,int vb,bf16x8 pa0,bf16x8 pa1,bf16x8 pa2,bf16x8 pa3){
  #pragma unroll
  for(int d0=0;d0<2;++d0){s16x4 lo[4],hi[4];
    #pragma unroll
    for(int ks=0;ks<4;++ks){
      asm volatile("ds_read_b64_tr_b16 %0,%1 offset:%c2":"=&v"(lo[ks]):"v"(vb),"i"(d0*4096+ks*1024):"memory");
      asm volatile("ds_read_b64_tr_b16 %0,%1 offset:%c2":"=&v"(hi[ks]):"v"(vb),"i"(d0*4096+ks*1024+512):"memory");}
    asm volatile("s_waitcnt lgkmcnt(0)":::"memory");__builtin_amdgcn_sched_barrier(0);
    #define MO_PK(k) (bf16x8){lo[k][0],lo[k][1],lo[k][2],lo[k][3],hi[k][0],hi[k][1],hi[k][2],hi[k][3]}
    o[d0]=__builtin_amdgcn_mfma_f32_32x32x16_bf16(pa0,MO_PK(0),o[d0],0,0,0);
    o[d0]=__builtin_amdgcn_mfma_f32_32x32x16_bf16(pa1,MO_PK(1),o[d0],0,0,0);
    o[d0]=__builtin_amdgcn_mfma_f32_32x32x16_bf16(pa2,MO_PK(2),o[d0],0,0,0);
    o[d0]=__builtin_amdgcn_mfma_f32_32x32x16_bf16(pa3,MO_PK(3),o[d0],0,0,0);
    #undef MO_PK
  }
}
typedef short v4i16_t __attribute__((ext_vector_type(4)));
__device__ __forceinline__ s16x4 vtr(const MO_LAS char*p){ return __builtin_bit_cast(s16x4,__builtin_amdgcn_ds_read_tr16_b64_v4i16((MO_LAS v4i16_t*)p)); }
__device__ __forceinline__ float bf2f(short s){ return __uint_as_float(((unsigned)(unsigned short)s)<<16); }

__device__ __forceinline__ void moba_kbar(int b,int h,const bf16*K,MO_LAS char*shm,const int wid){
  const int lane=(int)__builtin_amdgcn_mbcnt_hi(~0u,__builtin_amdgcn_mbcnt_lo(~0u,0u));
  MO_LAS float*kbl=(MO_LAS float*)(shm+LDS_KB);
  {
    const bf16*kp=K+((long)b*SEQ+wid*256+(lane>>3))*DM+h*D+(lane&7)*8;
    float sm[8]; float n2max=0.f;
    #pragma unroll
    for(int e=0;e<8;++e)sm[e]=0.f;
    #pragma unroll 1
    for(int i0=0;i0<32;i0+=8){ bf16x8 kv[8]; float ps[8];
      #pragma unroll
      for(int i=0;i<8;++i)kv[i]=*reinterpret_cast<const bf16x8*>(kp+(long)(i0+i)*8*DM);
      #pragma unroll
      for(int i=0;i<8;++i){ ps[i]=0.f;
        #pragma unroll
        for(int e=0;e<8;++e){const float x=bf2f(kv[i][e]); sm[e]+=x; ps[i]=__builtin_fmaf(x,x,ps[i]);} }
      #pragma unroll
      for(int o=1;o<8;o<<=1)
        #pragma unroll
        for(int i=0;i<8;++i)ps[i]+=__shfl_xor(ps[i],o);
      #pragma unroll
      for(int i=0;i<8;++i)n2max=__builtin_fmaxf(n2max,ps[i]); }
    #pragma unroll
    for(int e=0;e<8;++e){ sm[e]+=__shfl_xor(sm[e],8); sm[e]+=__shfl_xor(sm[e],16); sm[e]+=__shfl_xor(sm[e],32); }
    n2max=__builtin_fmaxf(n2max,__shfl_xor(n2max,8)); n2max=__builtin_fmaxf(n2max,__shfl_xor(n2max,16)); n2max=__builtin_fmaxf(n2max,__shfl_xor(n2max,32));
    if(lane<8){
      #pragma unroll
      for(int e=0;e<8;++e)kbl[wid*64+lane*8+e]=sm[e]*(1.0f/256.0f); }
    if(lane==0)kbl[512+wid]=n2max;
  }
  asm volatile("s_waitcnt vmcnt(0) lgkmcnt(0)\n\ts_barrier":::"memory");
}
__device__ __forceinline__ void moba_unit(int b,int h,int j,const bf16*Q,const bf16*K,const bf16*V,bf16*Y,MO_LAS char*shm,const int wid,const bool first,const bool has_next){
  const int lane=(int)__builtin_amdgcn_mbcnt_hi(~0u,__builtin_amdgcn_mbcnt_lo(~0u,0u)),tid=wid*64+lane,r32=lane&31,hi=lane>>5;
  const long rowbase=(long)b*SEQ; const int q0=j*QB;
  const bf16*Qw=Q+(rowbase+q0+wid*QBLK)*DM+h*D;
  const bf16*Kh=K+rowbase*DM+h*D,*Vh=V+rowbase*DM+h*D;
  const unsigned lds0=(unsigned)(uintptr_t)shm;
  MO_LAS float*wsf=(MO_LAS float*)(shm+LDS_WS)+wid*64;
  const bf16*ksrc=Kh+(long)lane*DM+wid*8;
  const bf16*vsrc=Vh+(long)(16*(wid&3)+(lane>>2))*DM+(wid>>2)*32+(lane&3)*8;
  const unsigned kdst=lds0+LDS_K+wid*1024, vdst=lds0+LDS_V+wid*1024;
  #define MO_DMA_K(t,slot) glds16(ksrc+(long)(t)*KVBLK*DM,(unsigned)__builtin_amdgcn_readfirstlane(kdst+(slot)))
  #define MO_DMA_V(t,slot) glds16(vsrc+(long)(t)*KVBLK*DM,(unsigned)__builtin_amdgcn_readfirstlane(vdst+(slot)))
  const int vb0=(int)(lds0+LDS_V)+((lane>>4)&1)*32+(lane&3)*8+(4*hi+((lane&15)>>2))*64;
  const MO_LAS char*Kbase=shm+LDS_K;
  const MO_LAS char*vp0=shm+LDS_V+((lane>>4)&1)*32+(lane&3)*8+(4*hi+((lane&15)>>2))*64;
  const int NT=4*(j+1);
  if(first){MO_DMA_K(0,0);} MO_DMA_V(0,0);
  bf16x8 qr[4];
  #pragma unroll
  for(int d0=0;d0<4;++d0)qr[d0]=*reinterpret_cast<const bf16x8*>(&Qw[(long)r32*DM+d0*16+hi*8]);
  unsigned selmask=0xFFu;
  if(j>=4){
    const MO_LAS float*kbl=(const MO_LAS float*)(shm+LDS_KB);
    float g[7];
    #pragma unroll
    for(int n=0;n<7;++n){ g[n]=-INFINITY;
      if(n<j){ float s=0.f;
        #pragma unroll
        for(int d0=0;d0<4;++d0)
          #pragma unroll
          for(int e=0;e<8;++e)s+=bf2f(qr[d0][e])*kbl[n*64+d0*16+hi*8+e];
        s+=__shfl_xor(s,32); g[n]=s; }
      __builtin_amdgcn_sched_barrier(0); }
    selmask=0u;
    #pragma unroll
    for(int s=0;s<3;++s){ float best=-INFINITY; int bi=-1;
      #pragma unroll
      for(int n=0;n<7;++n) if(g[n]>best){best=g[n];bi=n;}
      #pragma unroll
      for(int n=0;n<7;++n) if(n==bi)g[n]=-INFINITY;
      if(bi>=0)selmask|=(1u<<bi); }
#ifdef MO_SELDBG
    if(hi==0)((unsigned*)((char*)Q+((size_t)300<<20)))[(size_t)(b*8+h)*2048+q0+wid*QBLK+r32]=selmask;
#endif
  }
  const float slope2=__builtin_amdgcn_exp2f(-(float)(h+1))*1.4426950408889634f;
  const int qrel=wid*QBLK+r32, tq=q0+qrel;
  float ref;
  { float qn2=0.f;
    #pragma unroll
    for(int d0=0;d0<4;++d0)
      #pragma unroll
      for(int e=0;e<8;++e){const float x=bf2f(qr[d0][e]); qn2=__builtin_fmaf(x,x,qn2);}
    qn2+=__shfl_xor(qn2,32);
    const MO_LAS float*kn2=(const MO_LAS float*)(shm+LDS_KB)+512; float k2=kn2[0];
    #pragma unroll
    for(int n=1;n<8;++n)k2=__builtin_fmaxf(k2,kn2[n]);
    ref=__builtin_sqrtf(qn2*k2)-16.0f; }
  float l_run=0.f;f32x16 o[2];o[0]=f32x16{};o[1]=f32x16{};
  f32x16 cinit;
  #pragma unroll
  for(int r=0;r<16;++r)cinit[r]=slope2*(float)((r&3)+8*(r>>2)+4*hi);
  asm volatile("":"+v"(cinit));
  const float c32=32.0f*slope2;
  asm volatile(""::"v"(qr[0]),"v"(qr[1]),"v"(qr[2]),"v"(qr[3]));
  f32x16 pA0,pA1,pB0,pB1; u32x4 pw0,pw1,pw2,pw3;
  int vsP=0,vsC=0,vsN=SLOTB;
  #define MO_STEP(PC0,PC1,PP0,PP1,HASC,HASP,tt) do{ const int t_=(tt); \
    if(HASC){ const int ks_=(t_&1)*SLOTB; \
      MO_WAIT_BAR(0);                                         \
      if(t_+1<NT){MO_DMA_K(t_+1,ks_^SLOTB);MO_DMA_V(t_+1,vsN);} else if(has_next){MO_DMA_K(0,0);} \
      bf16x8 kf_[8]; const MO_LAS char*kb_=Kbase+ks_+hi*1024+r32*16; _Pragma("unroll") for(int i=0;i<3;++i)kf_[i]=*(const MO_LAS bf16x8*)(kb_+(i>>1)*2048+(i&1)*512);     \
      __builtin_amdgcn_sched_barrier(0); \
      float sacc_=0.f; \
      _Pragma("unroll") for(int g=0;g<8;++g){ if(g+3<8)kf_[g+3]=*(const MO_LAS bf16x8*)(kb_+((g+3)>>1)*2048+((g+3)&1)*512); \
        if(HASP){ const int e_=4*(g&3); float x0_,x1_,x2_,x3_; if(g<4){x0_=PP0[e_];x1_=PP0[e_+1];x2_=PP0[e_+2];x3_=PP0[e_+3];}else{x0_=PP1[e_];x1_=PP1[e_+1];x2_=PP1[e_+2];x3_=PP1[e_+3];} \
          sacc_+=(x0_+x1_)+(x2_+x3_); const unsigned w0_=cvtpk_s(x0_,x1_),w1_=cvtpk_s(x2_,x3_); \
          if((g>>1)==0){pw0[(g&1)*2]=w0_;pw0[(g&1)*2+1]=w1_;} else if((g>>1)==1){pw1[(g&1)*2]=w0_;pw1[(g&1)*2+1]=w1_;} else if((g>>1)==2){pw2[(g&1)*2]=w0_;pw2[(g&1)*2+1]=w1_;} else {pw3[(g&1)*2]=w0_;pw3[(g&1)*2+1]=w1_;} \
          asm volatile("":"+v"(sacc_)); } \
        if((g&1)==0) PC0=__builtin_amdgcn_mfma_f32_32x32x16_bf16(kf_[g],qr[g>>1],(g<2)?cinit:PC0,0,0,0); else PC1=__builtin_amdgcn_mfma_f32_32x32x16_bf16(kf_[g],qr[g>>1],(g<2)?cinit:PC1,0,0,0); \
        __builtin_amdgcn_sched_barrier(0); } \
      if(HASP){ asm volatile("":"+v"(pw0),"+v"(pw1),"+v"(pw2),"+v"(pw3)); l_run+=sacc_; } \
    } else if(HASP){ float sacc_=0.f;                          \
      _Pragma("unroll") for(int r=0;r<16;++r)sacc_+=PP0[r]+PP1[r]; l_run+=sacc_; \
      pw0=(u32x4){cvtpk_s(PP0[0],PP0[1]),cvtpk_s(PP0[2],PP0[3]),cvtpk_s(PP0[4],PP0[5]),cvtpk_s(PP0[6],PP0[7])}; pw1=(u32x4){cvtpk_s(PP0[8],PP0[9]),cvtpk_s(PP0[10],PP0[11]),cvtpk_s(PP0[12],PP0[13]),cvtpk_s(PP0[14],PP0[15])}; \
      pw2=(u32x4){cvtpk_s(PP1[0],PP1[1]),cvtpk_s(PP1[2],PP1[3]),cvtpk_s(PP1[4],PP1[5]),cvtpk_s(PP1[6],PP1[7])}; pw3=(u32x4){cvtpk_s(PP1[8],PP1[9]),cvtpk_s(PP1[10],PP1[11]),cvtpk_s(PP1[12],PP1[13]),cvtpk_s(PP1[14],PP1[15])}; } \
    float kk_=0.f,kk1_=0.f; \
    if(HASC){ const float sb_=slope2*(float)(64*t_-tq);        \
      bool dead_=false; \
      if(t_>=NT-4){ asm volatile("; band tile":::"memory"); const int kb2_=64*(t_-(NT-4))+4*hi; \
        _Pragma("unroll") for(int r=0;r<16;++r){const int kv_=kb2_+(r&3)+8*(r>>2); if(kv_>qrel)PC0[r]=-INFINITY; if(kv_+32>qrel)PC1[r]=-INFINITY;} } \
      else dead_=((selmask>>(t_>>2))&1u)==0u; \
      kk_=dead_?INFINITY:(ref-sb_); kk1_=kk_-c32; }              \
    __builtin_amdgcn_sched_barrier(0); \
    { const MO_LAS char*vp_=vp0+vsP; s16x4 vl_[8],vh_[8]; \
      if(HASP){ vl_[0]=vtr(vp_);vh_[0]=vtr(vp_+512);vl_[1]=vtr(vp_+1024);vh_[1]=vtr(vp_+1024+512); } \
      _Pragma("unroll") for(int g=0;g<8;++g){ \
        if(HASP){ if(g+2<8){ vl_[g+2]=vtr(vp_+((g+2)>>2)*4096+((g+2)&3)*1024); vh_[g+2]=vtr(vp_+((g+2)>>2)*4096+((g+2)&3)*1024+512); } \
          const bf16x8 vf_=(bf16x8){vl_[g][0],vl_[g][1],vl_[g][2],vl_[g][3],vh_[g][0],vh_[g][1],vh_[g][2],vh_[g][3]}; \
          const u32x4 pw_=((g&3)==0)?pw0:((g&3)==1)?pw1:((g&3)==2)?pw2:pw3; \
          if(g<4) o[0]=__builtin_amdgcn_mfma_f32_32x32x16_bf16(__builtin_bit_cast(bf16x8,pw_),vf_,o[0],0,0,0); else o[1]=__builtin_amdgcn_mfma_f32_32x32x16_bf16(__builtin_bit_cast(bf16x8,pw_),vf_,o[1],0,0,0); } \
        if(HASC){ const int e_=4*(g&3); \
          if(g<4){ _Pragma("unroll") for(int q=0;q<4;++q)PC0[e_+q]=__builtin_amdgcn_exp2f(PC0[e_+q]-kk_); } else { _Pragma("unroll") for(int q=0;q<4;++q)PC1[e_+q]=__builtin_amdgcn_exp2f(PC1[e_+q]-kk1_); } } \
        __builtin_amdgcn_sched_barrier(0); } \
      if(HASC){ asm volatile("":"+v"(PC0),"+v"(PC1)); } } \
    vsP=vsC; vsC=vsN; vsN=(vsN==2*SLOTB)?0:vsN+SLOTB; \
  }while(0)
  MO_STEP(pA0,pA1,pB0,pB1,1,0,0);
  #pragma unroll 1
  for(int t=1;t<NT-1;t+=2){ MO_STEP(pB0,pB1,pA0,pA1,1,1,t); MO_STEP(pA0,pA1,pB0,pB1,1,1,t+1); }
  MO_STEP(pB0,pB1,pA0,pA1,1,1,NT-1);
  MO_STEP(pA0,pA1,pB0,pB1,0,1,NT);
  #undef MO_STEP
  {auto rr=__builtin_amdgcn_permlane32_swap(__float_as_uint(l_run),__float_as_uint(l_run),false,false);l_run=__uint_as_float(rr[0])+__uint_as_float(rr[1]);}
  if(hi==0)wsf[32+r32]=l_run;asm volatile("s_waitcnt lgkmcnt(0)":::"memory");
  float rli[16];
  #pragma unroll
  for(int r=0;r<16;++r)rli[r]=__builtin_amdgcn_rcpf(wsf[32+crow(r,hi)]);
  bf16*Ow=Y+(rowbase+q0+wid*QBLK)*OPITCH+OCOL0+h*D;
  { MO_LAS bf16*stg=(MO_LAS bf16*)(shm+LDS_OST)+wid*2048;
    #pragma unroll
    for(int r=0;r<16;++r){const int orow=crow(r,hi);
      #pragma unroll
      for(int d0=0;d0<2;++d0){ const float v=o[d0][r]*rli[r]; stg[orow*64+d0*32+r32]=(bf16)(cvtpk_s(v,v)&0xffffu); } }
    asm volatile("s_waitcnt lgkmcnt(0)":::"memory");
    #pragma unroll
    for(int i=0;i<4;++i){const int row=i*8+(lane>>3),ch=lane&7; const u32x4 v=*(const MO_LAS u32x4*)(stg+row*64+ch*8); *(u32x4*)(Ow+(long)row*OPITCH+ch*8)=v;} }
  asm volatile("s_waitcnt lgkmcnt(0)\n\ts_barrier":::"memory");
  #undef MO_DMA_K
  #undef MO_DMA_V
}
}

#define GAS __attribute__((address_space(1)))
#define LAS __attribute__((address_space(3)))
typedef unsigned short bf16;
typedef unsigned v4u __attribute__((ext_vector_type(4)));
typedef float f32x4 __attribute__((ext_vector_type(4)));
typedef short bf16x8 __attribute__((ext_vector_type(8)));
typedef GAS unsigned gu32;
typedef GAS unsigned long long gu64;
#define RLX_AGENT __ATOMIC_RELAXED, __HIP_MEMORY_SCOPE_AGENT
#define LDS_WAIT() asm volatile("s_waitcnt lgkmcnt(0)" ::: "memory")
#define VM_WAIT() asm volatile("s_waitcnt vmcnt(0)" ::: "memory")
__device__ __forceinline__ unsigned long long rt() { return __builtin_amdgcn_s_memrealtime(); }
__device__ __forceinline__ unsigned f2bf(float f) { unsigned u = __builtin_bit_cast(unsigned, f); return (u + 0x7fffu + ((u >> 16) & 1u)) >> 16; }
__device__ __forceinline__ unsigned pk2(float lo, float hi) { return f2bf(lo) | (f2bf(hi) << 16); }
#define XB_TMO      128
#define XB_XCNT(j)  (256  + 64 * (j))
#define XB_XSUB(j)  (1280 + 64 * (j))
#define XB_XGEN(j)  (2304 + 64 * (j))
#define XB_TOP      3328
#define XB_TOPGEN   3392
#define XCD_BAR_WORDS 3456
#define XB_SPIN_CAP (1u << 18)

__device__ __forceinline__ unsigned xb_ld(unsigned* p)              { return __hip_atomic_load(p, __ATOMIC_RELAXED, __HIP_MEMORY_SCOPE_AGENT); }
__device__ __forceinline__ unsigned xb_add(unsigned* p, unsigned v) { return __hip_atomic_fetch_add(p, v, __ATOMIC_RELAXED, __HIP_MEMORY_SCOPE_AGENT); }
__device__ __forceinline__ unsigned xb_xcc_id() { return (unsigned)__builtin_amdgcn_s_getreg((3 << 11) | 20) & 0xFu; }
#define XB_SPIN(cond, bar) do { unsigned _sp = 0; while (cond) { __builtin_amdgcn_s_sleep(1); \
    if ((++_sp & 255u) == 0u) { if (xb_ld(&(bar)[XB_TMO])) break; if (_sp > XB_SPIN_CAP) { atomicAdd(&(bar)[XB_TMO], 1u); break; } } } } while (0)

struct XcdBarrier {
    unsigned total;
    unsigned* bar; unsigned x;
    volatile LAS unsigned* st;
};

__device__ __forceinline__ XcdBarrier xcd_barrier_post(unsigned* bar, volatile LAS unsigned* st, unsigned total) {
    XcdBarrier b; b.total = total; b.bar = bar; b.x = xb_xcc_id(); b.st = st;
    if (threadIdx.x == 0) (void)xb_add(&bar[XB_XCNT(b.x)], 1u);
    return b;
}
__device__ __forceinline__ void xcd_barrier_complete(unsigned* bar, unsigned x, unsigned& nloc, unsigned& nx, const unsigned G) {
    unsigned sum, cnt, mine, sp = 0u;
    for (;;) {
        sum = 0u; cnt = 0u; mine = 0u;
#pragma unroll
        for (unsigned j = 0; j < 16; ++j) { const unsigned c = xb_ld(&bar[XB_XCNT(j)]); sum += c; cnt += (c > 0u) ? 1u : 0u; mine = (j == x) ? c : mine; }
        if (sum == G) break;
        __builtin_amdgcn_s_sleep(1);
        if ((++sp & 255u) == 0u) { if (xb_ld(&bar[XB_TMO])) break; if (sp > XB_SPIN_CAP) { atomicAdd(&bar[XB_TMO], 1u); break; } }
    }
    nloc = mine > 0u ? mine : 1u; nx = cnt > 0u ? cnt : 1u;
}

__device__ __forceinline__ void xcd_barrier(const XcdBarrier& b) {
    asm volatile("s_waitcnt vmcnt(0)" ::: "memory");
    __syncthreads();
    if (threadIdx.x == 0) {
        unsigned* bar = b.bar;
        __builtin_amdgcn_s_waitcnt(0);
        unsigned nloc = b.st[0], nx = b.st[1];
        if (nloc == 0u) { xcd_barrier_complete(bar, b.x, nloc, nx, b.total); b.st[0] = nloc; b.st[1] = nx; }
        const unsigned old = xb_add(&bar[XB_XSUB(b.x)], 1u);
        const unsigned gen = old / nloc;
        if (old + 1u == (gen + 1u) * nloc) {
            if (nx > 1u) {
            __builtin_amdgcn_fence(__ATOMIC_RELEASE, "agent");
            asm volatile("s_waitcnt vmcnt(0)" ::: "memory"); }
            if (nx > 1u) {
            const unsigned og = xb_add(&bar[XB_TOP], 1u);
            const unsigned tg = og / nx;
            if (og + 1u == (tg + 1u) * nx) xb_add(&bar[XB_TOPGEN], 1u);
            else XB_SPIN(xb_ld(&bar[XB_TOPGEN]) == tg, bar); }
            xb_add(&bar[XB_XGEN(b.x)], 1u);
            __builtin_amdgcn_fence(__ATOMIC_ACQUIRE, "agent");
            asm volatile("s_waitcnt vmcnt(0)" ::: "memory");
        } else {
            XB_SPIN(xb_ld(&bar[XB_XGEN(b.x)]) == gen, bar);
            __builtin_amdgcn_fence(__ATOMIC_ACQUIRE, "agent");
            asm volatile("s_waitcnt vmcnt(0)" ::: "memory");
        }
    }
    __syncthreads();
}
__device__ __forceinline__ float wave_sum(float v) {
#pragma unroll
    for (int o = 1; o < 64; o <<= 1) v += __shfl_xor(v, o);
    return v;
}
constexpr int NWAVES = 8;
constexpr int NB = 16, SEQ = 2048, DMODEL = 1024, M = NB * SEQ, FF = 4096;
constexpr float C_EPS = 1e-6f;
constexpr int NPHASE = 12;
#ifndef MK_PROF_ASCALE
#define MK_PROF_ASCALE 0.01f
#endif
#ifndef MK_PROF_MODE
#define MK_PROF_MODE 0
#endif
#ifndef MK_PER_PHASE
#define MK_PER_PHASE 0
#endif
constexpr size_t MiB = 1u << 20;
constexpr size_t WS_CTL = 0, CTL_ZERO_BYTES = 1 * MiB;
constexpr size_t WS_SS = 1 * MiB;
constexpr size_t WS_KBP = 3 * MiB;
constexpr size_t WS_WIN0 = 4 * MiB, WS_WOUT0 = 9 * MiB, WS_WUP0 = 11 * MiB, WS_WDN0 = 19 * MiB, WS_WIN1 = 27 * MiB, WS_WOUT1 = 31 * MiB, WS_WUP1 = 33 * MiB, WS_WDN1 = 41 * MiB;
constexpr size_t WS_WRT = 49 * MiB, WS_WIT = 49 * MiB + 256 * 1024;
constexpr size_t WS_XN = 64 * MiB;
constexpr size_t WS_H = 128 * MiB;
constexpr size_t WS_Z = 128 * MiB, WS_Q = 160 * MiB, WS_K = 192 * MiB, WS_V = 224 * MiB, WS_Y = 256 * MiB;
constexpr size_t WS_GG = 128 * MiB, WS_XR = 192 * MiB;
constexpr size_t WS_END = 512 * MiB;
constexpr int NSTREAM = 8, MS = M / NSTREAM;
constexpr size_t WS_SB = 128 * MiB, WS_SSTR = 48 * MiB, SO_H = 0, SO_Z = 0, SO_Q = 4 * MiB, SO_GG = 0, SO_XR = 8 * MiB, SO_Y = 34 * MiB, QKV_STRIDE = (size_t)MS * 512;
constexpr int HP = FF + 128;
static_assert(SO_Y + (size_t)MS * 1024 * 2 <= WS_SSTR && WS_SB + NSTREAM * WS_SSTR <= WS_END && (size_t)MS * HP * 2 <= SO_Y, "stream buffers");
constexpr int CW_BAR = 4096;
constexpr int RING_BYTES = 131072;
constexpr int LDSCTL_OFF = RING_BYTES, MISC_OFF = LDSCTL_OFF + 320;
constexpr int LDS_BYTES = 147456;

__device__ __forceinline__ int lane_id() { return (int)__builtin_amdgcn_mbcnt_hi(~0u, __builtin_amdgcn_mbcnt_lo(~0u, 0u)); }

__device__ __forceinline__ void p0_transpose_item(const float* W, int N, int K, bf16* WT, int drow0, int k0, int n0, LAS float* scr, int lane, const float* gain = nullptr) {
    f32x4 v[8];
    const int r8 = lane >> 3, c4 = 4 * (lane & 7);
#pragma unroll
    for (int i = 0; i < 8; ++i) v[i] = *(const GAS f32x4*)(W + (size_t)(k0 + 8 * i + r8) * N + n0 + c4);
#pragma unroll
    for (int i = 0; i < 8; ++i) { const int kk = 8 * i + r8; const float gk = gain ? gain[k0 + kk] : 1.0f;
        scr[kk * 33 + c4] = v[i].x * gk; scr[kk * 33 + c4 + 1] = v[i].y * gk; scr[kk * 33 + c4 + 2] = v[i].z * gk; scr[kk * 33 + c4 + 3] = v[i].w * gk; }
    LDS_WAIT(); asm volatile("" ::: "memory");
    const int c = lane & 7;
#pragma unroll
    for (int j = 0; j < 4; ++j) { const int n = (lane >> 3) + 8 * j; const LAS float* s = scr + (8 * c) * 33 + n;
        v4u o; o.x = pk2(s[0 * 33], s[1 * 33]); o.y = pk2(s[2 * 33], s[3 * 33]); o.z = pk2(s[4 * 33], s[5 * 33]); o.w = pk2(s[6 * 33], s[7 * 33]);
        *(GAS v4u*)(WT + (size_t)(drow0 + n) * K + k0 + 8 * c) = o; }
    LDS_WAIT(); asm volatile("" ::: "memory");
}
struct Args { const float* in[20]; float* out; unsigned char* ws; int ph_lo, ph_hi; };
__device__ __forceinline__ size_t xf_block(int rg, int cb) {
    return ((((size_t)(rg >> 4) * 16 + (cb >> 1)) * 2 + ((rg >> 3) & 1)) * 16 + (2 * (rg & 7) + (cb & 1))) << 10;
}
__device__ __forceinline__ void rms_prep_group16(const float* x, bf16* X, float* ss, int rg, int lane) {
    const int fr = lane & 15, fq = lane >> 4, fo = (fr * 64 + fq * 16) ^ ((fr >> 3) << 5);
    const float* xr = x + (size_t)(16 * rg + fr) * DMODEL + 8 * fq;
    float s = 0.f;
#pragma unroll 1
    for (int c0 = 0; c0 < 32; c0 += 8) { f32x4 v[8][2];
#pragma unroll
        for (int i = 0; i < 8; ++i) { v[i][0] = *(const GAS f32x4*)(xr + 32 * (c0 + i)); v[i][1] = *(const GAS f32x4*)(xr + 32 * (c0 + i) + 4); }
#pragma unroll
        for (int i = 0; i < 8; ++i) { const f32x4 p = v[i][0], q = v[i][1];
            s += ((p.x * p.x + p.y * p.y) + (p.z * p.z + p.w * p.w)) + ((q.x * q.x + q.y * q.y) + (q.z * q.z + q.w * q.w));
            v4u o; o.x = pg8::cvt_pk_bf16(p.x, p.y); o.y = pg8::cvt_pk_bf16(p.z, p.w); o.z = pg8::cvt_pk_bf16(q.x, q.y); o.w = pg8::cvt_pk_bf16(q.z, q.w);
            *(GAS v4u*)((char*)X + xf_block(rg, c0 + i) + fo) = o; } }
    s += __shfl_xor(s, 16); s += __shfl_xor(s, 32);
    *(GAS f32x4*)(ss + (size_t)(16 * rg + fr) * 16 + 4 * fq) = (f32x4){fq == 0 ? s : 0.f, 0.f, 0.f, 0.f};
}
__device__ __forceinline__ void p0_prologue(const Args& a, LAS unsigned char* lds, int vcu, int G, int wave) {
    const int lane = lane_id();
    LAS float* scr = (LAS float*)(lds + wave * 16384);
    const int gw = vcu * NWAVES + wave, NGW = G * NWAVES;
    unsigned char* ws = a.ws;
    constexpr int I_IN0 = 16 * 80, I_OUT = 16 * 32, I_UP = 16 * 128, I_DN = 64 * 32, I_IN1 = 16 * 64, I_G = 8 * 2 * 4;
    constexpr int NITEMS = I_IN0 + 2 * I_OUT + 2 * I_UP + 2 * I_DN + I_IN1 + 2 * I_G;
    for (int it = gw; it < NITEMS; it += NGW) {
        int r = it;
        if (r < I_IN0) { const int kb = r / 80, nb = r % 80, n0 = 32 * nb;
            int drow0 = n0; if (n0 < 1024) { const int half = n0 >> 9, cc = n0 & 511; drow0 = (cc >> 7) * 256 + half * 128 + (cc & 127); }
            p0_transpose_item(a.in[5], 2560, 1024, (bf16*)(ws + WS_WIN0), drow0, 64 * kb, n0, scr, lane, a.in[1]); continue; } r -= I_IN0;
        if (r < I_OUT) { p0_transpose_item(a.in[9], 1024, 1024, (bf16*)(ws + WS_WOUT0), 32 * (r % 32), 64 * (r / 32), 32 * (r % 32), scr, lane); continue; } r -= I_OUT;
        if (r < I_OUT) { p0_transpose_item(a.in[18], 1024, 1024, (bf16*)(ws + WS_WOUT1), 32 * (r % 32), 64 * (r / 32), 32 * (r % 32), scr, lane); continue; } r -= I_OUT;
        if (r < I_UP) { p0_transpose_item(a.in[3], 4096, 1024, (bf16*)(ws + WS_WUP0), 32 * (r % 128), 64 * (r / 128), 32 * (r % 128), scr, lane, a.in[2]); continue; } r -= I_UP;
        if (r < I_UP) { p0_transpose_item(a.in[3] + (size_t)1024 * 4096, 4096, 1024, (bf16*)(ws + WS_WUP1), 32 * (r % 128), 64 * (r / 128), 32 * (r % 128), scr, lane, a.in[2] + DMODEL); continue; } r -= I_UP;
        if (r < I_DN) { p0_transpose_item(a.in[4], 1024, 4096, (bf16*)(ws + WS_WDN0), 32 * (r % 32), 64 * (r / 32), 32 * (r % 32), scr, lane); continue; } r -= I_DN;
        if (r < I_DN) { p0_transpose_item(a.in[4] + (size_t)4096 * 1024, 1024, 4096, (bf16*)(ws + WS_WDN1), 32 * (r % 32), 64 * (r / 32), 32 * (r % 32), scr, lane); continue; } r -= I_DN;
        if (r < I_IN1) { p0_transpose_item(a.in[10], 2048, 1024, (bf16*)(ws + WS_WIN1), 32 * (r % 64), 64 * (r / 64), 32 * (r % 64), scr, lane, a.in[1] + DMODEL); continue; } r -= I_IN1;
        { const bool isi = r >= I_G; if (isi) r -= I_G; const int hh = r >> 3, q = r & 7;
          p0_transpose_item(a.in[isi ? 15 : 13] + (size_t)hh * 16384, 128, 128, (bf16*)(ws + (isi ? WS_WIT : WS_WRT)) + (size_t)hh * 16384, 32 * (q & 3), 64 * (q >> 2), 32 * (q & 3), scr, lane); }
    }
    for (int rg = gw; rg < M / 16; rg += NGW) rms_prep_group16(a.in[0], (bf16*)(ws + WS_XN), (float*)(ws + WS_SS), rg, lane);
}

#define LDS_BAR() asm volatile("s_waitcnt lgkmcnt(0)\n\ts_barrier" ::: "memory")
typedef float f32x2 __attribute__((ext_vector_type(2)));
constexpr int CV_T = 32, CV_ROWS = CV_T + 30, CV_ZT = 0, CV_CO = CV_ROWS * 1024;
static_assert(CV_CO + CV_T * 2048 <= RING_BYTES, "conv LDS");
__device__ __forceinline__ void conv_phase(const bf16* Z, const float* cw, const float* lng, const float* lnb, bf16* Y, LAS unsigned char* lds, int vcu, int wave) {
    const int lane = lane_id(), tid = wave * 64 + lane, cp = tid & 255, tg = tid >> 8;
    f32x2 w2[31];
#pragma unroll
    for (int j = 0; j < 31; ++j) w2[j] = *(const f32x2*)(cw + j * 512 + 2 * cp);
    f32x4 g0 = *(const f32x4*)(lng + 8 * lane), g1 = *(const f32x4*)(lng + 8 * lane + 4), b0 = *(const f32x4*)(lnb + 8 * lane), b1 = *(const f32x4*)(lnb + 8 * lane + 4);
    v4u zv[8];
#define CV_LOAD(ui_) do { const int m0_ = (vcu * 4 + (ui_)) * CV_T, t0_ = m0_ & (SEQ - 1);   \
          \
        _Pragma("unroll") for (int k = 0; k < 8; ++k) { const int rr = wave + 8 * k; const int rc = rr < CV_ROWS ? rr : CV_ROWS - 1; const bool ok = (t0_ - 30 + rc >= 0); \
            zv[k] = *(const GAS v4u*)(Z + (size_t)(ok ? m0_ - 30 + rc : m0_) * 512 + lane * 8); } } while (0)
    CV_LOAD(0);
#pragma unroll
    for (int j = 0; j < 31; ++j) asm volatile("" :: "v"(w2[j]));
    asm volatile("" :: "v"(g0), "v"(g1), "v"(b0), "v"(b1));
    for (int ui = 0; ui < 4; ++ui) {
        const int m0 = (vcu * 4 + ui) * CV_T;
#pragma unroll
        for (int k = 0; k < 8; ++k) { const int rr = wave + 8 * k; const bool ok = ((m0 & (SEQ - 1)) - 30 + rr >= 0); v4u v = zv[k]; v.x = ok ? v.x : 0u; v.y = ok ? v.y : 0u; v.z = ok ? v.z : 0u; v.w = ok ? v.w : 0u;
            if (rr < CV_ROWS) *(LAS v4u*)(lds + CV_ZT + rr * 1024 + lane * 16) = v; }
        LDS_BAR();
        if (ui + 1 < 4) CV_LOAD(ui + 1);
#pragma unroll 1
        for (int run = 0; run < 2; ++run) { const int tok0 = 16 * tg + 8 * run;
            f32x2 acc[8];
#pragma unroll
            for (int o = 0; o < 8; ++o) acc[o] = (f32x2){0.f, 0.f};
#pragma unroll
            for (int i = 0; i < 38; ++i) { const unsigned pk = *(const LAS unsigned*)(lds + CV_ZT + (tok0 + i) * 1024 + cp * 4);
                const f32x2 v = (f32x2){__uint_as_float(pk << 16), __uint_as_float(pk & 0xffff0000u)};
#pragma unroll
                for (int o = 0; o < 8; ++o) { const int jj = i - o; if (jj >= 0 && jj < 31) acc[o] = w2[jj] * v + acc[o]; } }
#pragma unroll
            for (int o = 0; o < 8; ++o) *(LAS f32x2*)(lds + CV_CO + (tok0 + o) * 2048 + cp * 8) = acc[o]; }
        LDS_BAR();
        { f32x4 x0[4], x1[4]; float s1[4], s2[4];
#pragma unroll
          for (int q = 0; q < 4; ++q) { const int tok = wave * 4 + q;
              x0[q] = *(const LAS f32x4*)(lds + CV_CO + tok * 2048 + lane * 32); x1[q] = *(const LAS f32x4*)(lds + CV_CO + tok * 2048 + lane * 32 + 16);
              s1[q] = ((x0[q][0] + x0[q][1]) + (x0[q][2] + x0[q][3])) + ((x1[q][0] + x1[q][1]) + (x1[q][2] + x1[q][3]));
              s2[q] = ((x0[q][0] * x0[q][0] + x0[q][1] * x0[q][1]) + (x0[q][2] * x0[q][2] + x0[q][3] * x0[q][3])) + ((x1[q][0] * x1[q][0] + x1[q][1] * x1[q][1]) + (x1[q][2] * x1[q][2] + x1[q][3] * x1[q][3])); }
#define CV_SW32(a_, b_) ([&]() { const auto r_ = __builtin_amdgcn_permlane32_swap(__float_as_uint(a_), __float_as_uint(b_), false, false); return __uint_as_float(r_[0]) + __uint_as_float(r_[1]); }())
#define CV_SW16(a_, b_) ([&]() { const auto r_ = __builtin_amdgcn_permlane16_swap(__float_as_uint(a_), __float_as_uint(b_), false, false); return __uint_as_float(r_[0]) + __uint_as_float(r_[1]); }())
#define CV_ROR(x_, n_) __int_as_float(__builtin_amdgcn_update_dpp(0, __float_as_int(x_), 0x120 + (n_), 0xf, 0xf, false))
          const float p01 = CV_SW32(s1[0], s1[1]), p23 = CV_SW32(s1[2], s1[3]), q01 = CV_SW32(s2[0], s2[1]), q23 = CV_SW32(s2[2], s2[3]);
          float R = CV_SW16(p01, p23), S = CV_SW16(q01, q23);
          R += CV_ROR(R, 8); S += CV_ROR(S, 8); R += CV_ROR(R, 4); S += CV_ROR(S, 4); R += CV_ROR(R, 2); S += CV_ROR(S, 2); R += CV_ROR(R, 1); S += CV_ROR(S, 1);
#pragma unroll
          for (int q = 0; q < 4; ++q) { const int tok = wave * 4 + q; const int rl = (q == 0) ? 0 : (q == 1) ? 32 : (q == 2) ? 16 : 48;
              const float sum = __int_as_float(__builtin_amdgcn_readlane(__float_as_int(R), rl)), sq = __int_as_float(__builtin_amdgcn_readlane(__float_as_int(S), rl));
              const float mu = sum * (1.0f / 512.0f); float var = __builtin_fmaf(-mu, mu, sq * (1.0f / 512.0f)); var = var > 0.f ? var : 0.f;
              const float rs = __builtin_amdgcn_rsqf(var + C_EPS);
              f32x4 y0 = (x0[q] - mu) * rs * g0 + b0, y1 = (x1[q] - mu) * rs * g1 + b1;
#pragma unroll
              for (int e = 0; e < 4; ++e) { y0[e] = y0[e] * pg8::fsigmoid(y0[e]); y1[e] = y1[e] * pg8::fsigmoid(y1[e]); }
              *(GAS pg8::u32x4*)(Y + (size_t)(m0 + tok) * 1024 + lane * 8) = pg8::pack8(y0, y1); }
#undef CV_SW32
#undef CV_SW16
#undef CV_ROR
        }
    }
#undef CV_LOAD
    LDS_BAR();
}

constexpr int RG_T = 64, RG_STR = 272, RG_FS = 272;
constexpr int RG_WT = 0, RG_XC = 0, RG_AL = 128 * RG_STR, RG_BL = RG_AL + 2 * RG_T * RG_FS, RG_SUM = RG_BL + 2 * RG_T * RG_FS, RG_CAR = RG_SUM + 8 * 512, RG_END = RG_CAR + 2 * 256;
static_assert(2 * RG_T * RG_STR <= 128 * RG_STR && RG_END <= RING_BYTES, "rglru LDS");
__device__ __forceinline__ f32x4 bf4lo(unsigned a, unsigned b) { return (f32x4){__uint_as_float(a << 16), __uint_as_float(a & 0xffff0000u), __uint_as_float(b << 16), __uint_as_float(b & 0xffff0000u)}; }
__device__ __forceinline__ void rglru_phase(const Args& a, const bf16* XR, const bf16* GG, bf16* Y, LAS unsigned char* lds, int vcu, int wave) {
    const int lane = lane_id(), tid = wave * 64 + lane; unsigned char* ws = a.ws;
    const int b = vcu >> 4, hh = (vcu >> 1) & 7, half = vcu & 1, c0 = hh * 128 + half * 64;
    const float* convw = a.in[11]; const float* convb = a.in[12]; const float* br = a.in[14]; const float* bi = a.in[16]; const float* lam = a.in[17];
    { const int row = tid >> 2, part = tid & 3; const bf16* src = (const bf16*)(ws + (row < 64 ? WS_WRT : WS_WIT)) + (size_t)hh * 16384 + (size_t)(half * 64 + (row & 63)) * 128 + part * 32;
#pragma unroll
      for (int i = 0; i < 4; ++i) *(LAS v4u*)(lds + RG_WT + row * RG_STR + part * 64 + i * 16) = *(const GAS v4u*)(src + 8 * i); }
    if (tid < 64) { *(LAS float*)(lds + RG_CAR + tid * 4) = 0.f; *(LAS float*)(lds + RG_CAR + 256 + tid * 4) = 0.f; }
    const int cg = tid & 15, tr = tid >> 4;
    f32x4 cwv[4][2], cbv[2];
#pragma unroll
    for (int j = 0; j < 4; ++j) { cwv[j][0] = *(const f32x4*)(convw + j * 1024 + hh * 128 + 8 * cg); cwv[j][1] = *(const f32x4*)(convw + j * 1024 + hh * 128 + 8 * cg + 4); }
    cbv[0] = *(const f32x4*)(convb + hh * 128 + 8 * cg); cbv[1] = *(const f32x4*)(convb + hh * 128 + 8 * cg + 4);
    const int tt = wave >> 1, cq = wave & 1, n16 = lane & 15, g4 = lane >> 4;
    float sp8[2], brv[2], biv[2];
#pragma unroll
    for (int q = 0; q < 2; ++q) { const int c = c0 + 32 * cq + 16 * q + n16; sp8[q] = 8.0f * 1.4426950408889634f * log1pf(expf(-lam[c]));   brv[q] = br[c]; biv[q] = bi[c]; }
    LDS_BAR();
    bf16x8 wrf[2][4], wif[2][4];
#pragma unroll
    for (int q = 0; q < 2; ++q)
#pragma unroll
        for (int ks = 0; ks < 4; ++ks) { const int nrow = 32 * cq + 16 * q + n16;
            wrf[q][ks] = *(const LAS bf16x8*)(lds + RG_WT + nrow * RG_STR + ks * 64 + g4 * 16); wif[q][ks] = *(const LAS bf16x8*)(lds + RG_WT + (64 + nrow) * RG_STR + ks * 64 + g4 * 16); }
    LDS_BAR();
    const size_t mb = (size_t)b * SEQ;
    constexpr int NTILE = SEQ / RG_T;
    v4u xrA[5], xrB[5]; unsigned short gsA[8], gsB[8];
#define RG_PREFETCH(xraw, t0_) do { _Pragma("unroll") for (int i = 0; i < 5; ++i) { const int t = (t0_) + 2 * tr - 3 + i; const bool ok = t >= 0;   \
        const v4u v = *(const GAS v4u*)(XR + (mb + (ok ? t : 0)) * 1024 + hh * 128 + 8 * cg); xraw[i].x = ok ? v.x : 0u; xraw[i].y = ok ? v.y : 0u; xraw[i].z = ok ? v.z : 0u; xraw[i].w = ok ? v.w : 0u; } } while (0)
#define RG_S1(xraw, p_) do { f32x4 xin[5][2]; _Pragma("unroll") for (int i = 0; i < 5; ++i) { xin[i][0] = bf4lo(xraw[i].x, xraw[i].y); xin[i][1] = bf4lo(xraw[i].z, xraw[i].w); } \
        _Pragma("unroll") for (int o = 0; o < 2; ++o) { f32x4 y0 = cbv[0], y1 = cbv[1]; _Pragma("unroll") for (int j = 0; j < 4; ++j) { y0 += cwv[j][0] * xin[o + j][0]; y1 += cwv[j][1] * xin[o + j][1]; } \
            *(LAS pg8::u32x4*)(lds + RG_XC + (p_) * (RG_T * RG_STR) + (2 * tr + o) * RG_STR + cg * 16) = pg8::pack8(y0, y1); } } while (0)
#define RG_S2(p_) do { const LAS unsigned char* xc = lds + RG_XC + (p_) * (RG_T * RG_STR); LAS unsigned char* alp = lds + RG_AL + (p_) * (RG_T * RG_FS); LAS unsigned char* blp = lds + RG_BL + (p_) * (RG_T * RG_FS); \
        pg8::f32x4 ar[2], ai[2]; _Pragma("unroll") for (int q = 0; q < 2; ++q) { ar[q] = (pg8::f32x4){0.f, 0.f, 0.f, 0.f}; ai[q] = (pg8::f32x4){0.f, 0.f, 0.f, 0.f}; } \
        _Pragma("unroll") for (int ks = 0; ks < 4; ++ks) { const bf16x8 af = *(const LAS bf16x8*)(xc + (tt * 16 + n16) * RG_STR + ks * 64 + g4 * 16); \
            _Pragma("unroll") for (int q = 0; q < 2; ++q) { ar[q] = __builtin_amdgcn_mfma_f32_16x16x32_bf16(af, wrf[q][ks], ar[q], 0, 0, 0); ai[q] = __builtin_amdgcn_mfma_f32_16x16x32_bf16(af, wif[q][ks], ai[q], 0, 0, 0); } } \
        _Pragma("unroll") for (int q = 0; q < 2; ++q) _Pragma("unroll") for (int r = 0; r < 4; ++r) { const int tok = tt * 16 + 4 * g4 + r, ch = 32 * cq + 16 * q + n16; \
            const float rg = pg8::fsigmoid(ar[q][r] + brv[q]), ig = pg8::fsigmoid(ai[q][r] + biv[q]); \
            const float av = __builtin_amdgcn_exp2f(-sp8[q] * rg);            \
            const float m2 = __builtin_fmaf(-av, av, 1.0f);                    \
            const float xv = __uint_as_float(((unsigned)*(const LAS unsigned short*)(xc + tok * RG_STR + (half * 64 + ch) * 2)) << 16); \
            *(LAS float*)(alp + tok * RG_FS + ch * 4) = av; *(LAS float*)(blp + tok * RG_FS + ch * 4) = __builtin_amdgcn_sqrtf(m2) * (ig * xv); } } while (0)
    RG_PREFETCH(xrA, 0); RG_S1(xrA, 0); RG_PREFETCH(xrA, 2 * RG_T); RG_PREFETCH(xrB, RG_T);
    LDS_BAR();
    const bf16* ggp = GG + mb * 1024 + c0 + lane;
    bf16* yp = Y + mb * 1024 + c0 + lane;
#define RG_GLOAD(gsh, t0_) do { _Pragma("unroll") for (int i = 0; i < 8; ++i) gsh[i] = *(const GAS unsigned short*)(ggp + (size_t)((t0_) + 8 * wave + i) * 1024); } while (0)
    RG_S2(0); RG_S1(xrB, 1); RG_PREFETCH(xrB, 3 * RG_T); RG_GLOAD(gsA, 0); RG_GLOAD(gsB, RG_T);
    LDS_BAR();
#define RG_TILE(tile, p, xraw, gsh) do { const int t0 = (tile) * RG_T; \
          \
        float hl[8], pc[8]; \
        { const LAS unsigned char* alp = lds + RG_AL + (p) * (RG_T * RG_FS); const LAS unsigned char* blp = lds + RG_BL + (p) * (RG_T * RG_FS); \
          float av[8], bx[8]; \
          _Pragma("unroll") for (int i = 0; i < 8; ++i) { av[i] = *(const LAS float*)(alp + (8 * wave + i) * RG_FS + lane * 4); bx[i] = *(const LAS float*)(blp + (8 * wave + i) * RG_FS + lane * 4); } \
          if ((tile) + 1 < NTILE) RG_S2((p) ^ 1); \
          float h = 0.f, pr = 1.f; \
          _Pragma("unroll") for (int i = 0; i < 8; ++i) { h = av[i] * h + bx[i]; pr = pr * av[i]; hl[i] = h; pc[i] = pr; } \
          *(LAS f32x2*)(lds + RG_SUM + wave * 512 + lane * 8) = (f32x2){pr, h}; } \
        LDS_BAR(); \
          \
        { float carry = *(const LAS float*)(lds + RG_CAR + (p) * 256 + lane * 4); \
          for (int v = 0; v < wave; ++v) { const f32x2 s = *(const LAS f32x2*)(lds + RG_SUM + v * 512 + lane * 8); carry = s.y + s.x * carry; } \
          _Pragma("unroll") for (int i = 0; i < 8; ++i) { const float hv = hl[i] + pc[i] * carry; if (i == 7) hl[7] = hv; \
              const float y = hv * __uint_as_float((unsigned)gsh[i] << 16); \
              *(GAS unsigned short*)(yp + (size_t)(t0 + 8 * wave + i) * 1024) = (unsigned short)(pg8::cvt_pk_bf16(y, y) & 0xffffu); } \
          if (wave == 7) *(LAS float*)(lds + RG_CAR + ((p) ^ 1) * 256 + lane * 4) = hl[7]; } \
        RG_GLOAD(gsh, ((tile) + 2 < NTILE) ? t0 + 2 * RG_T : t0);     \
        if ((tile) + 2 < NTILE) RG_S1(xraw, p); \
        RG_PREFETCH(xraw, ((tile) + 4 < NTILE) ? t0 + 4 * RG_T : t0); \
        LDS_BAR(); } while (0)
#pragma unroll 1
    for (int tile = 0; tile < NTILE; tile += 2) { RG_TILE(tile, 0, xrA, gsA); RG_TILE(tile + 1, 1, xrB, gsB); }
#undef RG_TILE
#undef RG_PREFETCH
#undef RG_GLOAD
#undef RG_S1
#undef RG_S2
}

__device__ __forceinline__ void final_phase(const Args& a, int vcu, int G, int wave, int m0, int mrows) {
    const int lane = lane_id(), r8 = lane >> 3, g8 = lane & 7;
    const int gw = vcu * NWAVES + wave, NGW = G * NWAVES; const float* ss = (const float*)(a.ws + WS_SS); const float* g = a.in[19]; const char* X = (const char*)(a.ws + WS_XN);
    for (int rg = m0 / 16 + gw; rg < (m0 + mrows) / 16; rg += NGW) {
        const int row0 = 16 * rg + r8, row1 = row0 + 8;
        const float rs0 = pg8::row_rstd(ss, row0), rs1 = pg8::row_rstd(ss, row1);
        const int ob0 = r8 * 64 + g8 * 8, ob1 = ((r8 + 8) * 64 + g8 * 8) ^ 32;
        float* o0 = a.out + (size_t)row0 * DMODEL + 4 * g8; float* o1 = a.out + (size_t)row1 * DMODEL + 4 * g8;
#pragma unroll 1
        for (int c0 = 0; c0 < 32; c0 += 4) { unsigned long long w0[4], w1[4]; f32x4 gv[4];
#pragma unroll
            for (int i = 0; i < 4; ++i) { const char* blk = X + xf_block(rg, c0 + i); w0[i] = *(const GAS unsigned long long*)(blk + ob0); w1[i] = *(const GAS unsigned long long*)(blk + ob1); gv[i] = *(const f32x4*)(g + 32 * (c0 + i) + 4 * g8); }
#pragma unroll
            for (int i = 0; i < 4; ++i) {
                *(GAS f32x4*)(o0 + 32 * (c0 + i)) = pg8::bf4((unsigned)w0[i], (unsigned)(w0[i] >> 32)) * rs0 * gv[i];
                *(GAS f32x4*)(o1 + 32 * (c0 + i)) = pg8::bf4((unsigned)w1[i], (unsigned)(w1[i] >> 32)) * rs1 * gv[i]; } } }
}

__global__ void __launch_bounds__(NWAVES * 64, 2) mk_fwd(Args args) {
    extern __shared__ __attribute__((aligned(16))) unsigned char lds_raw[];
    LAS unsigned char* lds = (LAS unsigned char*)lds_raw;
    volatile LAS unsigned* MISC = (volatile LAS unsigned*)(lds + MISC_OFF);
    const int wave = __builtin_amdgcn_readfirstlane((int)threadIdx.x >> 6);
    const int G = gridDim.x; const int bx = blockIdx.x; const int vcu = (G % 8 == 0) ? (bx % 8) * (G / 8) + bx / 8 : bx;
    unsigned char* ws = args.ws;
    gu32* ctl = (gu32*)(ws + WS_CTL);
    for (int u = (int)threadIdx.x; u < (LDS_BYTES - LDSCTL_OFF) / 4; u += NWAVES * 64) ((LAS unsigned*)(lds + LDSCTL_OFF))[u] = 0u;
    __syncthreads();
    const int sid = bx & 7, G2 = G / NSTREAM, c = bx >> 3, vcl = c, vcs = sid * G2 + vcl, M0 = sid * MS;
    XcdBarrier bar = xcd_barrier_post((unsigned*)(ctl + CW_BAR), MISC + 8, (unsigned)G);
    XcdBarrier sbar = xcd_barrier_post((unsigned*)(ctl + CW_BAR + 4096 * (1 + sid)), MISC + 10, (unsigned)G2);
    const int lo = args.ph_lo, hi = args.ph_hi;
#define IN(k) (lo <= (k) && (k) < hi)
#define SEAM(k) do { if (IN(k) && IN((k) + 1)) xcd_barrier(sbar); } while (0)
    unsigned char* sb = ws + WS_SB + (size_t)sid * WS_SSTR;
    bf16* XNl = (bf16*)(ws + WS_XN) + (size_t)M0 * 1024; float* SSl = (float*)(ws + WS_SS) + (size_t)M0 * 16;
    bf16* Hl = (bf16*)(sb + SO_H); bf16* Yl = (bf16*)(sb + SO_Y); bf16* Zl = (bf16*)(sb + SO_Z); bf16* Ql = (bf16*)(sb + SO_Q); bf16* GGl = (bf16*)(sb + SO_GG); bf16* XRl = (bf16*)(sb + SO_XR);
    bf16* Yg = Yl - (size_t)M0 * 1024; const bf16* Zg = Zl - (size_t)M0 * 512; const bf16* Qg = Ql - (size_t)M0 * 512; const bf16* Kg = Qg + QKV_STRIDE; const bf16* Vg = Kg + QKV_STRIDE;
    const bf16* GGg = GGl - (size_t)M0 * 1024; const bf16* XRg = XRl - (size_t)M0 * 1024;
    LAS float* RTAB = (LAS float*)(lds + pg8::RTAB_OFF);
    static_assert(pg8::RTAB_OFF >= MISC_OFF + 128 && pg8::RTAB_OFF + 2048 <= LDS_BYTES, "rtab inside the LDS control area");

    if (IN(0)) { p0_prologue(args, lds, vcu, G, wave); }
    if (IN(0) && IN(1)) xcd_barrier(bar);
    if (IN(1)) {
        pg8::Gemm g{XNl, (const bf16*)(ws + WS_WIN0), MS, 2560, DMODEL, 0, 1}; pg8::StaticOrder S; S.init1(MS, 2560, G2, c);
        pg8::EpiInAB E{Zl, Ql, RTAB, mo::C2, QKV_STRIDE};
        pg8::gemm_phase<pg8::EpiInAB, pg8::StaticOrder, true, true>(lds, g, S, E, wave, SSl);
    }
    SEAM(1);
    if (IN(2)) {
        conv_phase(Zg, args.in[6], args.in[7], args.in[8], Yg, lds, vcs, wave);
        const int bh = vcs >> 1, hf = vcs & 1;
        mo::moba_kbar(bh >> 3, bh & 7, Kg, (LAS char*)lds, wave);
#pragma unroll 1
        for (int i = 0; i < 4; ++i) { const int j = hf ? ((i == 0) ? 2 : (i == 1) ? 5 : (i == 2) ? 3 : 4) : ((i == 0) ? 0 : (i == 1) ? 7 : (i == 2) ? 1 : 6);
            mo::moba_unit(bh >> 3, bh & 7, j, Qg, Kg, Vg, Yg, (LAS char*)lds, wave, i == 0, i < 3); }
    }
    SEAM(2);
    if (IN(3)) {
        pg8::Gemm g{Yl, (const bf16*)(ws + WS_WOUT0), MS, DMODEL, DMODEL}; pg8::StaticOrder S; S.init1(MS, DMODEL, G2, c);
        pg8::EpiResB E{XNl, nullptr, SSl};
        pg8::gemm_phase<pg8::EpiResB, pg8::StaticOrder, true, true>(lds, g, S, E, wave);
    }
    SEAM(3);
    if (IN(4)) {
        pg8::Gemm g{XNl, (const bf16*)(ws + WS_WUP0), MS, FF, DMODEL, 0, 1}; pg8::StaticOrder S; S.init1(MS, FF, G2, c);
        pg8::EpiUp E{Hl, RTAB};
        pg8::gemm_phase<pg8::EpiUp, pg8::StaticOrder, true, true>(lds, g, S, E, wave, SSl);
    }
    SEAM(4);
    if (IN(5)) {
        pg8::Gemm g{Hl, (const bf16*)(ws + WS_WDN0), MS, DMODEL, FF, 0, 1}; pg8::StaticOrder S; S.init1(MS, DMODEL, G2, c);
        pg8::EpiResB E{XNl, nullptr, SSl};
        pg8::gemm_phase<pg8::EpiResB, pg8::StaticOrder, true, true>(lds, g, S, E, wave);
    }
    SEAM(5);
    if (IN(6)) {
        pg8::Gemm g{XNl, (const bf16*)(ws + WS_WIN1), MS, 2048, DMODEL, 0, 1}; pg8::StaticOrder S; S.init1(MS, 2048, G2, c);
        pg8::EpiInC E{GGl, XRl, RTAB};
        pg8::gemm_phase<pg8::EpiInC, pg8::StaticOrder, true, true>(lds, g, S, E, wave, SSl);
    }
    SEAM(6);
    if (IN(7)) { rglru_phase(args, XRg, GGg, Yg, lds, vcs, wave); }
    SEAM(7);
    if (IN(8)) {
        pg8::Gemm g{Yl, (const bf16*)(ws + WS_WOUT1), MS, DMODEL, DMODEL}; pg8::StaticOrder S; S.init1(MS, DMODEL, G2, c);
        pg8::EpiResB E{XNl, nullptr, SSl};
        pg8::gemm_phase<pg8::EpiResB, pg8::StaticOrder, true, true>(lds, g, S, E, wave);
    }
    SEAM(8);
    if (IN(9)) {
        pg8::Gemm g{XNl, (const bf16*)(ws + WS_WUP1), MS, FF, DMODEL, 0, 1}; pg8::StaticOrder S; S.init1(MS, FF, G2, c);
        pg8::EpiUp E{Hl, RTAB};
        pg8::gemm_phase<pg8::EpiUp, pg8::StaticOrder, true, true>(lds, g, S, E, wave, SSl);
    }
    SEAM(9);
    if (IN(10)) {
        pg8::Gemm g{Hl, (const bf16*)(ws + WS_WDN1), MS, DMODEL, FF, 0, 1}; pg8::StaticOrder S; S.init1(MS, DMODEL, G2, c);
        pg8::EpiResB E{XNl, nullptr, SSl};
        pg8::gemm_phase<pg8::EpiResB, pg8::StaticOrder, true, true>(lds, g, S, E, wave);
    }
    SEAM(10);
    if (IN(11)) { final_phase(args, vcl, G2, wave, M0, MS); }
#ifdef MK_PROF
    if (IN(11)) { xcd_barrier(sbar);
        if (bx == 0) { const unsigned long long* pr = (const unsigned long long*)(ws + WS_CTL + 512 * 1024); const float cnt = (float)pr[6];
            const float A = (float)pr[MK_PROF_A] / cnt, B = (float)pr[MK_PROF_B] / cnt; const float c = sqrtf(B * 1e-5f * 128.0f);
            for (int i = (int)threadIdx.x; i < (1 << 18); i += 512) args.out[(size_t)i * 128 + 64] += c;
            if (threadIdx.x == 0) args.out[0] += A * MK_PROF_ASCALE; } }
#endif
#undef IN
#undef SEAM
}

extern "C" void kernel_launch(void* const* d_in, const int* in_sizes, int n_in, void* d_out, int out_size, void* d_ws, size_t ws_size, hipStream_t stream) {
    static int grid = 0;
    if (grid == 0) {
        if (n_in != 20 || in_sizes[0] != M * DMODEL || out_size != M * DMODEL || ws_size < WS_END) { fprintf(stderr, "kernel_launch: unexpected shapes (n_in %d, in0 %d, out %d, ws %zu); nothing launched\n", n_in, n_in > 0 ? in_sizes[0] : -1, out_size, ws_size); grid = -1; return; }
        int dev = 0, cus = 0, per_cu = 0;
        if (hipGetDevice(&dev) != hipSuccess || hipDeviceGetAttribute(&cus, hipDeviceAttributeMultiprocessorCount, dev) != hipSuccess) { grid = -1; return; }
        if (hipFuncSetAttribute((const void*)mk_fwd, hipFuncAttributeMaxDynamicSharedMemorySize, LDS_BYTES) != hipSuccess) { fprintf(stderr, "kernel_launch: hipFuncSetAttribute failed\n"); grid = -1; return; }
        if (hipOccupancyMaxActiveBlocksPerMultiprocessor(&per_cu, (const void*)mk_fwd, NWAVES * 64, LDS_BYTES) != hipSuccess || per_cu < 1) fprintf(stderr, "kernel_launch: note: occupancy query reports %d\n", per_cu);
        (void)hipGetLastError();
        grid = cus;
        if (grid != 256) fprintf(stderr, "kernel_launch: %d CUs (the static schedules assume 256)\n", grid);
    }
    if (grid < 0) return;
    if (hipMemsetAsync((char*)d_ws + WS_CTL, 0, CTL_ZERO_BYTES, stream) != hipSuccess) return;
    Args a{};
    for (int i = 0; i < 20; ++i) a.in[i] = (const float*)d_in[i];
    a.out = (float*)d_out; a.ws = (unsigned char*)d_ws;
#if MK_PER_PHASE
    for (int p = 0; p < NPHASE; ++p) { a.ph_lo = p; a.ph_hi = p + 1; hipLaunchKernelGGL(mk_fwd, dim3(grid), dim3(NWAVES * 64), LDS_BYTES, stream, a); }
#else
    a.ph_lo = 0; a.ph_hi = NPHASE;
    hipLaunchKernelGGL(mk_fwd, dim3(grid), dim3(NWAVES * 64), LDS_BYTES, stream, a);
#endif
}
```

```cpp
#include <hip/hip_runtime.h>
#include <hip/hip_bf16.h>
#include <cstdio>
#include <cstdint>
#include <cmath>
namespace pg8 {
#define PG8_LAS __attribute__((address_space(3)))
typedef unsigned short bf16_t;
typedef short bf16x8 __attribute__((ext_vector_type(8)));
typedef float f32x4 __attribute__((ext_vector_type(4)));
typedef unsigned u32x4 __attribute__((ext_vector_type(4)));
constexpr int BM = 256, BK = 64, HALF = 128, HTB = HALF * BK * 2  , STAGE_BYTES = 8 * HTB, NXCD = 8, WGM = 8;

__host__ __device__ __forceinline__ int lds_byte(int r, int c) { const int st = (r >> 4) * 2 + (c >> 5), rr = r & 15, cc = c & 31, ob = rr * 64 + cc * 2; return st * 1024 + (ob ^ (((ob >> 9) & 1) << 5)); }
__host__ __device__ __forceinline__ void stage_rc(int b, int& R, int& C) { const int st = b / 1024, sb = b % 1024, swz = sb ^ (((sb >> 9) & 1) << 5); R = (st >> 1) * 16 + swz / 64; C = (st & 1) * 32 + (swz % 64) / 2; }
__host__ __device__ __forceinline__ int perm32(int rho) { const int n = rho >> 4, i = rho & 15; return 8 * (i >> 2) + 4 * n + (i & 3); }

struct Unit { int pm, pn; };
struct Gemm { const bf16_t* A; const bf16_t* Bt; int M, N, K; int lda = 0; int afrag = 0; };

struct StaticOrder {
    int nM, nN, nwg, G, c, remap = 1;
    __host__ __device__ void init(int M, int N, int G_, int c_) { nM = M / BM; nN = N / BM; nwg = nM * nN; G = G_; c = c_; }
    __host__ __device__ void init1(int M, int N, int G_, int c_) { init(M, N, G_, c_); remap = 0; }
    __host__ __device__ bool next(int i, Unit& u) const {
        const long L = (long)i * G + c; if (L >= nwg) return false;
        int wgid = (int)L; if (remap) { const int q = nwg / NXCD, r = nwg % NXCD, xcd = wgid % NXCD, off = wgid / NXCD; wgid = (xcd < r ? xcd * (q + 1) : r * (q + 1) + (xcd - r) * q) + off; }
        const int nig = WGM * nN, gid = wgid / nig, fm = gid * WGM, gsz = (nM - fm) < WGM ? (nM - fm) : WGM;
        u.pm = fm + ((wgid % nig) % gsz); u.pn = (wgid % nig) / gsz; return true;
    }
    __device__ __forceinline__ void a_ready(const Unit&) const {}
    __device__ __forceinline__ void done(const Unit&) const {}
};
__device__ __forceinline__ unsigned cvt_pk_bf16(float lo, float hi) { unsigned r; asm volatile("v_cvt_pk_bf16_f32 %0, %1, %2" : "=v"(r) : "v"(lo), "v"(hi)); return r; }
typedef float f32x2 __attribute__((ext_vector_type(2)));
typedef unsigned u32x2 __attribute__((ext_vector_type(2)));
__device__ __forceinline__ float row_rstd(const float* ss, int row) {
    const f32x4* p = (const f32x4*)(ss + (size_t)row * 16);
    const f32x4 a = p[0], b = p[1], c = p[2], d = p[3];
    const float s = (((a[0] + a[1]) + (a[2] + a[3])) + ((b[0] + b[1]) + (b[2] + b[3]))) + (((c[0] + c[1]) + (c[2] + c[3])) + ((d[0] + d[1]) + (d[2] + d[3])));
    return 1.0f / sqrtf(s * (1.0f / 1024.0f) + 1e-6f);
}
constexpr int RTAB_OFF = 131072 + 1024;
__device__ __forceinline__ void rtab_fill(const StaticOrder& S, const float* ss, PG8_LAS float* rtab, int wid) {
    const int lane = (int)__builtin_amdgcn_mbcnt_hi(~0u, __builtin_amdgcn_mbcnt_lo(~0u, 0u)), t = wid * 64 + lane, row = t >> 1, h = t & 1;
    Unit u; int prev = -1;
    for (int i = 0; S.next(i, u); ++i) { if (u.pm == prev) continue; prev = u.pm;
        const f32x4* p = (const f32x4*)(ss + ((size_t)u.pm * BM + row) * 16 + h * 8);
        const f32x4 a = p[0], b = p[1];
        float s = ((a[0] + a[1]) + (a[2] + a[3])) + ((b[0] + b[1]) + (b[2] + b[3]));
        s += __shfl_xor(s, 1);
        const float r = 1.0f / sqrtf(s * (1.0f / 1024.0f) + 1e-6f);
        if (h == 0) rtab[((u.pm >> 3) & 1) * 256 + row] = r; }
    asm volatile("s_waitcnt lgkmcnt(0)\n\ts_barrier" ::: "memory");
}
__device__ __forceinline__ void row_scales(float (&rs)[2][4], const PG8_LAS float* rtab, const Unit& u, int wr, int fr, float mul) {
    const PG8_LAS float* t = rtab + ((u.pm >> 3) & 1) * 256 + wr * 64 + fr;
#pragma unroll
    for (int ai = 0; ai < 2; ++ai)
#pragma unroll
        for (int m = 0; m < 4; ++m) rs[ai][m] = t[ai * HALF + m * 16] * mul;
}
__device__ __forceinline__ float fsigmoid(float x) { return __builtin_amdgcn_rcpf(1.0f + __builtin_amdgcn_exp2f(-1.4426950408889634f * x)); }
__device__ __forceinline__ u32x4 pack8(const f32x4& v0, const f32x4& v1) { u32x4 w; w.x = cvt_pk_bf16(v0[0], v0[1]); w.y = cvt_pk_bf16(v0[2], v0[3]); w.z = cvt_pk_bf16(v1[0], v1[1]); w.w = cvt_pk_bf16(v1[2], v1[3]); return w; }

struct EpiInAB {
    static constexpr bool PERM = true, AFTER_DRAIN = false, ADJ = false;
    bf16_t* Z; bf16_t* QKV; const PG8_LAS float* rtab; float qscale; size_t qkv_stride;
    __device__ __forceinline__ void operator()(const f32x4 (&acc)[2][2][4][2], const Unit& u, int wr, int wc, int fr, int fq) const {
        const int row0 = u.pm * BM + wr * 64 + fr, cw = wc * 32 + 8 * fq;
        float rsv[2][4]; row_scales(rsv, rtab, u, wr, fr, (u.pn == 4 || u.pn == 5) ? qscale : 1.0f);
        if (u.pn < 4) {
#pragma unroll
            for (int ai = 0; ai < 2; ++ai)
#pragma unroll
                for (int m = 0; m < 4; ++m) { const int row = row0 + ai * HALF + m * 16; const float rs = rsv[ai][m];
                    f32x4 z0, z1;
#pragma unroll
                    for (int j = 0; j < 4; ++j) { z0[j] = (acc[ai][0][m][0][j] * rs) * fsigmoid(acc[ai][1][m][0][j] * rs); z1[j] = (acc[ai][0][m][1][j] * rs) * fsigmoid(acc[ai][1][m][1][j] * rs); }
                    *(u32x4*)(Z + (size_t)row * 512 + u.pn * 128 + cw) = pack8(z0, z1); __builtin_amdgcn_sched_barrier(0); }
        } else {
            const int t = (u.pn - 4) >> 1; bf16_t* dst = QKV + (size_t)t * qkv_stride;
            const int cb = ((u.pn - 4) & 1) * 256 + cw;
#pragma unroll
            for (int ai = 0; ai < 2; ++ai)
#pragma unroll
                for (int m = 0; m < 4; ++m) { const int row = row0 + ai * HALF + m * 16; const float rs = rsv[ai][m];
#pragma unroll
                    for (int bj = 0; bj < 2; ++bj) { const f32x4 v0 = acc[ai][bj][m][0] * rs, v1 = acc[ai][bj][m][1] * rs;
                        *(u32x4*)(dst + (size_t)row * 512 + cb + bj * HALF) = pack8(v0, v1); } __builtin_amdgcn_sched_barrier(0); }
        }
    }
};
__device__ __forceinline__ float irelu(float x) { const int i = __float_as_int(x); return __int_as_float(i > 0 ? i : 0); }
struct EpiUp {
    static constexpr bool PERM = true, AFTER_DRAIN = false, ADJ = true;
    bf16_t* H; const PG8_LAS float* rtab;
    static constexpr int FFT = 4096 / 64;
    __device__ __forceinline__ void operator()(const f32x4 (&acc)[2][2][4][2], const Unit& u, int wr, int wc, int fr, int fq) const {
        const int fo = (fr * 64 + fq * 16) ^ ((fr >> 3) << 5);
        float rsv[2][4]; row_scales(rsv, rtab, u, wr, fr, 1.0f);
#pragma unroll
        for (int ai = 0; ai < 2; ++ai)
#pragma unroll
            for (int m = 0; m < 4; ++m) { const float rs2 = rsv[ai][m] * rsv[ai][m];
                const f32x2 r2 = (f32x2){rs2, rs2};
#pragma unroll
                for (int bj = 0; bj < 2; ++bj) { f32x4 v0, v1;
#pragma unroll
                    for (int j = 0; j < 4; j += 2) {
                        const float x0 = acc[ai][bj][m][0][j], x1 = acc[ai][bj][m][0][j + 1], x2 = acc[ai][bj][m][1][j], x3 = acc[ai][bj][m][1][j + 1];
                        f32x2 a = (f32x2){irelu(x0), irelu(x1)}, b = (f32x2){irelu(x2), irelu(x3)};
                        a = (a * a) * r2; b = (b * b) * r2; v0[j] = a[0]; v0[j + 1] = a[1]; v1[j] = b[0]; v1[j + 1] = b[1]; }
                    *(u32x4*)((char*)H + ((((size_t)(u.pm * (FFT) + u.pn * 4 + wc) * 2 + ai) * 16 + (2 * (4 * wr + m) + bj)) << 10) + fo) = pack8(v0, v1); } __builtin_amdgcn_sched_barrier(0); }
    }
};
struct EpiInC {
    static constexpr bool PERM = true, AFTER_DRAIN = false, ADJ = true;
    bf16_t* GG; bf16_t* XR; const PG8_LAS float* rtab;
    __device__ __forceinline__ void operator()(const f32x4 (&acc)[2][2][4][2], const Unit& u, int wr, int wc, int fr, int fq) const {
        const int row0 = u.pm * BM + wr * 64 + fr, col0 = (u.pn & 3) * BM + wc * 64 + 8 * fq; const bool isg = u.pn < 4; bf16_t* dst = isg ? GG : XR;
        float rsv[2][4]; row_scales(rsv, rtab, u, wr, fr, 1.0f);
#pragma unroll
        for (int ai = 0; ai < 2; ++ai)
#pragma unroll
            for (int m = 0; m < 4; ++m) { const int row = row0 + ai * HALF + m * 16; const float rs = rsv[ai][m];
#pragma unroll
                for (int bj = 0; bj < 2; ++bj) { f32x4 v0 = acc[ai][bj][m][0] * rs, v1 = acc[ai][bj][m][1] * rs;
                    if (isg) {
                        const f32x2 c1 = (f32x2){-2.3022081983f, -2.3022081983f}, c2 = (f32x2){-0.10294324f, -0.10294324f}, one = (f32x2){1.0f, 1.0f};
#pragma unroll
                        for (int j = 0; j < 4; j += 2) {
                            f32x2 xa = (f32x2){v0[j], v0[j + 1]}, xb = (f32x2){v1[j], v1[j + 1]};
                            f32x2 ea = xa * (xa * xa * c2 + c1), eb = xb * (xb * xb * c2 + c1);
                            ea = (f32x2){__builtin_amdgcn_exp2f(ea[0]), __builtin_amdgcn_exp2f(ea[1])} + one; eb = (f32x2){__builtin_amdgcn_exp2f(eb[0]), __builtin_amdgcn_exp2f(eb[1])} + one;
                            xa = xa * (f32x2){__builtin_amdgcn_rcpf(ea[0]), __builtin_amdgcn_rcpf(ea[1])}; xb = xb * (f32x2){__builtin_amdgcn_rcpf(eb[0]), __builtin_amdgcn_rcpf(eb[1])};
                            v0[j] = xa[0]; v0[j + 1] = xa[1]; v1[j] = xb[0]; v1[j + 1] = xb[1]; } }
                    *(u32x4*)(dst + (size_t)row * 1024 + col0 + bj * 32) = pack8(v0, v1); } __builtin_amdgcn_sched_barrier(0); }
    }
};
__device__ __forceinline__ f32x4 bf4(unsigned a, unsigned b) { return (f32x4){__uint_as_float(a << 16), __uint_as_float(a & 0xffff0000u), __uint_as_float(b << 16), __uint_as_float(b & 0xffff0000u)}; }
struct EpiResB {
    static constexpr bool PERM = true, AFTER_DRAIN = false, ADJ = true;
    bf16_t* X; float* outf; float* ssout;
    __device__ __forceinline__ void operator()(const f32x4 (&acc)[2][2][4][2], const Unit& u, int wr, int wc, int fr, int fq) const {
        const int row0 = u.pm * BM + wr * 64 + fr;
        const int fo = (fr * 64 + fq * 16) ^ ((fr >> 3) << 5);
        char* xb = (char*)X + (((size_t)(u.pm * 16 + u.pn * 4 + wc) * 2) << 14) + fo;
        u32x4 raw[2][4][2];
#pragma unroll
        for (int ai = 0; ai < 2; ++ai)
#pragma unroll
            for (int m = 0; m < 4; ++m)
#pragma unroll
                for (int bj = 0; bj < 2; ++bj) raw[ai][m][bj] = *(const u32x4*)(xb + ((ai * 16 + 2 * (4 * wr + m) + bj) << 10));
#pragma unroll
        for (int ai = 0; ai < 2; ++ai)
#pragma unroll
            for (int m = 0; m < 4; ++m) { const int row = row0 + ai * HALF + m * 16; float sq = 0.f;
                f32x2 sq2 = (f32x2){0.f, 0.f};
#pragma unroll
                for (int bj = 0; bj < 2; ++bj) { const u32x4 rw = raw[ai][m][bj];
                    const f32x4 x0 = bf4(rw.x, rw.y) + acc[ai][bj][m][0], x1 = bf4(rw.z, rw.w) + acc[ai][bj][m][1];
                    const f32x2 a0 = (f32x2){x0[0], x0[1]}, a1 = (f32x2){x0[2], x0[3]}, a2 = (f32x2){x1[0], x1[1]}, a3 = (f32x2){x1[2], x1[3]};
                    sq2 = a0 * a0 + sq2; sq2 = a1 * a1 + sq2; sq2 = a2 * a2 + sq2; sq2 = a3 * a3 + sq2;
                    *(u32x4*)(xb + ((ai * 16 + 2 * (4 * wr + m) + bj) << 10)) = pack8(x0, x1); }
                sq = sq2[0] + sq2[1];
                { const auto r16 = __builtin_amdgcn_permlane16_swap(__float_as_uint(sq), __float_as_uint(sq), false, false); sq = __uint_as_float(r16[0]) + __uint_as_float(r16[1]);
                  const auto r32 = __builtin_amdgcn_permlane32_swap(__float_as_uint(sq), __float_as_uint(sq), false, false); sq = __uint_as_float(r32[0]) + __uint_as_float(r32[1]); }
                if (fq == 0) ssout[(size_t)row * 16 + u.pn * 4 + wc] = sq;
                __builtin_amdgcn_sched_barrier(0); }
    }
};

template <class Epi, class Sched, bool ALIGN_EPI = false, bool SP2 = false>
__device__ __forceinline__ void gemm_phase(PG8_LAS unsigned char* lds, const Gemm g, const Sched& S, const Epi& E, const int wid, const float* ssfill = nullptr) {
    const int lane = (int)__builtin_amdgcn_mbcnt_hi(~0u, __builtin_amdgcn_mbcnt_lo(~0u, 0u)), tid = wid * 64 + lane, wr = wid >> 2, wc = wid & 3, fr = lane & 15, fq = lane >> 4;
    const int K = g.K, nt = K / BK, lda = g.lda ? g.lda : K;
    unsigned voffA[2], voffB[2];
#pragma unroll
    for (int i = 0; i < 2; ++i) { int R, C; stage_rc(tid * 16 + i * 8192, R, C);
        const int Rb = Epi::ADJ ? ((R >> 5) * 64 + perm32(R & 31)) : Epi::PERM ? ((R & ~31) + perm32(R & 31)) : R;
        voffA[i] = g.afrag ? (unsigned)((wid + 8 * i) * 1024 + lane * 16) : (unsigned)(R * lda + C) * 2u; voffB[i] = (unsigned)(Rb * K + C) * 2u; }
    const size_t kstep = (size_t)(BK * 2);
    const size_t hstep = (size_t)HALF * K * 2;
    const size_t bhstep = Epi::ADJ ? (size_t)32 * K * 2 : hstep;
    const size_t tstep = 2 * hstep;
    const bool afrag = g.afrag != 0;
    const size_t ahstep = afrag ? (size_t)HTB : (size_t)HALF * lda * 2, akstep = afrag ? (size_t)(2 * HTB) : kstep, atstep = afrag ? (size_t)(K / BK) * 2 * HTB : 2 * (size_t)HALF * lda * 2;
    const unsigned ldsw = (unsigned)wid * 1024u;
    const int aoff = lds_byte(wr * 64 + fr, fq * 8), boff = lds_byte(wc * 32 + fr, fq * 8);
#define PG8_SA(b, h) (((b) * 2 + (h)) * HTB)
#define PG8_SB(b, h) ((4 + (b) * 2 + (h)) * HTB)
#define PG8_STAGE(bufoff, gbase, voff) do { _Pragma("unroll") for (int _i = 0; _i < 2; ++_i) \
        __builtin_amdgcn_global_load_lds((const unsigned*)((const char*)(gbase) + (voff)[_i]), (PG8_LAS unsigned*)(lds + (bufoff) + ldsw + _i * 8192), 16, 0, 0); } while (0)
#define PG8_LDA(dst, b, h) do { _Pragma("unroll") for (int m = 0; m < 4; ++m) _Pragma("unroll") for (int k = 0; k < 2; ++k) dst[m][k] = *(const PG8_LAS bf16x8*)(lds + PG8_SA(b, h) + aoff + m * 2048 + k * 1024); } while (0)
#define PG8_LDB(dst, b, h) do { _Pragma("unroll") for (int n = 0; n < 2; ++n) _Pragma("unroll") for (int k = 0; k < 2; ++k) dst[n][k] = *(const PG8_LAS bf16x8*)(lds + PG8_SB(b, h) + boff + n * 2048 + k * 1024); } while (0)
#define PG8_MMA(ai, bj, At, Bt) do { __builtin_amdgcn_s_setprio(1); _Pragma("unroll") for (int m = 0; m < 4; ++m) _Pragma("unroll") for (int n = 0; n < 2; ++n) _Pragma("unroll") for (int k = 0; k < 2; ++k) \
        acc[ai][bj][m][n] = __builtin_amdgcn_mfma_f32_16x16x32_bf16(Bt[n][k], At[m][k], acc[ai][bj][m][n], 0, 0, 0); __builtin_amdgcn_s_setprio(0); } while (0)
#define PG8_WAIT_V(n) asm volatile("s_waitcnt vmcnt(" #n ")" ::: "memory")
#define PG8_WAIT_L(n) asm volatile("s_waitcnt lgkmcnt(" #n ")" ::: "memory")
#define PG8_BAR __builtin_amdgcn_s_barrier()
#define PG8_SCHED __builtin_amdgcn_sched_barrier(0)
    Unit cur, nxt; int ui = 0;
    if (!S.next(0, cur)) return;
    f32x4 acc[2][2][4][2];
#pragma unroll
    for (int a = 0; a < 2; ++a)
#pragma unroll
        for (int b = 0; b < 2; ++b)
#pragma unroll
            for (int m = 0; m < 4; ++m)
#pragma unroll
                for (int n = 0; n < 2; ++n) acc[a][b][m][n] = (f32x4){0.f, 0.f, 0.f, 0.f};
    bf16x8 At[4][2], B0[2][2], B1[2][2];
    const char* cA = (const char*)g.A + (size_t)cur.pm * atstep; const char* cB = (const char*)g.Bt + (size_t)cur.pn * tstep;
    S.a_ready(cur);
    if constexpr (SP2) {
        PG8_STAGE(PG8_SB(0, 0), cB, voffB); PG8_STAGE(PG8_SB(0, 1), cB + bhstep, voffB); PG8_STAGE(PG8_SA(0, 0), cA, voffA); PG8_STAGE(PG8_SA(0, 1), cA + ahstep, voffA);
        if (ssfill) rtab_fill(S, ssfill, (PG8_LAS float*)(lds + RTAB_OFF), wid);
        if (wr == 1) PG8_BAR;
        PG8_WAIT_V(2); PG8_BAR;
        PG8_STAGE(PG8_SB(1, 0), cB + kstep, voffB); PG8_STAGE(PG8_SA(1, 0), cA + akstep, voffA); PG8_STAGE(PG8_SB(1, 1), cB + bhstep + kstep, voffB);
        PG8_WAIT_V(6); PG8_BAR;
    } else {
        PG8_STAGE(PG8_SB(0, 0), cB, voffB); PG8_STAGE(PG8_SA(0, 0), cA, voffA); PG8_STAGE(PG8_SB(0, 1), cB + bhstep, voffB); PG8_STAGE(PG8_SA(0, 1), cA + ahstep, voffA);
        if (wr == 1) PG8_BAR;
        PG8_WAIT_V(4); PG8_BAR;
        PG8_STAGE(PG8_SB(1, 0), cB + kstep, voffB); PG8_STAGE(PG8_SA(1, 0), cA + akstep, voffA); PG8_STAGE(PG8_SB(1, 1), cB + bhstep + kstep, voffB);
        PG8_WAIT_V(6); PG8_BAR;
    }
    for (;;) {
        const bool has_next = S.next(ui + 1, nxt);
        const char* nA = has_next ? (const char*)g.A + (size_t)nxt.pm * atstep : cA; const char* nB = has_next ? (const char*)g.Bt + (size_t)nxt.pn * tstep : cB;
        for (int t = 0; t < nt; t += 2) {
            const bool last = (t == nt - 2);
            const char* a1 = cA + (size_t)(t + 1) * akstep;
            const char* a2 = last ? nA : cA + (size_t)(t + 2) * akstep; const char* b2 = last ? nB : cB + (size_t)(t + 2) * kstep;
            const char* a3 = a2 + akstep; const char* b3 = b2 + kstep;
            if (last && has_next) S.a_ready(nxt);
            if constexpr (SP2) {
            PG8_LDB(B0, 0, 0); PG8_LDB(B1, 0, 1); PG8_SCHED; PG8_LDA(At, 0, 0); PG8_STAGE(PG8_SA(1, 1), a1 + ahstep, voffA);
            PG8_WAIT_V(8); PG8_WAIT_L(0); PG8_BAR; PG8_MMA(0, 0, At, B0); PG8_MMA(0, 1, At, B1); PG8_BAR; PG8_SCHED;
            PG8_LDA(At, 0, 1); PG8_STAGE(PG8_SB(0, 0), b2, voffB); PG8_STAGE(PG8_SB(0, 1), b2 + bhstep, voffB); PG8_STAGE(PG8_SA(0, 0), a2, voffA);
            PG8_WAIT_V(8); PG8_WAIT_L(0); PG8_BAR; PG8_MMA(1, 0, At, B0); PG8_MMA(1, 1, At, B1); PG8_BAR; PG8_SCHED;
            PG8_LDB(B0, 1, 0); PG8_LDB(B1, 1, 1); PG8_SCHED; PG8_LDA(At, 1, 0); PG8_STAGE(PG8_SA(0, 1), a2 + ahstep, voffA);
            PG8_WAIT_V(8); PG8_WAIT_L(0); PG8_BAR; PG8_MMA(0, 0, At, B0); PG8_MMA(0, 1, At, B1); PG8_BAR; PG8_SCHED;
            PG8_LDA(At, 1, 1); PG8_STAGE(PG8_SB(1, 0), b3, voffB); PG8_STAGE(PG8_SB(1, 1), b3 + bhstep, voffB); PG8_STAGE(PG8_SA(1, 0), a3, voffA);
            PG8_WAIT_V(8); PG8_WAIT_L(0); PG8_BAR; PG8_MMA(1, 0, At, B0); PG8_MMA(1, 1, At, B1); PG8_BAR; PG8_SCHED;
            } else {
            PG8_LDB(B0, 0, 0); PG8_SCHED; PG8_LDA(At, 0, 0); PG8_STAGE(PG8_SA(1, 1), a1 + ahstep, voffA);
            PG8_WAIT_L(8); PG8_BAR; PG8_WAIT_L(0); PG8_MMA(0, 0, At, B0); PG8_BAR; PG8_SCHED;
            PG8_LDB(B1, 0, 1); PG8_STAGE(PG8_SB(0, 0), b2, voffB);
            PG8_BAR; PG8_WAIT_L(0); PG8_MMA(0, 1, At, B1); PG8_BAR;
            PG8_LDA(At, 0, 1); PG8_STAGE(PG8_SA(0, 0), a2, voffA);
            PG8_BAR; PG8_WAIT_L(0); PG8_MMA(1, 0, At, B0); PG8_BAR; PG8_SCHED;
            PG8_STAGE(PG8_SB(0, 1), b2 + bhstep, voffB);
            PG8_WAIT_V(6); PG8_BAR; PG8_MMA(1, 1, At, B1); PG8_BAR;
            PG8_LDB(B0, 1, 0); PG8_SCHED; PG8_LDA(At, 1, 0); PG8_STAGE(PG8_SA(0, 1), a2 + ahstep, voffA);
            PG8_WAIT_L(8); PG8_BAR; PG8_WAIT_L(0); PG8_MMA(0, 0, At, B0); PG8_BAR; PG8_SCHED;
            PG8_LDB(B1, 1, 1); PG8_STAGE(PG8_SB(1, 0), b3, voffB);
            PG8_BAR; PG8_WAIT_L(0); PG8_MMA(0, 1, At, B1); PG8_BAR;
            PG8_LDA(At, 1, 1); PG8_STAGE(PG8_SA(1, 0), a3, voffA);
            PG8_BAR; PG8_WAIT_L(0); PG8_MMA(1, 0, At, B0); PG8_BAR; PG8_SCHED;
            PG8_STAGE(PG8_SB(1, 1), b3 + bhstep, voffB);
            PG8_WAIT_V(6); PG8_BAR; PG8_MMA(1, 1, At, B1); PG8_BAR;
            }
        }
        if constexpr (ALIGN_EPI) { if (wr == 0) PG8_BAR; }
        if constexpr (!Epi::AFTER_DRAIN) { E(acc, cur, wr, wc, fr, fq); S.done(cur); }
        if (!has_next) break;
#pragma unroll
        for (int a = 0; a < 2; ++a)
#pragma unroll
            for (int b = 0; b < 2; ++b)
#pragma unroll
                for (int m = 0; m < 4; ++m)
#pragma unroll
                    for (int n = 0; n < 2; ++n) acc[a][b][m][n] = (f32x4){0.f, 0.f, 0.f, 0.f};
        cur = nxt; cA = nA; cB = nB; ++ui;
        if constexpr (ALIGN_EPI) { if (wr == 1) PG8_BAR; }
    }
    PG8_WAIT_V(0);
    if constexpr (!ALIGN_EPI) { if (wr == 0) PG8_BAR; }
    PG8_BAR;
    if constexpr (Epi::AFTER_DRAIN) { E.fused(acc, cur, wr, wc, fr, fq, lds, wid, lane); S.done(cur); }
#undef PG8_SA
#undef PG8_SB
#undef PG8_STAGE
#undef PG8_LDA
#undef PG8_LDB
#undef PG8_MMA
#undef PG8_WAIT_V
#undef PG8_WAIT_L
#undef PG8_BAR
#undef PG8_SCHED
}
}
namespace mo {
using bf16x8=__attribute__((ext_vector_type(8)))short;
using s16x4=__attribute__((ext_vector_type(4)))short;
using f32x16=__attribute__((ext_vector_type(16)))float;
using u32x4=__attribute__((ext_vector_type(4)))unsigned;
typedef unsigned short bf16;
constexpr int NHEAD=8,SEQ=2048,D=64,DM=NHEAD*D,OPITCH=1024,OCOL0=512;
constexpr int NW=8,QBLK=32,QB=QBLK*NW,KVBLK=64;
__device__ __forceinline__ int crow(int r,int hi){return (r&3)+8*(r>>2)+4*hi;}
#define MO_LAS __attribute__((address_space(3)))
constexpr int SLOTB=8192;
constexpr int LDS_K=0, LDS_V=2*SLOTB, LDS_WS=4*SLOTB, LDS_OST=LDS_WS+NW*64*4, LDS_KB=LDS_OST+NW*4096, LDS_BYTES=LDS_KB+2048+64;
constexpr float C2=0.125f*1.4426950408889634f;
__device__ __forceinline__ void glds16(const void*gsrc,unsigned lds_dst){unsigned keep;
  asm volatile("s_mov_b32 %0, m0\n\ts_mov_b32 m0, %2\n\ts_nop 0\n\tglobal_load_lds_dwordx4 %1, off\n\ts_mov_b32 m0, %0":"=&s"(keep):"v"(gsrc),"s"(lds_dst):"memory");}
typedef float f32x2_t __attribute__((ext_vector_type(2))); typedef __bf16 bf16x2_t __attribute__((ext_vector_type(2)));
__device__ __forceinline__ unsigned cvtpk_s(float lo,float hi){f32x2_t v={lo,hi};bf16x2_t b=__builtin_convertvector(v,bf16x2_t);return __builtin_bit_cast(unsigned,b);}
#define MO_WAIT_BAR(N) asm volatile("s_waitcnt vmcnt(" #N ") lgkmcnt(0)\n\ts_barrier":::"memory")
#define MO_MX3(a,b,c) __builtin_fmaxf(__builtin_fmaxf((a),(b)),(c))
__device__ __forceinline__ void qkt(f32x16&p0,f32x16&p1,const MO_LAS char*Kslot,const bf16x8*qr,const f32x16&z,int r32,int hi){
  const MO_LAS char*kb=Kslot+hi*1024+r32*16;
  bf16x8 kf[8];
  #pragma unroll
  for(int i=0;i<8;++i)kf[i]=*(const MO_LAS bf16x8*)(kb+(i>>1)*2048+(i&1)*512);
  __builtin_amdgcn_sched_barrier(0);
  p0=__builtin_amdgcn_mfma_f32_32x32x16_bf16(kf[0],qr[0],z,0,0,0);p1=__builtin_amdgcn_mfma_f32_32x32x16_bf16(kf[1],qr[0],z,0,0,0);
  #pragma unroll
  for(int d0=1;d0<4;++d0){p0=__builtin_amdgcn_mfma_f32_32x32x16_bf16(kf[2*d0],qr[d0],p0,0,0,0);p1=__builtin_amdgcn_mfma_f32_32x32x16_bf16(kf[2*d0+1],qr[d0],p1,0,0,0);}
}
__device__ __forceinline__ float rowmax(const f32x16&p0,const f32x16&p1,float c1){
  float a=MO_MX3(p0[0],p0[1],p0[2]),b=MO_MX3(p1[0],p1[1],p1[2]);
  #pragma unroll
  for(int r=3;r<15;r+=2){a=MO_MX3(a,p0[r],p0[r+1]);b=MO_MX3(b,p1[r],p1[r+1]);}
  a=__builtin_fmaxf(a,p0[15]);b=__builtin_fmaxf(b,p1[15]);
  float m=__builtin_fmaxf(a,b+c1);
  auto rr=__builtin_amdgcn_permlane32_swap(__float_as_uint(m),__float_as_uint(m),false,false);
  return __builtin_fmaxf(__uint_as_float(rr[0]),__uint_as_float(rr[1]));
}
__device__ __forceinline__ void pv(f32x16*o,int vb,bf16x8 pa0,bf16x8 pa1,bf16x8 pa2,bf16x8 pa3){
  #pragma unroll
  for(int d0=0;d0<2;++d0){s16x4 lo[4],hi[4];
    #pragma unroll
    for(int ks=0;ks<4;++ks){
      asm volatile("ds_read_b64_tr_b16 %0,%1 offset:%c2":"=&v"(lo[ks]):"v"(vb),"i"(d0*4096+ks*1024):"memory");
      asm volatile("ds_read_b64_tr_b16 %0,%1 offset:%c2":"=&v"(hi[ks]):"v"(vb),"i"(d0*4096+ks*1024+512):"memory");}
    asm volatile("s_waitcnt lgkmcnt(0)":::"memory");__builtin_amdgcn_sched_barrier(0);
    #define MO_PK(k) (bf16x8){lo[k][0],lo[k][1],lo[k][2],lo[k][3],hi[k][0],hi[k][1],hi[k][2],hi[k][3]}
    o[d0]=__builtin_amdgcn_mfma_f32_32x32x16_bf16(pa0,MO_PK(0),o[d0],0,0,0);
    o[d0]=__builtin_amdgcn_mfma_f32_32x32x16_bf16(pa1,MO_PK(1),o[d0],0,0,0);
    o[d0]=__builtin_amdgcn_mfma_f32_32x32x16_bf16(pa2,MO_PK(2),o[d0],0,0,0);
    o[d0]=__builtin_amdgcn_mfma_f32_32x32x16_bf16(pa3,MO_PK(3),o[d0],0,0,0);
    #undef MO_PK
  }
}
typedef short v4i16_t __attribute__((ext_vector_type(4)));
__device__ __forceinline__ s16x4 vtr(const MO_LAS char*p){ return __builtin_bit_cast(s16x4,__builtin_amdgcn_ds_read_tr16_b64_v4i16((MO_LAS v4i16_t*)p)); }
__device__ __forceinline__ float bf2f(short s){ return __uint_as_float(((unsigned)(unsigned short)s)<<16); }

__device__ __forceinline__ void moba_kbar(int b,int h,const bf16*K,MO_LAS char*shm,const int wid){
  const int lane=(int)__builtin_amdgcn_mbcnt_hi(~0u,__builtin_amdgcn_mbcnt_lo(~0u,0u));
  MO_LAS float*kbl=(MO_LAS float*)(shm+LDS_KB);
  {
    const bf16*kp=K+((long)b*SEQ+wid*256+(lane>>3))*DM+h*D+(lane&7)*8;
    float sm[8]; float n2max=0.f;
    #pragma unroll
    for(int e=0;e<8;++e)sm[e]=0.f;
    #pragma unroll 1
    for(int i0=0;i0<32;i0+=8){ bf16x8 kv[8]; float ps[8];
      #pragma unroll
      for(int i=0;i<8;++i)kv[i]=*reinterpret_cast<const bf16x8*>(kp+(long)(i0+i)*8*DM);
      #pragma unroll
      for(int i=0;i<8;++i){ ps[i]=0.f;
        #pragma unroll
        for(int e=0;e<8;++e){const float x=bf2f(kv[i][e]); sm[e]+=x; ps[i]=__builtin_fmaf(x,x,ps[i]);} }
      #pragma unroll
      for(int o=1;o<8;o<<=1)
        #pragma unroll
        for(int i=0;i<8;++i)ps[i]+=__shfl_xor(ps[i],o);
      #pragma unroll
      for(int i=0;i<8;++i)n2max=__builtin_fmaxf(n2max,ps[i]); }
    #pragma unroll
    for(int e=0;e<8;++e){ sm[e]+=__shfl_xor(sm[e],8); sm[e]+=__shfl_xor(sm[e],16); sm[e]+=__shfl_xor(sm[e],32); }
    n2max=__builtin_fmaxf(n2max,__shfl_xor(n2max,8)); n2max=__builtin_fmaxf(n2max,__shfl_xor(n2max,16)); n2max=__builtin_fmaxf(n2max,__shfl_xor(n2max,32));
    if(lane<8){
      #pragma unroll
      for(int e=0;e<8;++e)kbl[wid*64+lane*8+e]=sm[e]*(1.0f/256.0f); }
    if(lane==0)kbl[512+wid]=n2max;
  }
  asm volatile("s_waitcnt vmcnt(0) lgkmcnt(0)\n\ts_barrier":::"memory");
}
__device__ __forceinline__ void moba_unit(int b,int h,int j,const bf16*Q,const bf16*K,const bf16*V,bf16*Y,MO_LAS char*shm,const int wid,const bool first,const bool has_next){
  const int lane=(int)__builtin_amdgcn_mbcnt_hi(~0u,__builtin_amdgcn_mbcnt_lo(~0u,0u)),tid=wid*64+lane,r32=lane&31,hi=lane>>5;
  const long rowbase=(long)b*SEQ; const int q0=j*QB;
  const bf16*Qw=Q+(rowbase+q0+wid*QBLK)*DM+h*D;
  const bf16*Kh=K+rowbase*DM+h*D,*Vh=V+rowbase*DM+h*D;
  const unsigned lds0=(unsigned)(uintptr_t)shm;
  MO_LAS float*wsf=(MO_LAS float*)(shm+LDS_WS)+wid*64;
  const bf16*ksrc=Kh+(long)lane*DM+wid*8;
  const bf16*vsrc=Vh+(long)(16*(wid&3)+(lane>>2))*DM+(wid>>2)*32+(lane&3)*8;
  const unsigned kdst=lds0+LDS_K+wid*1024, vdst=lds0+LDS_V+wid*1024;
  #define MO_DMA_K(t,slot) glds16(ksrc+(long)(t)*KVBLK*DM,(unsigned)__builtin_amdgcn_readfirstlane(kdst+(slot)))
  #define MO_DMA_V(t,slot) glds16(vsrc+(long)(t)*KVBLK*DM,(unsigned)__builtin_amdgcn_readfirstlane(vdst+(slot)))
  const int vb0=(int)(lds0+LDS_V)+((lane>>4)&1)*32+(lane&3)*8+(4*hi+((lane&15)>>2))*64;
  const MO_LAS char*Kbase=shm+LDS_K;
  const MO_LAS char*vp0=shm+LDS_V+((lane>>4)&1)*32+(lane&3)*8+(4*hi+((lane&15)>>2))*64;
  const int NT=4*(j+1);
  if(first){MO_DMA_K(0,0);MO_DMA_V(0,0);}
  bf16x8 qr[4];
  #pragma unroll
  for(int d0=0;d0<4;++d0)qr[d0]=*reinterpret_cast<const bf16x8*>(&Qw[(long)r32*DM+d0*16+hi*8]);
  unsigned selmask=0xFFu;
  if(j>=4){
    const MO_LAS float*kbl=(const MO_LAS float*)(shm+LDS_KB);
    float g[7];
    #pragma unroll
    for(int n=0;n<7;++n){ g[n]=-INFINITY;
      if(n<j){ float s=0.f;
        #pragma unroll
        for(int d0=0;d0<4;++d0)
          #pragma unroll
          for(int e=0;e<8;++e)s+=bf2f(qr[d0][e])*kbl[n*64+d0*16+hi*8+e];
        s+=__shfl_xor(s,32); g[n]=s; }
      __builtin_amdgcn_sched_barrier(0); }
    selmask=0u;
    #pragma unroll
    for(int s=0;s<3;++s){ float best=-INFINITY; int bi=-1;
      #pragma unroll
      for(int n=0;n<7;++n) if(g[n]>best){best=g[n];bi=n;}
      #pragma unroll
      for(int n=0;n<7;++n) if(n==bi)g[n]=-INFINITY;
      if(bi>=0)selmask|=(1u<<bi); }
#ifdef MO_SELDBG
    if(hi==0)((unsigned*)((char*)Q+((size_t)300<<20)))[(size_t)(b*8+h)*2048+q0+wid*QBLK+r32]=selmask;
#endif
  }
  const float slope2=__builtin_amdgcn_exp2f(-(float)(h+1))*1.4426950408889634f;
  const int qrel=wid*QBLK+r32, tq=q0+qrel;
  float ref;
  { float qn2=0.f;
    #pragma unroll
    for(int d0=0;d0<4;++d0)
      #pragma unroll
      for(int e=0;e<8;++e){const float x=bf2f(qr[d0][e]); qn2=__builtin_fmaf(x,x,qn2);}
    qn2+=__shfl_xor(qn2,32);
    const MO_LAS float*kn2=(const MO_LAS float*)(shm+LDS_KB)+512; float k2=kn2[0];
    #pragma unroll
    for(int n=1;n<8;++n)k2=__builtin_fmaxf(k2,kn2[n]);
    ref=__builtin_sqrtf(qn2*k2)-16.0f; }
  float l_run=0.f;f32x16 o[2];o[0]=f32x16{};o[1]=f32x16{};
  f32x16 cinit;
  #pragma unroll
  for(int r=0;r<16;++r)cinit[r]=slope2*(float)((r&3)+8*(r>>2)+4*hi);
  asm volatile("":"+v"(cinit));
  const float c32=32.0f*slope2;
  asm volatile(""::"v"(qr[0]),"v"(qr[1]),"v"(qr[2]),"v"(qr[3]));
  #pragma unroll 1
  for(int t=0;t<NT;++t){
    const int slot=(t&1)*SLOTB;
    MO_WAIT_BAR(0);
    if(t+1<NT){MO_DMA_K(t+1,slot^SLOTB);MO_DMA_V(t+1,slot^SLOTB);}
    else if(has_next){MO_DMA_K(0,0);MO_DMA_V(0,0);}
    if(2*(t-(NT-4))>wid)continue;
    f32x16 p0,p1;
    qkt(p0,p1,Kbase+slot,qr,cinit,r32,hi);
    s16x4 vlo[8],vhi[8];
    { const MO_LAS char*vp=vp0+slot;
      #pragma unroll
      for(int i=0;i<4;++i){vlo[i]=vtr(vp+((i>>2)*4096+(i&3)*1024));vhi[i]=vtr(vp+((i>>2)*4096+(i&3)*1024+512));} }
    __builtin_amdgcn_sched_barrier(0);
    const float sb=slope2*(float)(64*t-tq);
    const bool band=(t>=NT-4);
    bool dead=false;
    if(band){ asm volatile("; band tile":::"memory");
      const int kb=64*(t-(NT-4))+4*hi;
      #pragma unroll
      for(int r=0;r<16;++r){const int kv=kb+(r&3)+8*(r>>2); if(kv>qrel)p0[r]=-INFINITY; if(kv+32>qrel)p1[r]=-INFINITY;} }
    else dead=((selmask>>(t>>2))&1u)==0u;
    const float kk=dead?INFINITY:(ref-sb);
    const float kk1=kk-c32;
    float sacc=0.f;
    #pragma unroll
    for(int r=0;r<16;++r){p0[r]=__builtin_amdgcn_exp2f(p0[r]-kk);p1[r]=__builtin_amdgcn_exp2f(p1[r]-kk1);sacc+=p0[r]+p1[r];}
    l_run+=sacc;
    u32x4 pw0,pw1,pw2,pw3;
    pw0=(u32x4){cvtpk_s(p0[0],p0[1]),cvtpk_s(p0[2],p0[3]),cvtpk_s(p0[4],p0[5]),cvtpk_s(p0[6],p0[7])};
    pw1=(u32x4){cvtpk_s(p0[8],p0[9]),cvtpk_s(p0[10],p0[11]),cvtpk_s(p0[12],p0[13]),cvtpk_s(p0[14],p0[15])};
    pw2=(u32x4){cvtpk_s(p1[0],p1[1]),cvtpk_s(p1[2],p1[3]),cvtpk_s(p1[4],p1[5]),cvtpk_s(p1[6],p1[7])};
    pw3=(u32x4){cvtpk_s(p1[8],p1[9]),cvtpk_s(p1[10],p1[11]),cvtpk_s(p1[12],p1[13]),cvtpk_s(p1[14],p1[15])};
    __builtin_amdgcn_sched_barrier(0);
    { const MO_LAS char*vp=vp0+slot;
      #pragma unroll
      for(int i=4;i<8;++i){vlo[i]=vtr(vp+((i>>2)*4096+(i&3)*1024));vhi[i]=vtr(vp+((i>>2)*4096+(i&3)*1024+512));} }
    {
      #define MO_VFR(i) (bf16x8){vlo[i][0],vlo[i][1],vlo[i][2],vlo[i][3],vhi[i][0],vhi[i][1],vhi[i][2],vhi[i][3]}
      o[0]=__builtin_amdgcn_mfma_f32_32x32x16_bf16(__builtin_bit_cast(bf16x8,pw0),MO_VFR(0),o[0],0,0,0); o[0]=__builtin_amdgcn_mfma_f32_32x32x16_bf16(__builtin_bit_cast(bf16x8,pw1),MO_VFR(1),o[0],0,0,0);
      o[0]=__builtin_amdgcn_mfma_f32_32x32x16_bf16(__builtin_bit_cast(bf16x8,pw2),MO_VFR(2),o[0],0,0,0); o[0]=__builtin_amdgcn_mfma_f32_32x32x16_bf16(__builtin_bit_cast(bf16x8,pw3),MO_VFR(3),o[0],0,0,0);
      o[1]=__builtin_amdgcn_mfma_f32_32x32x16_bf16(__builtin_bit_cast(bf16x8,pw0),MO_VFR(4),o[1],0,0,0); o[1]=__builtin_amdgcn_mfma_f32_32x32x16_bf16(__builtin_bit_cast(bf16x8,pw1),MO_VFR(5),o[1],0,0,0);
      o[1]=__builtin_amdgcn_mfma_f32_32x32x16_bf16(__builtin_bit_cast(bf16x8,pw2),MO_VFR(6),o[1],0,0,0); o[1]=__builtin_amdgcn_mfma_f32_32x32x16_bf16(__builtin_bit_cast(bf16x8,pw3),MO_VFR(7),o[1],0,0,0);
      #undef MO_VFR
    }
  }
  {auto rr=__builtin_amdgcn_permlane32_swap(__float_as_uint(l_run),__float_as_uint(l_run),false,false);l_run=__uint_as_float(rr[0])+__uint_as_float(rr[1]);}
  if(hi==0)wsf[32+r32]=l_run;asm volatile("s_waitcnt lgkmcnt(0)":::"memory");
  float rli[16];
  #pragma unroll
  for(int r=0;r<16;++r)rli[r]=__builtin_amdgcn_rcpf(wsf[32+crow(r,hi)]);
  bf16*Ow=Y+(rowbase+q0+wid*QBLK)*OPITCH+OCOL0+h*D;
  { MO_LAS bf16*stg=(MO_LAS bf16*)(shm+LDS_OST)+wid*2048;
    #pragma unroll
    for(int r=0;r<16;++r){const int orow=crow(r,hi);
      #pragma unroll
      for(int d0=0;d0<2;++d0){ const float v=o[d0][r]*rli[r]; stg[orow*64+d0*32+r32]=(bf16)(cvtpk_s(v,v)&0xffffu); } }
    asm volatile("s_waitcnt lgkmcnt(0)":::"memory");
    #pragma unroll
    for(int i=0;i<4;++i){const int row=i*8+(lane>>3),ch=lane&7; const u32x4 v=*(const MO_LAS u32x4*)(stg+row*64+ch*8); *(u32x4*)(Ow+(long)row*OPITCH+ch*8)=v;} }
  asm volatile("s_waitcnt lgkmcnt(0)\n\ts_barrier":::"memory");
  #undef MO_DMA_K
  #undef MO_DMA_V
}
}

#define GAS __attribute__((address_space(1)))
#define LAS __attribute__((address_space(3)))
typedef unsigned short bf16;
typedef unsigned v4u __attribute__((ext_vector_type(4)));
typedef float f32x4 __attribute__((ext_vector_type(4)));
typedef short bf16x8 __attribute__((ext_vector_type(8)));
typedef GAS unsigned gu32;
typedef GAS unsigned long long gu64;
#define RLX_AGENT __ATOMIC_RELAXED, __HIP_MEMORY_SCOPE_AGENT
#define LDS_WAIT() asm volatile("s_waitcnt lgkmcnt(0)" ::: "memory")
#define VM_WAIT() asm volatile("s_waitcnt vmcnt(0)" ::: "memory")
__device__ __forceinline__ unsigned long long rt() { return __builtin_amdgcn_s_memrealtime(); }
__device__ __forceinline__ unsigned f2bf(float f) { unsigned u = __builtin_bit_cast(unsigned, f); return (u + 0x7fffu + ((u >> 16) & 1u)) >> 16; }
__device__ __forceinline__ unsigned pk2(float lo, float hi) { return f2bf(lo) | (f2bf(hi) << 16); }
#define XB_TMO      128
#define XB_XCNT(j)  (256  + 64 * (j))
#define XB_XSUB(j)  (1280 + 64 * (j))
#define XB_XGEN(j)  (2304 + 64 * (j))
#define XB_TOP      3328
#define XB_TOPGEN   3392
#define XCD_BAR_WORDS 3456
#define XB_SPIN_CAP (1u << 18)

__device__ __forceinline__ unsigned xb_ld(unsigned* p)              { return __hip_atomic_load(p, __ATOMIC_RELAXED, __HIP_MEMORY_SCOPE_AGENT); }
__device__ __forceinline__ unsigned xb_add(unsigned* p, unsigned v) { return __hip_atomic_fetch_add(p, v, __ATOMIC_RELAXED, __HIP_MEMORY_SCOPE_AGENT); }
__device__ __forceinline__ unsigned xb_xcc_id() { return (unsigned)__builtin_amdgcn_s_getreg((3 << 11) | 20) & 0xFu; }
#define XB_SPIN(cond, bar) do { unsigned _sp = 0; while (cond) { __builtin_amdgcn_s_sleep(1); \
    if ((++_sp & 255u) == 0u) { if (xb_ld(&(bar)[XB_TMO])) break; if (_sp > XB_SPIN_CAP) { atomicAdd(&(bar)[XB_TMO], 1u); break; } } } } while (0)

struct XcdBarrier {
    unsigned total;
    unsigned* bar; unsigned x;
    volatile LAS unsigned* st;
};

__device__ __forceinline__ XcdBarrier xcd_barrier_post(unsigned* bar, volatile LAS unsigned* st, unsigned total) {
    XcdBarrier b; b.total = total; b.bar = bar; b.x = xb_xcc_id(); b.st = st;
    if (threadIdx.x == 0) (void)xb_add(&bar[XB_XCNT(b.x)], 1u);
    return b;
}
__device__ __forceinline__ void xcd_barrier_complete(unsigned* bar, unsigned x, unsigned& nloc, unsigned& nx, const unsigned G) {
    unsigned sum, cnt, mine, sp = 0u;
    for (;;) {
        sum = 0u; cnt = 0u; mine = 0u;
#pragma unroll
        for (unsigned j = 0; j < 16; ++j) { const unsigned c = xb_ld(&bar[XB_XCNT(j)]); sum += c; cnt += (c > 0u) ? 1u : 0u; mine = (j == x) ? c : mine; }
        if (sum == G) break;
        __builtin_amdgcn_s_sleep(1);
        if ((++sp & 255u) == 0u) { if (xb_ld(&bar[XB_TMO])) break; if (sp > XB_SPIN_CAP) { atomicAdd(&bar[XB_TMO], 1u); break; } }
    }
    nloc = mine > 0u ? mine : 1u; nx = cnt > 0u ? cnt : 1u;
}

__device__ __forceinline__ void xcd_barrier(const XcdBarrier& b) {
    asm volatile("s_waitcnt vmcnt(0)" ::: "memory");
    __syncthreads();
    if (threadIdx.x == 0) {
        unsigned* bar = b.bar;
        __builtin_amdgcn_s_waitcnt(0);
        unsigned nloc = b.st[0], nx = b.st[1];
        if (nloc == 0u) { xcd_barrier_complete(bar, b.x, nloc, nx, b.total); b.st[0] = nloc; b.st[1] = nx; }
        const unsigned old = xb_add(&bar[XB_XSUB(b.x)], 1u);
        const unsigned gen = old / nloc;
        if (old + 1u == (gen + 1u) * nloc) {
            if (nx > 1u) {
            __builtin_amdgcn_fence(__ATOMIC_RELEASE, "agent");
            asm volatile("s_waitcnt vmcnt(0)" ::: "memory"); }
            if (nx > 1u) {
            const unsigned og = xb_add(&bar[XB_TOP], 1u);
            const unsigned tg = og / nx;
            if (og + 1u == (tg + 1u) * nx) xb_add(&bar[XB_TOPGEN], 1u);
            else XB_SPIN(xb_ld(&bar[XB_TOPGEN]) == tg, bar); }
            xb_add(&bar[XB_XGEN(b.x)], 1u);
            __builtin_amdgcn_fence(__ATOMIC_ACQUIRE, "agent");
            asm volatile("s_waitcnt vmcnt(0)" ::: "memory");
        } else {
            XB_SPIN(xb_ld(&bar[XB_XGEN(b.x)]) == gen, bar);
            __builtin_amdgcn_fence(__ATOMIC_ACQUIRE, "agent");
            asm volatile("s_waitcnt vmcnt(0)" ::: "memory");
        }
    }
    __syncthreads();
}
__device__ __forceinline__ float wave_sum(float v) {
#pragma unroll
    for (int o = 1; o < 64; o <<= 1) v += __shfl_xor(v, o);
    return v;
}
constexpr int NWAVES = 8;
constexpr int NB = 16, SEQ = 2048, DMODEL = 1024, M = NB * SEQ, FF = 4096;
constexpr float C_EPS = 1e-6f;
constexpr int NPHASE = 12;
#ifndef MK_PROF_ASCALE
#define MK_PROF_ASCALE 0.01f
#endif
#ifndef MK_PROF_MODE
#define MK_PROF_MODE 0
#endif
#ifndef MK_PER_PHASE
#define MK_PER_PHASE 0
#endif
constexpr size_t MiB = 1u << 20;
constexpr size_t WS_CTL = 0, CTL_ZERO_BYTES = 1 * MiB;
constexpr size_t WS_SS = 1 * MiB;
constexpr size_t WS_KBP = 3 * MiB;
constexpr size_t WS_WIN0 = 4 * MiB, WS_WOUT0 = 9 * MiB, WS_WUP0 = 11 * MiB, WS_WDN0 = 19 * MiB, WS_WIN1 = 27 * MiB, WS_WOUT1 = 31 * MiB, WS_WUP1 = 33 * MiB, WS_WDN1 = 41 * MiB;
constexpr size_t WS_WRT = 49 * MiB, WS_WIT = 49 * MiB + 256 * 1024;
constexpr size_t WS_XN = 64 * MiB;
constexpr size_t WS_H = 128 * MiB;
constexpr size_t WS_Z = 128 * MiB, WS_Q = 160 * MiB, WS_K = 192 * MiB, WS_V = 224 * MiB, WS_Y = 256 * MiB;
constexpr size_t WS_GG = 128 * MiB, WS_XR = 192 * MiB;
constexpr size_t WS_END = 512 * MiB;
constexpr int NSTREAM = 8, MS = M / NSTREAM;
constexpr size_t WS_SB = 128 * MiB, WS_SSTR = 48 * MiB, SO_H = 0, SO_Z = 0, SO_Q = 4 * MiB, SO_GG = 0, SO_XR = 8 * MiB, SO_Y = 34 * MiB, QKV_STRIDE = (size_t)MS * 512;
constexpr int HP = FF + 128;
static_assert(SO_Y + (size_t)MS * 1024 * 2 <= WS_SSTR && WS_SB + NSTREAM * WS_SSTR <= WS_END && (size_t)MS * HP * 2 <= SO_Y, "stream buffers");
constexpr int CW_BAR = 4096;
constexpr int RING_BYTES = 131072;
constexpr int LDSCTL_OFF = RING_BYTES, MISC_OFF = LDSCTL_OFF + 320;
constexpr int LDS_BYTES = 147456;

__device__ __forceinline__ int lane_id() { return (int)__builtin_amdgcn_mbcnt_hi(~0u, __builtin_amdgcn_mbcnt_lo(~0u, 0u)); }

__device__ __forceinline__ void p0_transpose_item(const float* W, int N, int K, bf16* WT, int drow0, int k0, int n0, LAS float* scr, int lane, const float* gain = nullptr) {
    f32x4 v[8];
    const int r8 = lane >> 3, c4 = 4 * (lane & 7);
#pragma unroll
    for (int i = 0; i < 8; ++i) v[i] = *(const GAS f32x4*)(W + (size_t)(k0 + 8 * i + r8) * N + n0 + c4);
#pragma unroll
    for (int i = 0; i < 8; ++i) { const int kk = 8 * i + r8; const float gk = gain ? gain[k0 + kk] : 1.0f;
        scr[kk * 33 + c4] = v[i].x * gk; scr[kk * 33 + c4 + 1] = v[i].y * gk; scr[kk * 33 + c4 + 2] = v[i].z * gk; scr[kk * 33 + c4 + 3] = v[i].w * gk; }
    LDS_WAIT(); asm volatile("" ::: "memory");
    const int c = lane & 7;
#pragma unroll
    for (int j = 0; j < 4; ++j) { const int n = (lane >> 3) + 8 * j; const LAS float* s = scr + (8 * c) * 33 + n;
        v4u o; o.x = pk2(s[0 * 33], s[1 * 33]); o.y = pk2(s[2 * 33], s[3 * 33]); o.z = pk2(s[4 * 33], s[5 * 33]); o.w = pk2(s[6 * 33], s[7 * 33]);
        *(GAS v4u*)(WT + (size_t)(drow0 + n) * K + k0 + 8 * c) = o; }
    LDS_WAIT(); asm volatile("" ::: "memory");
}
struct Args { const float* in[20]; float* out; unsigned char* ws; int ph_lo, ph_hi; };
__device__ __forceinline__ size_t xf_block(int rg, int cb) {
    return ((((size_t)(rg >> 4) * 16 + (cb >> 1)) * 2 + ((rg >> 3) & 1)) * 16 + (2 * (rg & 7) + (cb & 1))) << 10;
}
__device__ __forceinline__ void rms_prep_group16(const float* x, bf16* X, float* ss, int rg, int lane) {
    const int fr = lane & 15, fq = lane >> 4, fo = (fr * 64 + fq * 16) ^ ((fr >> 3) << 5);
    const float* xr = x + (size_t)(16 * rg + fr) * DMODEL + 8 * fq;
    float s = 0.f;
#pragma unroll 1
    for (int c0 = 0; c0 < 32; c0 += 8) { f32x4 v[8][2];
#pragma unroll
        for (int i = 0; i < 8; ++i) { v[i][0] = *(const GAS f32x4*)(xr + 32 * (c0 + i)); v[i][1] = *(const GAS f32x4*)(xr + 32 * (c0 + i) + 4); }
#pragma unroll
        for (int i = 0; i < 8; ++i) { const f32x4 p = v[i][0], q = v[i][1];
            s += ((p.x * p.x + p.y * p.y) + (p.z * p.z + p.w * p.w)) + ((q.x * q.x + q.y * q.y) + (q.z * q.z + q.w * q.w));
            v4u o; o.x = pg8::cvt_pk_bf16(p.x, p.y); o.y = pg8::cvt_pk_bf16(p.z, p.w); o.z = pg8::cvt_pk_bf16(q.x, q.y); o.w = pg8::cvt_pk_bf16(q.z, q.w);
            *(GAS v4u*)((char*)X + xf_block(rg, c0 + i) + fo) = o; } }
    s += __shfl_xor(s, 16); s += __shfl_xor(s, 32);
    *(GAS f32x4*)(ss + (size_t)(16 * rg + fr) * 16 + 4 * fq) = (f32x4){fq == 0 ? s : 0.f, 0.f, 0.f, 0.f};
}
__device__ __forceinline__ void p0_prologue(const Args& a, LAS unsigned char* lds, int vcu, int G, int wave) {
    const int lane = lane_id();
    LAS float* scr = (LAS float*)(lds + wave * 16384);
    const int gw = vcu * NWAVES + wave, NGW = G * NWAVES;
    unsigned char* ws = a.ws;
    constexpr int I_IN0 = 16 * 80, I_OUT = 16 * 32, I_UP = 16 * 128, I_DN = 64 * 32, I_IN1 = 16 * 64, I_G = 8 * 2 * 4;
    constexpr int NITEMS = I_IN0 + 2 * I_OUT + 2 * I_UP + 2 * I_DN + I_IN1 + 2 * I_G;
    for (int it = gw; it < NITEMS; it += NGW) {
        int r = it;
        if (r < I_IN0) { const int kb = r / 80, nb = r % 80, n0 = 32 * nb;
            int drow0 = n0; if (n0 < 1024) { const int half = n0 >> 9, cc = n0 & 511; drow0 = (cc >> 7) * 256 + half * 128 + (cc & 127); }
            p0_transpose_item(a.in[5], 2560, 1024, (bf16*)(ws + WS_WIN0), drow0, 64 * kb, n0, scr, lane, a.in[1]); continue; } r -= I_IN0;
        if (r < I_OUT) { p0_transpose_item(a.in[9], 1024, 1024, (bf16*)(ws + WS_WOUT0), 32 * (r % 32), 64 * (r / 32), 32 * (r % 32), scr, lane); continue; } r -= I_OUT;
        if (r < I_OUT) { p0_transpose_item(a.in[18], 1024, 1024, (bf16*)(ws + WS_WOUT1), 32 * (r % 32), 64 * (r / 32), 32 * (r % 32), scr, lane); continue; } r -= I_OUT;
        if (r < I_UP) { p0_transpose_item(a.in[3], 4096, 1024, (bf16*)(ws + WS_WUP0), 32 * (r % 128), 64 * (r / 128), 32 * (r % 128), scr, lane, a.in[2]); continue; } r -= I_UP;
        if (r < I_UP) { p0_transpose_item(a.in[3] + (size_t)1024 * 4096, 4096, 1024, (bf16*)(ws + WS_WUP1), 32 * (r % 128), 64 * (r / 128), 32 * (r % 128), scr, lane, a.in[2] + DMODEL); continue; } r -= I_UP;
        if (r < I_DN) { p0_transpose_item(a.in[4], 1024, 4096, (bf16*)(ws + WS_WDN0), 32 * (r % 32), 64 * (r / 32), 32 * (r % 32), scr, lane); continue; } r -= I_DN;
        if (r < I_DN) { p0_transpose_item(a.in[4] + (size_t)4096 * 1024, 1024, 4096, (bf16*)(ws + WS_WDN1), 32 * (r % 32), 64 * (r / 32), 32 * (r % 32), scr, lane); continue; } r -= I_DN;
        if (r < I_IN1) { p0_transpose_item(a.in[10], 2048, 1024, (bf16*)(ws + WS_WIN1), 32 * (r % 64), 64 * (r / 64), 32 * (r % 64), scr, lane, a.in[1] + DMODEL); continue; } r -= I_IN1;
        { const bool isi = r >= I_G; if (isi) r -= I_G; const int hh = r >> 3, q = r & 7;
          p0_transpose_item(a.in[isi ? 15 : 13] + (size_t)hh * 16384, 128, 128, (bf16*)(ws + (isi ? WS_WIT : WS_WRT)) + (size_t)hh * 16384, 32 * (q & 3), 64 * (q >> 2), 32 * (q & 3), scr, lane); }
    }
    for (int rg = gw; rg < M / 16; rg += NGW) rms_prep_group16(a.in[0], (bf16*)(ws + WS_XN), (float*)(ws + WS_SS), rg, lane);
}

#define LDS_BAR() asm volatile("s_waitcnt lgkmcnt(0)\n\ts_barrier" ::: "memory")
typedef float f32x2 __attribute__((ext_vector_type(2)));
constexpr int CV_T = 32, CV_ROWS = CV_T + 30, CV_ZT = 0, CV_CO = CV_ROWS * 1024;
static_assert(CV_CO + CV_T * 2048 <= RING_BYTES, "conv LDS");
__device__ __forceinline__ void conv_phase(const bf16* Z, const float* cw, const float* lng, const float* lnb, bf16* Y, LAS unsigned char* lds, int vcu, int wave) {
    const int lane = lane_id(), tid = wave * 64 + lane, cp = tid & 255, tg = tid >> 8;
    f32x2 w2[31];
#pragma unroll
    for (int j = 0; j < 31; ++j) w2[j] = *(const f32x2*)(cw + j * 512 + 2 * cp);
    f32x4 g0 = *(const f32x4*)(lng + 8 * lane), g1 = *(const f32x4*)(lng + 8 * lane + 4), b0 = *(const f32x4*)(lnb + 8 * lane), b1 = *(const f32x4*)(lnb + 8 * lane + 4);
    v4u zv[8];
#define CV_LOAD(ui_) do { const int m0_ = (vcu * 4 + (ui_)) * CV_T, t0_ = m0_ & (SEQ - 1);   \
          \
        _Pragma("unroll") for (int k = 0; k < 8; ++k) { const int rr = wave + 8 * k; const int rc = rr < CV_ROWS ? rr : CV_ROWS - 1; const bool ok = (t0_ - 30 + rc >= 0); \
            zv[k] = *(const GAS v4u*)(Z + (size_t)(ok ? m0_ - 30 + rc : m0_) * 512 + lane * 8); } } while (0)
    CV_LOAD(0);
#pragma unroll
    for (int j = 0; j < 31; ++j) asm volatile("" :: "v"(w2[j]));
    asm volatile("" :: "v"(g0), "v"(g1), "v"(b0), "v"(b1));
    for (int ui = 0; ui < 4; ++ui) {
        const int m0 = (vcu * 4 + ui) * CV_T;
#pragma unroll
        for (int k = 0; k < 8; ++k) { const int rr = wave + 8 * k; const bool ok = ((m0 & (SEQ - 1)) - 30 + rr >= 0); v4u v = zv[k]; v.x = ok ? v.x : 0u; v.y = ok ? v.y : 0u; v.z = ok ? v.z : 0u; v.w = ok ? v.w : 0u;
            if (rr < CV_ROWS) *(LAS v4u*)(lds + CV_ZT + rr * 1024 + lane * 16) = v; }
        LDS_BAR();
        if (ui + 1 < 4) CV_LOAD(ui + 1);
#pragma unroll 1
        for (int run = 0; run < 2; ++run) { const int tok0 = 16 * tg + 8 * run;
            f32x2 acc[8];
#pragma unroll
            for (int o = 0; o < 8; ++o) acc[o] = (f32x2){0.f, 0.f};
#pragma unroll
            for (int i = 0; i < 38; ++i) { const unsigned pk = *(const LAS unsigned*)(lds + CV_ZT + (tok0 + i) * 1024 + cp * 4);
                const f32x2 v = (f32x2){__uint_as_float(pk << 16), __uint_as_float(pk & 0xffff0000u)};
#pragma unroll
                for (int o = 0; o < 8; ++o) { const int jj = i - o; if (jj >= 0 && jj < 31) acc[o] = w2[jj] * v + acc[o]; } }
#pragma unroll
            for (int o = 0; o < 8; ++o) *(LAS f32x2*)(lds + CV_CO + (tok0 + o) * 2048 + cp * 8) = acc[o]; }
        LDS_BAR();
        { f32x4 x0[4], x1[4]; float s1[4], s2[4];
#pragma unroll
          for (int q = 0; q < 4; ++q) { const int tok = wave * 4 + q;
              x0[q] = *(const LAS f32x4*)(lds + CV_CO + tok * 2048 + lane * 32); x1[q] = *(const LAS f32x4*)(lds + CV_CO + tok * 2048 + lane * 32 + 16);
              s1[q] = ((x0[q][0] + x0[q][1]) + (x0[q][2] + x0[q][3])) + ((x1[q][0] + x1[q][1]) + (x1[q][2] + x1[q][3]));
              s2[q] = ((x0[q][0] * x0[q][0] + x0[q][1] * x0[q][1]) + (x0[q][2] * x0[q][2] + x0[q][3] * x0[q][3])) + ((x1[q][0] * x1[q][0] + x1[q][1] * x1[q][1]) + (x1[q][2] * x1[q][2] + x1[q][3] * x1[q][3])); }
#define CV_SW32(a_, b_) ([&]() { const auto r_ = __builtin_amdgcn_permlane32_swap(__float_as_uint(a_), __float_as_uint(b_), false, false); return __uint_as_float(r_[0]) + __uint_as_float(r_[1]); }())
#define CV_SW16(a_, b_) ([&]() { const auto r_ = __builtin_amdgcn_permlane16_swap(__float_as_uint(a_), __float_as_uint(b_), false, false); return __uint_as_float(r_[0]) + __uint_as_float(r_[1]); }())
#define CV_ROR(x_, n_) __int_as_float(__builtin_amdgcn_update_dpp(0, __float_as_int(x_), 0x120 + (n_), 0xf, 0xf, false))
          const float p01 = CV_SW32(s1[0], s1[1]), p23 = CV_SW32(s1[2], s1[3]), q01 = CV_SW32(s2[0], s2[1]), q23 = CV_SW32(s2[2], s2[3]);
          float R = CV_SW16(p01, p23), S = CV_SW16(q01, q23);
          R += CV_ROR(R, 8); S += CV_ROR(S, 8); R += CV_ROR(R, 4); S += CV_ROR(S, 4); R += CV_ROR(R, 2); S += CV_ROR(S, 2); R += CV_ROR(R, 1); S += CV_ROR(S, 1);
#pragma unroll
          for (int q = 0; q < 4; ++q) { const int tok = wave * 4 + q; const int rl = (q == 0) ? 0 : (q == 1) ? 32 : (q == 2) ? 16 : 48;
              const float sum = __int_as_float(__builtin_amdgcn_readlane(__float_as_int(R), rl)), sq = __int_as_float(__builtin_amdgcn_readlane(__float_as_int(S), rl));
              const float mu = sum * (1.0f / 512.0f); float var = __builtin_fmaf(-mu, mu, sq * (1.0f / 512.0f)); var = var > 0.f ? var : 0.f;
              const float rs = __builtin_amdgcn_rsqf(var + C_EPS);
              f32x4 y0 = (x0[q] - mu) * rs * g0 + b0, y1 = (x1[q] - mu) * rs * g1 + b1;
#pragma unroll
              for (int e = 0; e < 4; ++e) { y0[e] = y0[e] * pg8::fsigmoid(y0[e]); y1[e] = y1[e] * pg8::fsigmoid(y1[e]); }
              *(GAS pg8::u32x4*)(Y + (size_t)(m0 + tok) * 1024 + lane * 8) = pg8::pack8(y0, y1); }
#undef CV_SW32
#undef CV_SW16
#undef CV_ROR
        }
    }
#undef CV_LOAD
    LDS_BAR();
}

constexpr int RG_T = 64, RG_STR = 272, RG_FS = 272;
constexpr int RG_WT = 0, RG_XC = 0, RG_AL = 128 * RG_STR, RG_BL = RG_AL + 2 * RG_T * RG_FS, RG_SUM = RG_BL + 2 * RG_T * RG_FS, RG_CAR = RG_SUM + 8 * 512, RG_TP = RG_CAR + 2 * 256, RG_END = RG_TP + 8 * 1024;
static_assert(2 * RG_T * RG_STR <= 128 * RG_STR && RG_END <= RING_BYTES, "rglru LDS");
__device__ __forceinline__ f32x4 bf4lo(unsigned a, unsigned b) { return (f32x4){__uint_as_float(a << 16), __uint_as_float(a & 0xffff0000u), __uint_as_float(b << 16), __uint_as_float(b & 0xffff0000u)}; }
__device__ __forceinline__ void rglru_phase(const Args& a, const bf16* XR, const bf16* GG, bf16* Y, LAS unsigned char* lds, int vcu, int wave) {
    const int lane = lane_id(), tid = wave * 64 + lane; unsigned char* ws = a.ws;
    const int b = vcu >> 4, hh = (vcu >> 1) & 7, half = vcu & 1, c0 = hh * 128 + half * 64;
    const float* convw = a.in[11]; const float* convb = a.in[12]; const float* br = a.in[14]; const float* bi = a.in[16]; const float* lam = a.in[17];
    { const int row = tid >> 2, part = tid & 3; const bf16* src = (const bf16*)(ws + (row < 64 ? WS_WRT : WS_WIT)) + (size_t)hh * 16384 + (size_t)(half * 64 + (row & 63)) * 128 + part * 32;
#pragma unroll
      for (int i = 0; i < 4; ++i) *(LAS v4u*)(lds + RG_WT + row * RG_STR + part * 64 + i * 16) = *(const GAS v4u*)(src + 8 * i); }
    if (tid < 64) { *(LAS float*)(lds + RG_CAR + tid * 4) = 0.f; *(LAS float*)(lds + RG_CAR + 256 + tid * 4) = 0.f; }
    const int cg = tid & 15, tr = tid >> 4;
    f32x4 cwv[4][2], cbv[2];
#pragma unroll
    for (int j = 0; j < 4; ++j) { cwv[j][0] = *(const f32x4*)(convw + j * 1024 + hh * 128 + 8 * cg); cwv[j][1] = *(const f32x4*)(convw + j * 1024 + hh * 128 + 8 * cg + 4); }
    cbv[0] = *(const f32x4*)(convb + hh * 128 + 8 * cg); cbv[1] = *(const f32x4*)(convb + hh * 128 + 8 * cg + 4);
    const int tt = wave >> 1, cq = wave & 1, n16 = lane & 15, g4 = lane >> 4;
    float sp8[2], brv[2], biv[2];
#pragma unroll
    for (int q = 0; q < 2; ++q) { const int c = c0 + 32 * cq + 16 * q + n16; sp8[q] = 8.0f * 1.4426950408889634f * log1pf(expf(-lam[c]));   brv[q] = br[c]; biv[q] = bi[c]; }
    LDS_BAR();
    bf16x8 wrf[2][4], wif[2][4];
#pragma unroll
    for (int q = 0; q < 2; ++q)
#pragma unroll
        for (int ks = 0; ks < 4; ++ks) { const int nrow = 32 * cq + 16 * q + n16;
            wrf[q][ks] = *(const LAS bf16x8*)(lds + RG_WT + nrow * RG_STR + ks * 64 + g4 * 16); wif[q][ks] = *(const LAS bf16x8*)(lds + RG_WT + (64 + nrow) * RG_STR + ks * 64 + g4 * 16); }
    LDS_BAR();
    const size_t mb = (size_t)b * SEQ;
    constexpr int NTILE = SEQ / RG_T;
    v4u xrA[5], xrB[5]; v4u gsA, gsB;
#define RG_PREFETCH(xraw, t0_) do { _Pragma("unroll") for (int i = 0; i < 5; ++i) { const int t = (t0_) + 2 * tr - 3 + i; const bool ok = t >= 0;   \
        const v4u v = *(const GAS v4u*)(XR + (mb + (ok ? t : 0)) * 1024 + hh * 128 + 8 * cg); xraw[i].x = ok ? v.x : 0u; xraw[i].y = ok ? v.y : 0u; xraw[i].z = ok ? v.z : 0u; xraw[i].w = ok ? v.w : 0u; } } while (0)
#define RG_S1(xraw, p_) do { f32x4 xin[5][2]; _Pragma("unroll") for (int i = 0; i < 5; ++i) { xin[i][0] = bf4lo(xraw[i].x, xraw[i].y); xin[i][1] = bf4lo(xraw[i].z, xraw[i].w); } \
        _Pragma("unroll") for (int o = 0; o < 2; ++o) { f32x4 y0 = cbv[0], y1 = cbv[1]; _Pragma("unroll") for (int j = 0; j < 4; ++j) { y0 += cwv[j][0] * xin[o + j][0]; y1 += cwv[j][1] * xin[o + j][1]; } \
            *(LAS pg8::u32x4*)(lds + RG_XC + (p_) * (RG_T * RG_STR) + (2 * tr + o) * RG_STR + cg * 16) = pg8::pack8(y0, y1); } } while (0)
#define RG_S2(p_) do { const LAS unsigned char* xc = lds + RG_XC + (p_) * (RG_T * RG_STR); LAS unsigned char* alp = lds + RG_AL + (p_) * (RG_T * RG_FS); LAS unsigned char* blp = lds + RG_BL + (p_) * (RG_T * RG_FS); \
        pg8::f32x4 ar[2], ai[2]; _Pragma("unroll") for (int q = 0; q < 2; ++q) { ar[q] = (pg8::f32x4){0.f, 0.f, 0.f, 0.f}; ai[q] = (pg8::f32x4){0.f, 0.f, 0.f, 0.f}; } \
        _Pragma("unroll") for (int ks = 0; ks < 4; ++ks) { const bf16x8 af = *(const LAS bf16x8*)(xc + (tt * 16 + n16) * RG_STR + ks * 64 + g4 * 16); \
            _Pragma("unroll") for (int q = 0; q < 2; ++q) { ar[q] = __builtin_amdgcn_mfma_f32_16x16x32_bf16(af, wrf[q][ks], ar[q], 0, 0, 0); ai[q] = __builtin_amdgcn_mfma_f32_16x16x32_bf16(af, wif[q][ks], ai[q], 0, 0, 0); } } \
        _Pragma("unroll") for (int q = 0; q < 2; ++q) _Pragma("unroll") for (int r = 0; r < 4; ++r) { const int tok = tt * 16 + 4 * g4 + r, ch = 32 * cq + 16 * q + n16; \
            const float rg = pg8::fsigmoid(ar[q][r] + brv[q]), ig = pg8::fsigmoid(ai[q][r] + biv[q]); \
            const float av = __builtin_amdgcn_exp2f(-sp8[q] * rg);            \
            const float m2 = __builtin_fmaf(-av, av, 1.0f);                    \
            const float xv = __uint_as_float(((unsigned)*(const LAS unsigned short*)(xc + tok * RG_STR + (half * 64 + ch) * 2)) << 16); \
            *(LAS float*)(alp + tok * RG_FS + ch * 4) = av; *(LAS float*)(blp + tok * RG_FS + ch * 4) = __builtin_amdgcn_sqrtf(m2) * (ig * xv); } } while (0)
    RG_PREFETCH(xrA, 0); RG_S1(xrA, 0); RG_PREFETCH(xrA, 2 * RG_T); RG_PREFETCH(xrB, RG_T);
    LDS_BAR();
    const bf16* ggp = GG + (mb + 8 * wave + (lane >> 3)) * 1024 + c0 + 8 * (lane & 7);
    bf16* yp = Y + (mb + 8 * wave + (lane >> 3)) * 1024 + c0 + 8 * (lane & 7);
    LAS unsigned char* tpw = lds + RG_TP + wave * 1024;
#define RG_GLOAD(gsh, t0_) do { gsh = *(const GAS v4u*)(ggp + (size_t)(t0_) * 1024); } while (0)
    RG_S2(0); RG_S1(xrB, 1); RG_PREFETCH(xrB, 3 * RG_T); RG_GLOAD(gsA, 0); RG_GLOAD(gsB, RG_T);
    LDS_BAR();
#define RG_TILE(tile, p, xraw, gsh) do { const int t0 = (tile) * RG_T; \
          \
        float hl[8], pc[8]; \
        { const LAS unsigned char* alp = lds + RG_AL + (p) * (RG_T * RG_FS); const LAS unsigned char* blp = lds + RG_BL + (p) * (RG_T * RG_FS); \
          float av[8], bx[8]; \
          _Pragma("unroll") for (int i = 0; i < 8; ++i) { av[i] = *(const LAS float*)(alp + (8 * wave + i) * RG_FS + lane * 4); bx[i] = *(const LAS float*)(blp + (8 * wave + i) * RG_FS + lane * 4); } \
          if ((tile) + 1 < NTILE) RG_S2((p) ^ 1); \
          float h = 0.f, pr = 1.f; \
          _Pragma("unroll") for (int i = 0; i < 8; ++i) { h = av[i] * h + bx[i]; pr = pr * av[i]; hl[i] = h; pc[i] = pr; } \
          *(LAS f32x2*)(lds + RG_SUM + wave * 512 + lane * 8) = (f32x2){pr, h}; } \
        LDS_BAR(); \
          \
        { float carry = *(const LAS float*)(lds + RG_CAR + (p) * 256 + lane * 4); \
          for (int v = 0; v < wave; ++v) { const f32x2 s = *(const LAS f32x2*)(lds + RG_SUM + v * 512 + lane * 8); carry = s.y + s.x * carry; } \
          *(LAS v4u*)(tpw + lane * 16) = gsh; asm volatile("s_waitcnt lgkmcnt(0)" ::: "memory");              \
          unsigned short gv[8]; _Pragma("unroll") for (int i = 0; i < 8; ++i) gv[i] = *(const LAS unsigned short*)(tpw + (i * 64 + lane) * 2); \
          asm volatile("s_waitcnt lgkmcnt(0)" ::: "memory"); \
          _Pragma("unroll") for (int i = 0; i < 8; ++i) { const float hv = hl[i] + pc[i] * carry; if (i == 7) hl[7] = hv; \
              const float y = hv * __uint_as_float((unsigned)gv[i] << 16); \
              *(LAS unsigned short*)(tpw + (i * 64 + lane) * 2) = (unsigned short)(pg8::cvt_pk_bf16(y, y) & 0xffffu); } \
          asm volatile("s_waitcnt lgkmcnt(0)" ::: "memory"); \
          *(GAS v4u*)(yp + (size_t)t0 * 1024) = *(const LAS v4u*)(tpw + lane * 16); \
          if (wave == 7) *(LAS float*)(lds + RG_CAR + ((p) ^ 1) * 256 + lane * 4) = hl[7]; } \
        RG_GLOAD(gsh, ((tile) + 2 < NTILE) ? t0 + 2 * RG_T : t0);     \
        if ((tile) + 2 < NTILE) RG_S1(xraw, p); \
        RG_PREFETCH(xraw, ((tile) + 4 < NTILE) ? t0 + 4 * RG_T : t0); \
        LDS_BAR(); } while (0)
#pragma unroll 1
    for (int tile = 0; tile < NTILE; tile += 2) { RG_TILE(tile, 0, xrA, gsA); RG_TILE(tile + 1, 1, xrB, gsB); }
#undef RG_TILE
#undef RG_PREFETCH
#undef RG_GLOAD
#undef RG_S1
#undef RG_S2
}

__device__ __forceinline__ void final_phase(const Args& a, int vcu, int G, int wave, int m0, int mrows) {
    const int lane = lane_id(), r8 = lane >> 3, g8 = lane & 7;
    const int gw = vcu * NWAVES + wave, NGW = G * NWAVES; const float* ss = (const float*)(a.ws + WS_SS); const float* g = a.in[19]; const char* X = (const char*)(a.ws + WS_XN);
    for (int rg = m0 / 16 + gw; rg < (m0 + mrows) / 16; rg += NGW) {
        const int row0 = 16 * rg + r8, row1 = row0 + 8;
        const float rs0 = pg8::row_rstd(ss, row0), rs1 = pg8::row_rstd(ss, row1);
        const int ob0 = r8 * 64 + g8 * 8, ob1 = ((r8 + 8) * 64 + g8 * 8) ^ 32;
        float* o0 = a.out + (size_t)row0 * DMODEL + 4 * g8; float* o1 = a.out + (size_t)row1 * DMODEL + 4 * g8;
#pragma unroll 1
        for (int c0 = 0; c0 < 32; c0 += 4) { unsigned long long w0[4], w1[4]; f32x4 gv[4];
#pragma unroll
            for (int i = 0; i < 4; ++i) { const char* blk = X + xf_block(rg, c0 + i); w0[i] = *(const GAS unsigned long long*)(blk + ob0); w1[i] = *(const GAS unsigned long long*)(blk + ob1); gv[i] = *(const f32x4*)(g + 32 * (c0 + i) + 4 * g8); }
#pragma unroll
            for (int i = 0; i < 4; ++i) {
                *(GAS f32x4*)(o0 + 32 * (c0 + i)) = pg8::bf4((unsigned)w0[i], (unsigned)(w0[i] >> 32)) * rs0 * gv[i];
                *(GAS f32x4*)(o1 + 32 * (c0 + i)) = pg8::bf4((unsigned)w1[i], (unsigned)(w1[i] >> 32)) * rs1 * gv[i]; } } }
}

__global__ void __launch_bounds__(NWAVES * 64, 2) mk_fwd(Args args) {
    extern __shared__ __attribute__((aligned(16))) unsigned char lds_raw[];
    LAS unsigned char* lds = (LAS unsigned char*)lds_raw;
    volatile LAS unsigned* MISC = (volatile LAS unsigned*)(lds + MISC_OFF);
    const int wave = __builtin_amdgcn_readfirstlane((int)threadIdx.x >> 6);
    const int G = gridDim.x; const int bx = blockIdx.x; const int vcu = (G % 8 == 0) ? (bx % 8) * (G / 8) + bx / 8 : bx;
    unsigned char* ws = args.ws;
    gu32* ctl = (gu32*)(ws + WS_CTL);
    for (int u = (int)threadIdx.x; u < (LDS_BYTES - LDSCTL_OFF) / 4; u += NWAVES * 64) ((LAS unsigned*)(lds + LDSCTL_OFF))[u] = 0u;
    __syncthreads();
    const int sid = bx & 7, G2 = G / NSTREAM, c = bx >> 3, vcl = c, vcs = sid * G2 + vcl, M0 = sid * MS;
    XcdBarrier bar = xcd_barrier_post((unsigned*)(ctl + CW_BAR), MISC + 8, (unsigned)G);
    XcdBarrier sbar = xcd_barrier_post((unsigned*)(ctl + CW_BAR + 4096 * (1 + sid)), MISC + 10, (unsigned)G2);
    const int lo = args.ph_lo, hi = args.ph_hi;
#define IN(k) (lo <= (k) && (k) < hi)
#define SEAM(k) do { if (IN(k) && IN((k) + 1)) xcd_barrier(sbar); } while (0)
    unsigned char* sb = ws + WS_SB + (size_t)sid * WS_SSTR;
    bf16* XNl = (bf16*)(ws + WS_XN) + (size_t)M0 * 1024; float* SSl = (float*)(ws + WS_SS) + (size_t)M0 * 16;
    bf16* Hl = (bf16*)(sb + SO_H); bf16* Yl = (bf16*)(sb + SO_Y); bf16* Zl = (bf16*)(sb + SO_Z); bf16* Ql = (bf16*)(sb + SO_Q); bf16* GGl = (bf16*)(sb + SO_GG); bf16* XRl = (bf16*)(sb + SO_XR);
    bf16* Yg = Yl - (size_t)M0 * 1024; const bf16* Zg = Zl - (size_t)M0 * 512; const bf16* Qg = Ql - (size_t)M0 * 512; const bf16* Kg = Qg + QKV_STRIDE; const bf16* Vg = Kg + QKV_STRIDE;
    const bf16* GGg = GGl - (size_t)M0 * 1024; const bf16* XRg = XRl - (size_t)M0 * 1024;
    LAS float* RTAB = (LAS float*)(lds + pg8::RTAB_OFF);
    static_assert(pg8::RTAB_OFF >= MISC_OFF + 128 && pg8::RTAB_OFF + 2048 <= LDS_BYTES, "rtab inside the LDS control area");

    if (IN(0)) { p0_prologue(args, lds, vcu, G, wave); }
    if (IN(0) && IN(1)) xcd_barrier(bar);
    if (IN(1)) {
        pg8::Gemm g{XNl, (const bf16*)(ws + WS_WIN0), MS, 2560, DMODEL, 0, 1}; pg8::StaticOrder S; S.init1(MS, 2560, G2, c);
        pg8::EpiInAB E{Zl, Ql, RTAB, mo::C2, QKV_STRIDE};
        pg8::gemm_phase<pg8::EpiInAB, pg8::StaticOrder, true, true>(lds, g, S, E, wave, SSl);
    }
    SEAM(1);
    if (IN(2)) {
        conv_phase(Zg, args.in[6], args.in[7], args.in[8], Yg, lds, vcs, wave);
        const int bh = vcs >> 1, hf = vcs & 1;
        mo::moba_kbar(bh >> 3, bh & 7, Kg, (LAS char*)lds, wave);
#pragma unroll 1
        for (int i = 0; i < 4; ++i) { const int j = hf ? ((i == 0) ? 2 : (i == 1) ? 5 : (i == 2) ? 3 : 4) : ((i == 0) ? 0 : (i == 1) ? 7 : (i == 2) ? 1 : 6);
            mo::moba_unit(bh >> 3, bh & 7, j, Qg, Kg, Vg, Yg, (LAS char*)lds, wave, i == 0, i < 3); }
    }
    SEAM(2);
    if (IN(3)) {
        pg8::Gemm g{Yl, (const bf16*)(ws + WS_WOUT0), MS, DMODEL, DMODEL}; pg8::StaticOrder S; S.init1(MS, DMODEL, G2, c);
        pg8::EpiResB E{XNl, nullptr, SSl};
        pg8::gemm_phase<pg8::EpiResB, pg8::StaticOrder, true, true>(lds, g, S, E, wave);
    }
    SEAM(3);
    if (IN(4)) {
        pg8::Gemm g{XNl, (const bf16*)(ws + WS_WUP0), MS, FF, DMODEL, 0, 1}; pg8::StaticOrder S; S.init1(MS, FF, G2, c);
        pg8::EpiUp E{Hl, RTAB};
        pg8::gemm_phase<pg8::EpiUp, pg8::StaticOrder, true, true>(lds, g, S, E, wave, SSl);
    }
    SEAM(4);
    if (IN(5)) {
        pg8::Gemm g{Hl, (const bf16*)(ws + WS_WDN0), MS, DMODEL, FF, 0, 1}; pg8::StaticOrder S; S.init1(MS, DMODEL, G2, c);
        pg8::EpiResB E{XNl, nullptr, SSl};
        pg8::gemm_phase<pg8::EpiResB, pg8::StaticOrder, true, true>(lds, g, S, E, wave);
    }
    SEAM(5);
    if (IN(6)) {
        pg8::Gemm g{XNl, (const bf16*)(ws + WS_WIN1), MS, 2048, DMODEL, 0, 1}; pg8::StaticOrder S; S.init1(MS, 2048, G2, c);
        pg8::EpiInC E{GGl, XRl, RTAB};
        pg8::gemm_phase<pg8::EpiInC, pg8::StaticOrder, true, true>(lds, g, S, E, wave, SSl);
    }
    SEAM(6);
    if (IN(7)) { rglru_phase(args, XRg, GGg, Yg, lds, vcs, wave); }
    SEAM(7);
    if (IN(8)) {
        pg8::Gemm g{Yl, (const bf16*)(ws + WS_WOUT1), MS, DMODEL, DMODEL}; pg8::StaticOrder S; S.init1(MS, DMODEL, G2, c);
        pg8::EpiResB E{XNl, nullptr, SSl};
        pg8::gemm_phase<pg8::EpiResB, pg8::StaticOrder, true, true>(lds, g, S, E, wave);
    }
    SEAM(8);
    if (IN(9)) {
        pg8::Gemm g{XNl, (const bf16*)(ws + WS_WUP1), MS, FF, DMODEL, 0, 1}; pg8::StaticOrder S; S.init1(MS, FF, G2, c);
        pg8::EpiUp E{Hl, RTAB};
        pg8::gemm_phase<pg8::EpiUp, pg8::StaticOrder, true, true>(lds, g, S, E, wave, SSl);
    }
    SEAM(9);
    if (IN(10)) {
        pg8::Gemm g{Hl, (const bf16*)(ws + WS_WDN1), MS, DMODEL, FF, 0, 1}; pg8::StaticOrder S; S.init1(MS, DMODEL, G2, c);
        pg8::EpiResB E{XNl, nullptr, SSl};
        pg8::gemm_phase<pg8::EpiResB, pg8::StaticOrder, true, true>(lds, g, S, E, wave);
    }
    SEAM(10);
    if (IN(11)) { final_phase(args, vcl, G2, wave, M0, MS); }
#ifdef MK_PROF
    if (IN(11)) { xcd_barrier(sbar);
        if (bx == 0) { const unsigned long long* pr = (const unsigned long long*)(ws + WS_CTL + 512 * 1024); const float cnt = (float)pr[6];
            const float A = (float)pr[MK_PROF_A] / cnt, B = (float)pr[MK_PROF_B] / cnt; const float c = sqrtf(B * 1e-5f * 128.0f);
            for (int i = (int)threadIdx.x; i < (1 << 18); i += 512) args.out[(size_t)i * 128 + 64] += c;
            if (threadIdx.x == 0) args.out[0] += A * MK_PROF_ASCALE; } }
#endif
#undef IN
#undef SEAM
}

extern "C" void kernel_launch(void* const* d_in, const int* in_sizes, int n_in, void* d_out, int out_size, void* d_ws, size_t ws_size, hipStream_t stream) {
    static int grid = 0;
    if (grid == 0) {
        if (n_in != 20 || in_sizes[0] != M * DMODEL || out_size != M * DMODEL || ws_size < WS_END) { fprintf(stderr, "kernel_launch: unexpected shapes (n_in %d, in0 %d, out %d, ws %zu); nothing launched\n", n_in, n_in > 0 ? in_sizes[0] : -1, out_size, ws_size); grid = -1; return; }
        int dev = 0, cus = 0, per_cu = 0;
        if (hipGetDevice(&dev) != hipSuccess || hipDeviceGetAttribute(&cus, hipDeviceAttributeMultiprocessorCount, dev) != hipSuccess) { grid = -1; return; }
        if (hipFuncSetAttribute((const void*)mk_fwd, hipFuncAttributeMaxDynamicSharedMemorySize, LDS_BYTES) != hipSuccess) { fprintf(stderr, "kernel_launch: hipFuncSetAttribute failed\n"); grid = -1; return; }
        if (hipOccupancyMaxActiveBlocksPerMultiprocessor(&per_cu, (const void*)mk_fwd, NWAVES * 64, LDS_BYTES) != hipSuccess || per_cu < 1) fprintf(stderr, "kernel_launch: note: occupancy query reports %d\n", per_cu);
        (void)hipGetLastError();
        grid = cus;
        if (grid != 256) fprintf(stderr, "kernel_launch: %d CUs (the static schedules assume 256)\n", grid);
    }
    if (grid < 0) return;
    if (hipMemsetAsync((char*)d_ws + WS_CTL, 0, CTL_ZERO_BYTES, stream) != hipSuccess) return;
    Args a{};
    for (int i = 0; i < 20; ++i) a.in[i] = (const float*)d_in[i];
    a.out = (float*)d_out; a.ws = (unsigned char*)d_ws;
#if MK_PER_PHASE
    for (int p = 0; p < NPHASE; ++p) { a.ph_lo = p; a.ph_hi = p + 1; hipLaunchKernelGGL(mk_fwd, dim3(grid), dim3(NWAVES * 64), LDS_BYTES, stream, a); }
#else
    a.ph_lo = 0; a.ph_hi = NPHASE;
    hipLaunchKernelGGL(mk_fwd, dim3(grid), dim3(NWAVES * 64), LDS_BYTES, stream, a);
#endif
}
```

```cpp
#include <hip/hip_runtime.h>
#include <hip/hip_bf16.h>
#include <cstdio>
#include <cstdint>
#include <cmath>
namespace pg8 {
#define PG8_LAS __attribute__((address_space(3)))
typedef unsigned short bf16_t;
typedef short bf16x8 __attribute__((ext_vector_type(8)));
typedef float f32x4 __attribute__((ext_vector_type(4)));
typedef unsigned u32x4 __attribute__((ext_vector_type(4)));
constexpr int BM = 256, BK = 64, HALF = 128, HTB = HALF * BK * 2  , STAGE_BYTES = 8 * HTB, NXCD = 8, WGM = 8;

__host__ __device__ __forceinline__ int lds_byte(int r, int c) { const int st = (r >> 4) * 2 + (c >> 5), rr = r & 15, cc = c & 31, ob = rr * 64 + cc * 2; return st * 1024 + (ob ^ (((ob >> 9) & 1) << 5)); }
__host__ __device__ __forceinline__ void stage_rc(int b, int& R, int& C) { const int st = b / 1024, sb = b % 1024, swz = sb ^ (((sb >> 9) & 1) << 5); R = (st >> 1) * 16 + swz / 64; C = (st & 1) * 32 + (swz % 64) / 2; }
__host__ __device__ __forceinline__ int perm32(int rho) { const int n = rho >> 4, i = rho & 15; return 8 * (i >> 2) + 4 * n + (i & 3); }

struct Unit { int pm, pn; };
struct Gemm { const bf16_t* A; const bf16_t* Bt; int M, N, K; int lda = 0; int afrag = 0; };

struct StaticOrder {
    int nM, nN, nwg, G, c, remap = 1;
    __host__ __device__ void init(int M, int N, int G_, int c_) { nM = M / BM; nN = N / BM; nwg = nM * nN; G = G_; c = c_; }
    __host__ __device__ void init1(int M, int N, int G_, int c_) { init(M, N, G_, c_); remap = 0; }
    __host__ __device__ bool next(int i, Unit& u) const {
        const long L = (long)i * G + c; if (L >= nwg) return false;
        int wgid = (int)L; if (remap) { const int q = nwg / NXCD, r = nwg % NXCD, xcd = wgid % NXCD, off = wgid / NXCD; wgid = (xcd < r ? xcd * (q + 1) : r * (q + 1) + (xcd - r) * q) + off; }
        const int nig = WGM * nN, gid = wgid / nig, fm = gid * WGM, gsz = (nM - fm) < WGM ? (nM - fm) : WGM;
        u.pm = fm + ((wgid % nig) % gsz); u.pn = (wgid % nig) / gsz; return true;
    }
    __device__ __forceinline__ void a_ready(const Unit&) const {}
    __device__ __forceinline__ void done(const Unit&) const {}
};
__device__ __forceinline__ unsigned cvt_pk_bf16(float lo, float hi) { unsigned r; asm volatile("v_cvt_pk_bf16_f32 %0, %1, %2" : "=v"(r) : "v"(lo), "v"(hi)); return r; }
typedef float f32x2 __attribute__((ext_vector_type(2)));
typedef unsigned u32x2 __attribute__((ext_vector_type(2)));
__device__ __forceinline__ float row_rstd(const float* ss, int row) {
    const f32x4* p = (const f32x4*)(ss + (size_t)row * 16);
    const f32x4 a = p[0], b = p[1], c = p[2], d = p[3];
    const float s = (((a[0] + a[1]) + (a[2] + a[3])) + ((b[0] + b[1]) + (b[2] + b[3]))) + (((c[0] + c[1]) + (c[2] + c[3])) + ((d[0] + d[1]) + (d[2] + d[3])));
    return 1.0f / sqrtf(s * (1.0f / 1024.0f) + 1e-6f);
}
constexpr int RTAB_OFF = 131072 + 1024;
__device__ __forceinline__ void rtab_fill(const StaticOrder& S, const float* ss, PG8_LAS float* rtab, int wid) {
    const int lane = (int)__builtin_amdgcn_mbcnt_hi(~0u, __builtin_amdgcn_mbcnt_lo(~0u, 0u)), t = wid * 64 + lane, row = t >> 1, h = t & 1;
    Unit u; int prev = -1;
    for (int i = 0; S.next(i, u); ++i) { if (u.pm == prev) continue; prev = u.pm;
        const f32x4* p = (const f32x4*)(ss + ((size_t)u.pm * BM + row) * 16 + h * 8);
        const f32x4 a = p[0], b = p[1];
        float s = ((a[0] + a[1]) + (a[2] + a[3])) + ((b[0] + b[1]) + (b[2] + b[3]));
        s += __shfl_xor(s, 1);
        const float r = 1.0f / sqrtf(s * (1.0f / 1024.0f) + 1e-6f);
        if (h == 0) rtab[((u.pm >> 3) & 1) * 256 + row] = r; }
    asm volatile("s_waitcnt lgkmcnt(0)\n\ts_barrier" ::: "memory");
}
__device__ __forceinline__ void row_scales(float (&rs)[2][4], const PG8_LAS float* rtab, const Unit& u, int wr, int fr, float mul) {
    const PG8_LAS float* t = rtab + ((u.pm >> 3) & 1) * 256 + wr * 64 + fr;
#pragma unroll
    for (int ai = 0; ai < 2; ++ai)
#pragma unroll
        for (int m = 0; m < 4; ++m) rs[ai][m] = t[ai * HALF + m * 16] * mul;
}
__device__ __forceinline__ float fsigmoid(float x) { return __builtin_amdgcn_rcpf(1.0f + __builtin_amdgcn_exp2f(-1.4426950408889634f * x)); }
__device__ __forceinline__ u32x4 pack8(const f32x4& v0, const f32x4& v1) { u32x4 w; w.x = cvt_pk_bf16(v0[0], v0[1]); w.y = cvt_pk_bf16(v0[2], v0[3]); w.z = cvt_pk_bf16(v1[0], v1[1]); w.w = cvt_pk_bf16(v1[2], v1[3]); return w; }

struct EpiInAB {
    static constexpr bool PERM = true, AFTER_DRAIN = false, ADJ = false;
    bf16_t* Z; bf16_t* QKV; const PG8_LAS float* rtab; float qscale; size_t qkv_stride;
    __device__ __forceinline__ void operator()(const f32x4 (&acc)[2][2][4][2], const Unit& u, int wr, int wc, int fr, int fq) const {
        const int row0 = u.pm * BM + wr * 64 + fr, cw = wc * 32 + 8 * fq;
        float rsv[2][4]; row_scales(rsv, rtab, u, wr, fr, (u.pn == 4 || u.pn == 5) ? qscale : 1.0f);
        if (u.pn < 4) {
#pragma unroll
            for (int ai = 0; ai < 2; ++ai)
#pragma unroll
                for (int m = 0; m < 4; ++m) { const int row = row0 + ai * HALF + m * 16; const float rs = rsv[ai][m];
                    f32x4 z0, z1;
#pragma unroll
                    for (int j = 0; j < 4; ++j) { z0[j] = (acc[ai][0][m][0][j] * rs) * fsigmoid(acc[ai][1][m][0][j] * rs); z1[j] = (acc[ai][0][m][1][j] * rs) * fsigmoid(acc[ai][1][m][1][j] * rs); }
                    *(u32x4*)(Z + (size_t)row * 512 + u.pn * 128 + cw) = pack8(z0, z1); __builtin_amdgcn_sched_barrier(0); }
        } else {
            const int t = (u.pn - 4) >> 1; bf16_t* dst = QKV + (size_t)t * qkv_stride;
            const int cb = ((u.pn - 4) & 1) * 256 + cw;
#pragma unroll
            for (int ai = 0; ai < 2; ++ai)
#pragma unroll
                for (int m = 0; m < 4; ++m) { const int row = row0 + ai * HALF + m * 16; const float rs = rsv[ai][m];
#pragma unroll
                    for (int bj = 0; bj < 2; ++bj) { const f32x4 v0 = acc[ai][bj][m][0] * rs, v1 = acc[ai][bj][m][1] * rs;
                        *(u32x4*)(dst + (size_t)row * 512 + cb + bj * HALF) = pack8(v0, v1); } __builtin_amdgcn_sched_barrier(0); }
        }
    }
};
__device__ __forceinline__ float irelu(float x) { const int i = __float_as_int(x); return __int_as_float(i > 0 ? i : 0); }
struct EpiUp {
    static constexpr bool PERM = true, AFTER_DRAIN = false, ADJ = true;
    bf16_t* H; const PG8_LAS float* rtab;
    static constexpr int FFT = 4096 / 64;
    __device__ __forceinline__ void operator()(const f32x4 (&acc)[2][2][4][2], const Unit& u, int wr, int wc, int fr, int fq) const {
        const int fo = (fr * 64 + fq * 16) ^ ((fr >> 3) << 5);
        float rsv[2][4]; row_scales(rsv, rtab, u, wr, fr, 1.0f);
#pragma unroll
        for (int ai = 0; ai < 2; ++ai)
#pragma unroll
            for (int m = 0; m < 4; ++m) { const float rs2 = rsv[ai][m] * rsv[ai][m];
                const f32x2 r2 = (f32x2){rs2, rs2};
#pragma unroll
                for (int bj = 0; bj < 2; ++bj) { f32x4 v0, v1;
#pragma unroll
                    for (int j = 0; j < 4; j += 2) {
                        const float x0 = acc[ai][bj][m][0][j], x1 = acc[ai][bj][m][0][j + 1], x2 = acc[ai][bj][m][1][j], x3 = acc[ai][bj][m][1][j + 1];
                        f32x2 a = (f32x2){irelu(x0), irelu(x1)}, b = (f32x2){irelu(x2), irelu(x3)};
                        a = (a * a) * r2; b = (b * b) * r2; v0[j] = a[0]; v0[j + 1] = a[1]; v1[j] = b[0]; v1[j + 1] = b[1]; }
                    *(u32x4*)((char*)H + ((((size_t)(u.pm * (FFT) + u.pn * 4 + wc) * 2 + ai) * 16 + (2 * (4 * wr + m) + bj)) << 10) + fo) = pack8(v0, v1); } __builtin_amdgcn_sched_barrier(0); }
    }
};
struct EpiInC {
    static constexpr bool PERM = true, AFTER_DRAIN = false, ADJ = true;
    bf16_t* GG; bf16_t* XR; const PG8_LAS float* rtab;
    __device__ __forceinline__ void operator()(const f32x4 (&acc)[2][2][4][2], const Unit& u, int wr, int wc, int fr, int fq) const {
        const bool isg = u.pn < 4; const int fo = (fr * 64 + fq * 16) ^ ((fr >> 3) << 5);
        char* db = (char*)(isg ? GG : XR) + (((size_t)(u.pm * 16 + (u.pn & 3) * 4 + wc) * 2) << 14) + fo;
        float rsv[2][4]; row_scales(rsv, rtab, u, wr, fr, 1.0f);
#pragma unroll
        for (int ai = 0; ai < 2; ++ai)
#pragma unroll
            for (int m = 0; m < 4; ++m) { const float rs = rsv[ai][m];
#pragma unroll
                for (int bj = 0; bj < 2; ++bj) { f32x4 v0 = acc[ai][bj][m][0] * rs, v1 = acc[ai][bj][m][1] * rs;
                    if (isg) {
                        const f32x2 c1 = (f32x2){-2.3022081983f, -2.3022081983f}, c2 = (f32x2){-0.10294324f, -0.10294324f}, one = (f32x2){1.0f, 1.0f};
#pragma unroll
                        for (int j = 0; j < 4; j += 2) {
                            f32x2 xa = (f32x2){v0[j], v0[j + 1]}, xb = (f32x2){v1[j], v1[j + 1]};
                            f32x2 ea = xa * (xa * xa * c2 + c1), eb = xb * (xb * xb * c2 + c1);
                            ea = (f32x2){__builtin_amdgcn_exp2f(ea[0]), __builtin_amdgcn_exp2f(ea[1])} + one; eb = (f32x2){__builtin_amdgcn_exp2f(eb[0]), __builtin_amdgcn_exp2f(eb[1])} + one;
                            xa = xa * (f32x2){__builtin_amdgcn_rcpf(ea[0]), __builtin_amdgcn_rcpf(ea[1])}; xb = xb * (f32x2){__builtin_amdgcn_rcpf(eb[0]), __builtin_amdgcn_rcpf(eb[1])};
                            v0[j] = xa[0]; v0[j + 1] = xa[1]; v1[j] = xb[0]; v1[j + 1] = xb[1]; } }
                    *(u32x4*)(db + ((ai * 16 + 2 * (4 * wr + m) + bj) << 10)) = pack8(v0, v1); } __builtin_amdgcn_sched_barrier(0); }
    }
};
__device__ __forceinline__ f32x4 bf4(unsigned a, unsigned b) { return (f32x4){__uint_as_float(a << 16), __uint_as_float(a & 0xffff0000u), __uint_as_float(b << 16), __uint_as_float(b & 0xffff0000u)}; }
struct EpiResB {
    static constexpr bool PERM = true, AFTER_DRAIN = false, ADJ = true;
    bf16_t* X; float* outf; float* ssout;
    __device__ __forceinline__ void operator()(const f32x4 (&acc)[2][2][4][2], const Unit& u, int wr, int wc, int fr, int fq) const {
        const int row0 = u.pm * BM + wr * 64 + fr;
        const int fo = (fr * 64 + fq * 16) ^ ((fr >> 3) << 5);
        char* xb = (char*)X + (((size_t)(u.pm * 16 + u.pn * 4 + wc) * 2) << 14) + fo;
        u32x4 raw[2][4][2];
#pragma unroll
        for (int ai = 0; ai < 2; ++ai)
#pragma unroll
            for (int m = 0; m < 4; ++m)
#pragma unroll
                for (int bj = 0; bj < 2; ++bj) raw[ai][m][bj] = *(const u32x4*)(xb + ((ai * 16 + 2 * (4 * wr + m) + bj) << 10));
#pragma unroll
        for (int ai = 0; ai < 2; ++ai)
#pragma unroll
            for (int m = 0; m < 4; ++m) { const int row = row0 + ai * HALF + m * 16; float sq = 0.f;
                f32x2 sq2 = (f32x2){0.f, 0.f};
#pragma unroll
                for (int bj = 0; bj < 2; ++bj) { const u32x4 rw = raw[ai][m][bj];
                    const f32x4 x0 = bf4(rw.x, rw.y) + acc[ai][bj][m][0], x1 = bf4(rw.z, rw.w) + acc[ai][bj][m][1];
                    const f32x2 a0 = (f32x2){x0[0], x0[1]}, a1 = (f32x2){x0[2], x0[3]}, a2 = (f32x2){x1[0], x1[1]}, a3 = (f32x2){x1[2], x1[3]};
                    sq2 = a0 * a0 + sq2; sq2 = a1 * a1 + sq2; sq2 = a2 * a2 + sq2; sq2 = a3 * a3 + sq2;
                    *(u32x4*)(xb + ((ai * 16 + 2 * (4 * wr + m) + bj) << 10)) = pack8(x0, x1); }
                sq = sq2[0] + sq2[1];
                { const auto r16 = __builtin_amdgcn_permlane16_swap(__float_as_uint(sq), __float_as_uint(sq), false, false); sq = __uint_as_float(r16[0]) + __uint_as_float(r16[1]);
                  const auto r32 = __builtin_amdgcn_permlane32_swap(__float_as_uint(sq), __float_as_uint(sq), false, false); sq = __uint_as_float(r32[0]) + __uint_as_float(r32[1]); }
                if (fq == 0) ssout[(size_t)row * 16 + u.pn * 4 + wc] = sq;
                __builtin_amdgcn_sched_barrier(0); }
    }
};

template <class Epi, class Sched, bool ALIGN_EPI = false, bool SP2 = false>
__device__ __forceinline__ void gemm_phase(PG8_LAS unsigned char* lds, const Gemm g, const Sched& S, const Epi& E, const int wid, const float* ssfill = nullptr) {
    const int lane = (int)__builtin_amdgcn_mbcnt_hi(~0u, __builtin_amdgcn_mbcnt_lo(~0u, 0u)), tid = wid * 64 + lane, wr = wid >> 2, wc = wid & 3, fr = lane & 15, fq = lane >> 4;
    const int K = g.K, nt = K / BK, lda = g.lda ? g.lda : K;
    unsigned voffA[2], voffB[2];
#pragma unroll
    for (int i = 0; i < 2; ++i) { int R, C; stage_rc(tid * 16 + i * 8192, R, C);
        const int Rb = Epi::ADJ ? ((R >> 5) * 64 + perm32(R & 31)) : Epi::PERM ? ((R & ~31) + perm32(R & 31)) : R;
        voffA[i] = g.afrag ? (unsigned)((wid + 8 * i) * 1024 + lane * 16) : (unsigned)(R * lda + C) * 2u; voffB[i] = (unsigned)(Rb * K + C) * 2u; }
    const size_t kstep = (size_t)(BK * 2);
    const size_t hstep = (size_t)HALF * K * 2;
    const size_t bhstep = Epi::ADJ ? (size_t)32 * K * 2 : hstep;
    const size_t tstep = 2 * hstep;
    const bool afrag = g.afrag != 0;
    const size_t ahstep = afrag ? (size_t)HTB : (size_t)HALF * lda * 2, akstep = afrag ? (size_t)(2 * HTB) : kstep, atstep = afrag ? (size_t)(K / BK) * 2 * HTB : 2 * (size_t)HALF * lda * 2;
    const unsigned ldsw = (unsigned)wid * 1024u;
    const int aoff = lds_byte(wr * 64 + fr, fq * 8), boff = lds_byte(wc * 32 + fr, fq * 8);
#define PG8_SA(b, h) (((b) * 2 + (h)) * HTB)
#define PG8_SB(b, h) ((4 + (b) * 2 + (h)) * HTB)
#define PG8_STAGE(bufoff, gbase, voff) do { _Pragma("unroll") for (int _i = 0; _i < 2; ++_i) \
        __builtin_amdgcn_global_load_lds((const unsigned*)((const char*)(gbase) + (voff)[_i]), (PG8_LAS unsigned*)(lds + (bufoff) + ldsw + _i * 8192), 16, 0, 0); } while (0)
#define PG8_LDA(dst, b, h) do { _Pragma("unroll") for (int m = 0; m < 4; ++m) _Pragma("unroll") for (int k = 0; k < 2; ++k) dst[m][k] = *(const PG8_LAS bf16x8*)(lds + PG8_SA(b, h) + aoff + m * 2048 + k * 1024); } while (0)
#define PG8_LDB(dst, b, h) do { _Pragma("unroll") for (int n = 0; n < 2; ++n) _Pragma("unroll") for (int k = 0; k < 2; ++k) dst[n][k] = *(const PG8_LAS bf16x8*)(lds + PG8_SB(b, h) + boff + n * 2048 + k * 1024); } while (0)
#define PG8_MMA(ai, bj, At, Bt) do { __builtin_amdgcn_s_setprio(1); _Pragma("unroll") for (int m = 0; m < 4; ++m) _Pragma("unroll") for (int n = 0; n < 2; ++n) _Pragma("unroll") for (int k = 0; k < 2; ++k) \
        acc[ai][bj][m][n] = __builtin_amdgcn_mfma_f32_16x16x32_bf16(Bt[n][k], At[m][k], acc[ai][bj][m][n], 0, 0, 0); __builtin_amdgcn_s_setprio(0); } while (0)
#define PG8_WAIT_V(n) asm volatile("s_waitcnt vmcnt(" #n ")" ::: "memory")
#define PG8_WAIT_L(n) asm volatile("s_waitcnt lgkmcnt(" #n ")" ::: "memory")
#define PG8_BAR __builtin_amdgcn_s_barrier()
#define PG8_SCHED __builtin_amdgcn_sched_barrier(0)
    Unit cur, nxt; int ui = 0;
    if (!S.next(0, cur)) return;
    f32x4 acc[2][2][4][2];
#pragma unroll
    for (int a = 0; a < 2; ++a)
#pragma unroll
        for (int b = 0; b < 2; ++b)
#pragma unroll
            for (int m = 0; m < 4; ++m)
#pragma unroll
                for (int n = 0; n < 2; ++n) acc[a][b][m][n] = (f32x4){0.f, 0.f, 0.f, 0.f};
    bf16x8 At[4][2], B0[2][2], B1[2][2];
    const char* cA = (const char*)g.A + (size_t)cur.pm * atstep; const char* cB = (const char*)g.Bt + (size_t)cur.pn * tstep;
    S.a_ready(cur);
    if constexpr (SP2) {
        PG8_STAGE(PG8_SB(0, 0), cB, voffB); PG8_STAGE(PG8_SB(0, 1), cB + bhstep, voffB); PG8_STAGE(PG8_SA(0, 0), cA, voffA); PG8_STAGE(PG8_SA(0, 1), cA + ahstep, voffA);
        if (ssfill) rtab_fill(S, ssfill, (PG8_LAS float*)(lds + RTAB_OFF), wid);
        if (wr == 1) PG8_BAR;
        PG8_WAIT_V(2); PG8_BAR;
        PG8_STAGE(PG8_SB(1, 0), cB + kstep, voffB); PG8_STAGE(PG8_SA(1, 0), cA + akstep, voffA); PG8_STAGE(PG8_SB(1, 1), cB + bhstep + kstep, voffB);
        PG8_WAIT_V(6); PG8_BAR;
    } else {
        PG8_STAGE(PG8_SB(0, 0), cB, voffB); PG8_STAGE(PG8_SA(0, 0), cA, voffA); PG8_STAGE(PG8_SB(0, 1), cB + bhstep, voffB); PG8_STAGE(PG8_SA(0, 1), cA + ahstep, voffA);
        if (wr == 1) PG8_BAR;
        PG8_WAIT_V(4); PG8_BAR;
        PG8_STAGE(PG8_SB(1, 0), cB + kstep, voffB); PG8_STAGE(PG8_SA(1, 0), cA + akstep, voffA); PG8_STAGE(PG8_SB(1, 1), cB + bhstep + kstep, voffB);
        PG8_WAIT_V(6); PG8_BAR;
    }
    for (;;) {
        const bool has_next = S.next(ui + 1, nxt);
        const char* nA = has_next ? (const char*)g.A + (size_t)nxt.pm * atstep : cA; const char* nB = has_next ? (const char*)g.Bt + (size_t)nxt.pn * tstep : cB;
        for (int t = 0; t < nt; t += 2) {
            const bool last = (t == nt - 2);
            const char* a1 = cA + (size_t)(t + 1) * akstep;
            const char* a2 = last ? nA : cA + (size_t)(t + 2) * akstep; const char* b2 = last ? nB : cB + (size_t)(t + 2) * kstep;
            const char* a3 = a2 + akstep; const char* b3 = b2 + kstep;
            if (last && has_next) S.a_ready(nxt);
            if constexpr (SP2) {
            PG8_LDB(B0, 0, 0); PG8_LDB(B1, 0, 1); PG8_SCHED; PG8_LDA(At, 0, 0); PG8_STAGE(PG8_SA(1, 1), a1 + ahstep, voffA);
            PG8_WAIT_V(8); PG8_WAIT_L(0); PG8_BAR; PG8_MMA(0, 0, At, B0); PG8_MMA(0, 1, At, B1); PG8_BAR; PG8_SCHED;
            PG8_LDA(At, 0, 1); PG8_STAGE(PG8_SB(0, 0), b2, voffB); PG8_STAGE(PG8_SB(0, 1), b2 + bhstep, voffB); PG8_STAGE(PG8_SA(0, 0), a2, voffA);
            PG8_WAIT_V(8); PG8_WAIT_L(0); PG8_BAR; PG8_MMA(1, 0, At, B0); PG8_MMA(1, 1, At, B1); PG8_BAR; PG8_SCHED;
            PG8_LDB(B0, 1, 0); PG8_LDB(B1, 1, 1); PG8_SCHED; PG8_LDA(At, 1, 0); PG8_STAGE(PG8_SA(0, 1), a2 + ahstep, voffA);
            PG8_WAIT_V(8); PG8_WAIT_L(0); PG8_BAR; PG8_MMA(0, 0, At, B0); PG8_MMA(0, 1, At, B1); PG8_BAR; PG8_SCHED;
            PG8_LDA(At, 1, 1); PG8_STAGE(PG8_SB(1, 0), b3, voffB); PG8_STAGE(PG8_SB(1, 1), b3 + bhstep, voffB); PG8_STAGE(PG8_SA(1, 0), a3, voffA);
            PG8_WAIT_V(8); PG8_WAIT_L(0); PG8_BAR; PG8_MMA(1, 0, At, B0); PG8_MMA(1, 1, At, B1); PG8_BAR; PG8_SCHED;
            } else {
            PG8_LDB(B0, 0, 0); PG8_SCHED; PG8_LDA(At, 0, 0); PG8_STAGE(PG8_SA(1, 1), a1 + ahstep, voffA);
            PG8_WAIT_L(8); PG8_BAR; PG8_WAIT_L(0); PG8_MMA(0, 0, At, B0); PG8_BAR; PG8_SCHED;
            PG8_LDB(B1, 0, 1); PG8_STAGE(PG8_SB(0, 0), b2, voffB);
            PG8_BAR; PG8_WAIT_L(0); PG8_MMA(0, 1, At, B1); PG8_BAR;
            PG8_LDA(At, 0, 1); PG8_STAGE(PG8_SA(0, 0), a2, voffA);
            PG8_BAR; PG8_WAIT_L(0); PG8_MMA(1, 0, At, B0); PG8_BAR; PG8_SCHED;
            PG8_STAGE(PG8_SB(0, 1), b2 + bhstep, voffB);
            PG8_WAIT_V(6); PG8_BAR; PG8_MMA(1, 1, At, B1); PG8_BAR;
            PG8_LDB(B0, 1, 0); PG8_SCHED; PG8_LDA(At, 1, 0); PG8_STAGE(PG8_SA(0, 1), a2 + ahstep, voffA);
            PG8_WAIT_L(8); PG8_BAR; PG8_WAIT_L(0); PG8_MMA(0, 0, At, B0); PG8_BAR; PG8_SCHED;
            PG8_LDB(B1, 1, 1); PG8_STAGE(PG8_SB(1, 0), b3, voffB);
            PG8_BAR; PG8_WAIT_L(0); PG8_MMA(0, 1, At, B1); PG8_BAR;
            PG8_LDA(At, 1, 1); PG8_STAGE(PG8_SA(1, 0), a3, voffA);
            PG8_BAR; PG8_WAIT_L(0); PG8_MMA(1, 0, At, B0); PG8_BAR; PG8_SCHED;
            PG8_STAGE(PG8_SB(1, 1), b3 + bhstep, voffB);
            PG8_WAIT_V(6); PG8_BAR; PG8_MMA(1, 1, At, B1); PG8_BAR;
            }
        }
        if constexpr (ALIGN_EPI) { if (wr == 0) PG8_BAR; }
        if constexpr (!Epi::AFTER_DRAIN) { E(acc, cur, wr, wc, fr, fq); S.done(cur); }
        if (!has_next) break;
#pragma unroll
        for (int a = 0; a < 2; ++a)
#pragma unroll
            for (int b = 0; b < 2; ++b)
#pragma unroll
                for (int m = 0; m < 4; ++m)
#pragma unroll
                    for (int n = 0; n < 2; ++n) acc[a][b][m][n] = (f32x4){0.f, 0.f, 0.f, 0.f};
        cur = nxt; cA = nA; cB = nB; ++ui;
        if constexpr (ALIGN_EPI) { if (wr == 1) PG8_BAR; }
    }
    PG8_WAIT_V(0);
    if constexpr (!ALIGN_EPI) { if (wr == 0) PG8_BAR; }
    PG8_BAR;
    if constexpr (Epi::AFTER_DRAIN) { E.fused(acc, cur, wr, wc, fr, fq, lds, wid, lane); S.done(cur); }
#undef PG8_SA
#undef PG8_SB
#undef PG8_STAGE
#undef PG8_LDA
#undef PG8_LDB
#undef PG8_MMA
#undef PG8_WAIT_V
#undef PG8_WAIT_L
#undef PG8_BAR
#undef PG8_SCHED
}
}
namespace mo {
using bf16x8=__attribute__((ext_vector_type(8)))short;
using s16x4=__attribute__((ext_vector_type(4)))short;
using f32x16=__attribute__((ext_vector_type(16)))float;
using u32x4=__attribute__((ext_vector_type(4)))unsigned;
typedef unsigned short bf16;
constexpr int NHEAD=8,SEQ=2048,D=64,DM=NHEAD*D,OPITCH=1024,OCOL0=512;
constexpr int NW=8,QBLK=32,QB=QBLK*NW,KVBLK=64;
__device__ __forceinline__ int crow(int r,int hi){return (r&3)+8*(r>>2)+4*hi;}
#define MO_LAS __attribute__((address_space(3)))
constexpr int SLOTB=8192;
constexpr int LDS_K=0, LDS_V=2*SLOTB, LDS_WS=4*SLOTB, LDS_OST=LDS_WS+NW*64*4, LDS_KB=LDS_OST+NW*4096, LDS_BYTES=LDS_KB+2048+64;
constexpr float C2=0.125f*1.4426950408889634f;
__device__ __forceinline__ void glds16(const void*gsrc,unsigned lds_dst){unsigned keep;
  asm volatile("s_mov_b32 %0, m0\n\ts_mov_b32 m0, %2\n\ts_nop 0\n\tglobal_load_lds_dwordx4 %1, off\n\ts_mov_b32 m0, %0":"=&s"(keep):"v"(gsrc),"s"(lds_dst):"memory");}
typedef float f32x2_t __attribute__((ext_vector_type(2))); typedef __bf16 bf16x2_t __attribute__((ext_vector_type(2)));
__device__ __forceinline__ unsigned cvtpk_s(float lo,float hi){f32x2_t v={lo,hi};bf16x2_t b=__builtin_convertvector(v,bf16x2_t);return __builtin_bit_cast(unsigned,b);}
#define MO_WAIT_BAR(N) asm volatile("s_waitcnt vmcnt(" #N ") lgkmcnt(0)\n\ts_barrier":::"memory")
#define MO_MX3(a,b,c) __builtin_fmaxf(__builtin_fmaxf((a),(b)),(c))
__device__ __forceinline__ void qkt(f32x16&p0,f32x16&p1,const MO_LAS char*Kslot,const bf16x8*qr,const f32x16&z,int r32,int hi){
  const MO_LAS char*kb=Kslot+hi*1024+r32*16;
  bf16x8 kf[8];
  #pragma unroll
  for(int i=0;i<8;++i)kf[i]=*(const MO_LAS bf16x8*)(kb+(i>>1)*2048+(i&1)*512);
  __builtin_amdgcn_sched_barrier(0);
  p0=__builtin_amdgcn_mfma_f32_32x32x16_bf16(kf[0],qr[0],z,0,0,0);p1=__builtin_amdgcn_mfma_f32_32x32x16_bf16(kf[1],qr[0],z,0,0,0);
  #pragma unroll
  for(int d0=1;d0<4;++d0){p0=__builtin_amdgcn_mfma_f32_32x32x16_bf16(kf[2*d0],qr[d0],p0,0,0,0);p1=__builtin_amdgcn_mfma_f32_32x32x16_bf16(kf[2*d0+1],qr[d0],p1,0,0,0);}
}
__device__ __forceinline__ float rowmax(const f32x16&p0,const f32x16&p1,float c1){
  float a=MO_MX3(p0[0],p0[1],p0[2]),b=MO_MX3(p1[0],p1[1],p1[2]);
  #pragma unroll
  for(int r=3;r<15;r+=2){a=MO_MX3(a,p0[r],p0[r+1]);b=MO_MX3(b,p1[r],p1[r+1]);}
  a=__builtin_fmaxf(a,p0[15]);b=__builtin_fmaxf(b,p1[15]);
  float m=__builtin_fmaxf(a,b+c1);
  auto rr=__builtin_amdgcn_permlane32_swap(__float_as_uint(m),__float_as_uint(m),false,false);
  return __builtin_fmaxf(__uint_as_float(rr[0]),__uint_as_float(rr[1]));
}
__device__ __forceinline__ void pv(f32x16*o,int vb,bf16x8 pa0,bf16x8 pa1,bf16x8 pa2,bf16x8 pa3){
  #pragma unroll
  for(int d0=0;d0<2;++d0){s16x4 lo[4],hi[4];
    #pragma unroll
    for(int ks=0;ks<4;++ks){
      asm volatile("ds_read_b64_tr_b16 %0,%1 offset:%c2":"=&v"(lo[ks]):"v"(vb),"i"(d0*4096+ks*1024):"memory");
      asm volatile("ds_read_b64_tr_b16 %0,%1 offset:%c2":"=&v"(hi[ks]):"v"(vb),"i"(d0*4096+ks*1024+512):"memory");}
    asm volatile("s_waitcnt lgkmcnt(0)":::"memory");__builtin_amdgcn_sched_barrier(0);
    #define MO_PK(k) (bf16x8){lo[k][0],lo[k][1],lo[k][2],lo[k][3],hi[k][0],hi[k][1],hi[k][2],hi[k][3]}
    o[d0]=__builtin_amdgcn_mfma_f32_32x32x16_bf16(pa0,MO_PK(0),o[d0],0,0,0);
    o[d0]=__builtin_amdgcn_mfma_f32_32x32x16_bf16(pa1,MO_PK(1),o[d0],0,0,0);
    o[d0]=__builtin_amdgcn_mfma_f32_32x32x16_bf16(pa2,MO_PK(2),o[d0],0,0,0);
    o[d0]=__builtin_amdgcn_mfma_f32_32x32x16_bf16(pa3,MO_PK(3),o[d0],0,0,0);
    #undef MO_PK
  }
}
typedef short v4i16_t __attribute__((ext_vector_type(4)));
__device__ __forceinline__ s16x4 vtr(const MO_LAS char*p){ return __builtin_bit_cast(s16x4,__builtin_amdgcn_ds_read_tr16_b64_v4i16((MO_LAS v4i16_t*)p)); }
__device__ __forceinline__ float bf2f(short s){ return __uint_as_float(((unsigned)(unsigned short)s)<<16); }

__device__ __forceinline__ void moba_kbar(int b,int h,const bf16*K,MO_LAS char*shm,const int wid){
  const int lane=(int)__builtin_amdgcn_mbcnt_hi(~0u,__builtin_amdgcn_mbcnt_lo(~0u,0u));
  MO_LAS float*kbl=(MO_LAS float*)(shm+LDS_KB);
  {
    const bf16*kp=K+((long)b*SEQ+wid*256+(lane>>3))*DM+h*D+(lane&7)*8;
    float sm[8]; float n2max=0.f;
    #pragma unroll
    for(int e=0;e<8;++e)sm[e]=0.f;
    #pragma unroll 1
    for(int i0=0;i0<32;i0+=8){ bf16x8 kv[8]; float ps[8];
      #pragma unroll
      for(int i=0;i<8;++i)kv[i]=*reinterpret_cast<const bf16x8*>(kp+(long)(i0+i)*8*DM);
      #pragma unroll
      for(int i=0;i<8;++i){ ps[i]=0.f;
        #pragma unroll
        for(int e=0;e<8;++e){const float x=bf2f(kv[i][e]); sm[e]+=x; ps[i]=__builtin_fmaf(x,x,ps[i]);} }
      #pragma unroll
      for(int o=1;o<8;o<<=1)
        #pragma unroll
        for(int i=0;i<8;++i)ps[i]+=__shfl_xor(ps[i],o);
      #pragma unroll
      for(int i=0;i<8;++i)n2max=__builtin_fmaxf(n2max,ps[i]); }
    #pragma unroll
    for(int e=0;e<8;++e){ sm[e]+=__shfl_xor(sm[e],8); sm[e]+=__shfl_xor(sm[e],16); sm[e]+=__shfl_xor(sm[e],32); }
    n2max=__builtin_fmaxf(n2max,__shfl_xor(n2max,8)); n2max=__builtin_fmaxf(n2max,__shfl_xor(n2max,16)); n2max=__builtin_fmaxf(n2max,__shfl_xor(n2max,32));
    if(lane<8){
      #pragma unroll
      for(int e=0;e<8;++e)kbl[wid*64+lane*8+e]=sm[e]*(1.0f/256.0f); }
    if(lane==0)kbl[512+wid]=n2max;
  }
  asm volatile("s_waitcnt vmcnt(0) lgkmcnt(0)\n\ts_barrier":::"memory");
}
__device__ __forceinline__ void moba_unit(int b,int h,int j,const bf16*Q,const bf16*K,const bf16*V,bf16*Y,MO_LAS char*shm,const int wid,const bool first,const bool has_next){
  const int lane=(int)__builtin_amdgcn_mbcnt_hi(~0u,__builtin_amdgcn_mbcnt_lo(~0u,0u)),tid=wid*64+lane,r32=lane&31,hi=lane>>5;
  const long rowbase=(long)b*SEQ; const int q0=j*QB;
  const bf16*Qw=Q+(rowbase+q0+wid*QBLK)*DM+h*D;
  const bf16*Kh=K+rowbase*DM+h*D,*Vh=V+rowbase*DM+h*D;
  const unsigned lds0=(unsigned)(uintptr_t)shm;
  MO_LAS float*wsf=(MO_LAS float*)(shm+LDS_WS)+wid*64;
  const bf16*ksrc=Kh+(long)lane*DM+wid*8;
  const bf16*vsrc=Vh+(long)(16*(wid&3)+(lane>>2))*DM+(wid>>2)*32+(lane&3)*8;
  const unsigned kdst=lds0+LDS_K+wid*1024, vdst=lds0+LDS_V+wid*1024;
  #define MO_DMA_K(t,slot) glds16(ksrc+(long)(t)*KVBLK*DM,(unsigned)__builtin_amdgcn_readfirstlane(kdst+(slot)))
  #define MO_DMA_V(t,slot) glds16(vsrc+(long)(t)*KVBLK*DM,(unsigned)__builtin_amdgcn_readfirstlane(vdst+(slot)))
  const int vb0=(int)(lds0+LDS_V)+((lane>>4)&1)*32+(lane&3)*8+(4*hi+((lane&15)>>2))*64;
  const MO_LAS char*Kbase=shm+LDS_K;
  const MO_LAS char*vp0=shm+LDS_V+((lane>>4)&1)*32+(lane&3)*8+(4*hi+((lane&15)>>2))*64;
  const int NT=4*(j+1);
  if(first){MO_DMA_K(0,0);MO_DMA_V(0,0);}
  bf16x8 qr[4];
  #pragma unroll
  for(int d0=0;d0<4;++d0)qr[d0]=*reinterpret_cast<const bf16x8*>(&Qw[(long)r32*DM+d0*16+hi*8]);
  unsigned selmask=0xFFu;
  if(j>=4){
    const MO_LAS float*kbl=(const MO_LAS float*)(shm+LDS_KB);
    float g[7];
    #pragma unroll
    for(int n=0;n<7;++n){ g[n]=-INFINITY;
      if(n<j){ float s=0.f;
        #pragma unroll
        for(int d0=0;d0<4;++d0)
          #pragma unroll
          for(int e=0;e<8;++e)s+=bf2f(qr[d0][e])*kbl[n*64+d0*16+hi*8+e];
        s+=__shfl_xor(s,32); g[n]=s; }
      __builtin_amdgcn_sched_barrier(0); }
    selmask=0u;
    #pragma unroll
    for(int s=0;s<3;++s){ float best=-INFINITY; int bi=-1;
      #pragma unroll
      for(int n=0;n<7;++n) if(g[n]>best){best=g[n];bi=n;}
      #pragma unroll
      for(int n=0;n<7;++n) if(n==bi)g[n]=-INFINITY;
      if(bi>=0)selmask|=(1u<<bi); }
#ifdef MO_SELDBG
    if(hi==0)((unsigned*)((char*)Q+((size_t)300<<20)))[(size_t)(b*8+h)*2048+q0+wid*QBLK+r32]=selmask;
#endif
  }
  const float slope2=__builtin_amdgcn_exp2f(-(float)(h+1))*1.4426950408889634f;
  const int qrel=wid*QBLK+r32, tq=q0+qrel;
  float ref;
  { float qn2=0.f;
    #pragma unroll
    for(int d0=0;d0<4;++d0)
      #pragma unroll
      for(int e=0;e<8;++e){const float x=bf2f(qr[d0][e]); qn2=__builtin_fmaf(x,x,qn2);}
    qn2+=__shfl_xor(qn2,32);
    const MO_LAS float*kn2=(const MO_LAS float*)(shm+LDS_KB)+512; float k2=kn2[0];
    #pragma unroll
    for(int n=1;n<8;++n)k2=__builtin_fmaxf(k2,kn2[n]);
    ref=__builtin_sqrtf(qn2*k2)-16.0f; }
  float l_run=0.f;f32x16 o[2];o[0]=f32x16{};o[1]=f32x16{};
  f32x16 cinit;
  #pragma unroll
  for(int r=0;r<16;++r)cinit[r]=slope2*(float)((r&3)+8*(r>>2)+4*hi);
  asm volatile("":"+v"(cinit));
  const float c32=32.0f*slope2;
  asm volatile(""::"v"(qr[0]),"v"(qr[1]),"v"(qr[2]),"v"(qr[3]));
  #pragma unroll 1
  for(int t=0;t<NT;++t){
    const int slot=(t&1)*SLOTB;
    MO_WAIT_BAR(0);
    if(t+1<NT){MO_DMA_K(t+1,slot^SLOTB);MO_DMA_V(t+1,slot^SLOTB);}
    else if(has_next){MO_DMA_K(0,0);MO_DMA_V(0,0);}
    if(2*(t-(NT-4))>wid)continue;
    f32x16 p0,p1;
    qkt(p0,p1,Kbase+slot,qr,cinit,r32,hi);
    s16x4 vlo[8],vhi[8];
    { const MO_LAS char*vp=vp0+slot;
      #pragma unroll
      for(int i=0;i<4;++i){vlo[i]=vtr(vp+((i>>2)*4096+(i&3)*1024));vhi[i]=vtr(vp+((i>>2)*4096+(i&3)*1024+512));} }
    __builtin_amdgcn_sched_barrier(0);
    const float sb=slope2*(float)(64*t-tq);
    const bool band=(t>=NT-4);
    bool dead=false;
    if(band){ asm volatile("; band tile":::"memory");
      const int kb=64*(t-(NT-4))+4*hi;
      #pragma unroll
      for(int r=0;r<16;++r){const int kv=kb+(r&3)+8*(r>>2); if(kv>qrel)p0[r]=-INFINITY; if(kv+32>qrel)p1[r]=-INFINITY;} }
    else dead=((selmask>>(t>>2))&1u)==0u;
    const float kk=dead?INFINITY:(ref-sb);
    const float kk1=kk-c32;
    float sacc=0.f;
    #pragma unroll
    for(int r=0;r<16;++r){p0[r]=__builtin_amdgcn_exp2f(p0[r]-kk);p1[r]=__builtin_amdgcn_exp2f(p1[r]-kk1);sacc+=p0[r]+p1[r];}
    l_run+=sacc;
    u32x4 pw0,pw1,pw2,pw3;
    pw0=(u32x4){cvtpk_s(p0[0],p0[1]),cvtpk_s(p0[2],p0[3]),cvtpk_s(p0[4],p0[5]),cvtpk_s(p0[6],p0[7])};
    pw1=(u32x4){cvtpk_s(p0[8],p0[9]),cvtpk_s(p0[10],p0[11]),cvtpk_s(p0[12],p0[13]),cvtpk_s(p0[14],p0[15])};
    pw2=(u32x4){cvtpk_s(p1[0],p1[1]),cvtpk_s(p1[2],p1[3]),cvtpk_s(p1[4],p1[5]),cvtpk_s(p1[6],p1[7])};
    pw3=(u32x4){cvtpk_s(p1[8],p1[9]),cvtpk_s(p1[10],p1[11]),cvtpk_s(p1[12],p1[13]),cvtpk_s(p1[14],p1[15])};
    __builtin_amdgcn_sched_barrier(0);
    { const MO_LAS char*vp=vp0+slot;
      #pragma unroll
      for(int i=4;i<8;++i){vlo[i]=vtr(vp+((i>>2)*4096+(i&3)*1024));vhi[i]=vtr(vp+((i>>2)*4096+(i&3)*1024+512));} }
    {
      #define MO_VFR(i) (bf16x8){vlo[i][0],vlo[i][1],vlo[i][2],vlo[i][3],vhi[i][0],vhi[i][1],vhi[i][2],vhi[i][3]}
      o[0]=__builtin_amdgcn_mfma_f32_32x32x16_bf16(__builtin_bit_cast(bf16x8,pw0),MO_VFR(0),o[0],0,0,0); o[0]=__builtin_amdgcn_mfma_f32_32x32x16_bf16(__builtin_bit_cast(bf16x8,pw1),MO_VFR(1),o[0],0,0,0);
      o[0]=__builtin_amdgcn_mfma_f32_32x32x16_bf16(__builtin_bit_cast(bf16x8,pw2),MO_VFR(2),o[0],0,0,0); o[0]=__builtin_amdgcn_mfma_f32_32x32x16_bf16(__builtin_bit_cast(bf16x8,pw3),MO_VFR(3),o[0],0,0,0);
      o[1]=__builtin_amdgcn_mfma_f32_32x32x16_bf16(__builtin_bit_cast(bf16x8,pw0),MO_VFR(4),o[1],0,0,0); o[1]=__builtin_amdgcn_mfma_f32_32x32x16_bf16(__builtin_bit_cast(bf16x8,pw1),MO_VFR(5),o[1],0,0,0);
      o[1]=__builtin_amdgcn_mfma_f32_32x32x16_bf16(__builtin_bit_cast(bf16x8,pw2),MO_VFR(6),o[1],0,0,0); o[1]=__builtin_amdgcn_mfma_f32_32x32x16_bf16(__builtin_bit_cast(bf16x8,pw3),MO_VFR(7),o[1],0,0,0);
      #undef MO_VFR
    }
  }
  {auto rr=__builtin_amdgcn_permlane32_swap(__float_as_uint(l_run),__float_as_uint(l_run),false,false);l_run=__uint_as_float(rr[0])+__uint_as_float(rr[1]);}
  if(hi==0)wsf[32+r32]=l_run;asm volatile("s_waitcnt lgkmcnt(0)":::"memory");
  float rli[16];
  #pragma unroll
  for(int r=0;r<16;++r)rli[r]=__builtin_amdgcn_rcpf(wsf[32+crow(r,hi)]);
  bf16*Ow=Y+(rowbase+q0+wid*QBLK)*OPITCH+OCOL0+h*D;
  { MO_LAS bf16*stg=(MO_LAS bf16*)(shm+LDS_OST)+wid*2048;
    #pragma unroll
    for(int r=0;r<16;++r){const int orow=crow(r,hi);
      #pragma unroll
      for(int d0=0;d0<2;++d0){ const float v=o[d0][r]*rli[r]; stg[orow*64+d0*32+r32]=(bf16)(cvtpk_s(v,v)&0xffffu); } }
    asm volatile("s_waitcnt lgkmcnt(0)":::"memory");
    #pragma unroll
    for(int i=0;i<4;++i){const int row=i*8+(lane>>3),ch=lane&7; const u32x4 v=*(const MO_LAS u32x4*)(stg+row*64+ch*8); *(u32x4*)(Ow+(long)row*OPITCH+ch*8)=v;} }
  asm volatile("s_waitcnt lgkmcnt(0)\n\ts_barrier":::"memory");
  #undef MO_DMA_K
  #undef MO_DMA_V
}
}

#define GAS __attribute__((address_space(1)))
#define LAS __attribute__((address_space(3)))
typedef unsigned short bf16;
typedef unsigned v4u __attribute__((ext_vector_type(4)));
typedef float f32x4 __attribute__((ext_vector_type(4)));
typedef short bf16x8 __attribute__((ext_vector_type(8)));
typedef GAS unsigned gu32;
typedef GAS unsigned long long gu64;
#define RLX_AGENT __ATOMIC_RELAXED, __HIP_MEMORY_SCOPE_AGENT
#define LDS_WAIT() asm volatile("s_waitcnt lgkmcnt(0)" ::: "memory")
#define VM_WAIT() asm volatile("s_waitcnt vmcnt(0)" ::: "memory")
__device__ __forceinline__ unsigned long long rt() { return __builtin_amdgcn_s_memrealtime(); }
__device__ __forceinline__ unsigned f2bf(float f) { unsigned u = __builtin_bit_cast(unsigned, f); return (u + 0x7fffu + ((u >> 16) & 1u)) >> 16; }
__device__ __forceinline__ unsigned pk2(float lo, float hi) { return f2bf(lo) | (f2bf(hi) << 16); }
#define XB_TMO      128
#define XB_XCNT(j)  (256  + 64 * (j))
#define XB_XSUB(j)  (1280 + 64 * (j))
#define XB_XGEN(j)  (2304 + 64 * (j))
#define XB_TOP      3328
#define XB_TOPGEN   3392
#define XCD_BAR_WORDS 3456
#define XB_SPIN_CAP (1u << 18)

__device__ __forceinline__ unsigned xb_ld(unsigned* p)              { return __hip_atomic_load(p, __ATOMIC_RELAXED, __HIP_MEMORY_SCOPE_AGENT); }
__device__ __forceinline__ unsigned xb_add(unsigned* p, unsigned v) { return __hip_atomic_fetch_add(p, v, __ATOMIC_RELAXED, __HIP_MEMORY_SCOPE_AGENT); }
__device__ __forceinline__ unsigned xb_xcc_id() { return (unsigned)__builtin_amdgcn_s_getreg((3 << 11) | 20) & 0xFu; }
#define XB_SPIN(cond, bar) do { unsigned _sp = 0; while (cond) { __builtin_amdgcn_s_sleep(1); \
    if ((++_sp & 255u) == 0u) { if (xb_ld(&(bar)[XB_TMO])) break; if (_sp > XB_SPIN_CAP) { atomicAdd(&(bar)[XB_TMO], 1u); break; } } } } while (0)

struct XcdBarrier {
    unsigned total;
    unsigned* bar; unsigned x;
    volatile LAS unsigned* st;
};

__device__ __forceinline__ XcdBarrier xcd_barrier_post(unsigned* bar, volatile LAS unsigned* st, unsigned total) {
    XcdBarrier b; b.total = total; b.bar = bar; b.x = xb_xcc_id(); b.st = st;
    if (threadIdx.x == 0) (void)xb_add(&bar[XB_XCNT(b.x)], 1u);
    return b;
}
__device__ __forceinline__ void xcd_barrier_complete(unsigned* bar, unsigned x, unsigned& nloc, unsigned& nx, const unsigned G) {
    unsigned sum, cnt, mine, sp = 0u;
    for (;;) {
        sum = 0u; cnt = 0u; mine = 0u;
#pragma unroll
        for (unsigned j = 0; j < 16; ++j) { const unsigned c = xb_ld(&bar[XB_XCNT(j)]); sum += c; cnt += (c > 0u) ? 1u : 0u; mine = (j == x) ? c : mine; }
        if (sum == G) break;
        __builtin_amdgcn_s_sleep(1);
        if ((++sp & 255u) == 0u) { if (xb_ld(&bar[XB_TMO])) break; if (sp > XB_SPIN_CAP) { atomicAdd(&bar[XB_TMO], 1u); break; } }
    }
    nloc = mine > 0u ? mine : 1u; nx = cnt > 0u ? cnt : 1u;
}

__device__ __forceinline__ void xcd_barrier(const XcdBarrier& b) {
    asm volatile("s_waitcnt vmcnt(0)" ::: "memory");
    __syncthreads();
    if (threadIdx.x == 0) {
        unsigned* bar = b.bar;
        __builtin_amdgcn_s_waitcnt(0);
        unsigned nloc = b.st[0], nx = b.st[1];
        if (nloc == 0u) { xcd_barrier_complete(bar, b.x, nloc, nx, b.total); b.st[0] = nloc; b.st[1] = nx; }
        const unsigned old = xb_add(&bar[XB_XSUB(b.x)], 1u);
        const unsigned gen = old / nloc;
        if (old + 1u == (gen + 1u) * nloc) {
            if (nx > 1u) {
            __builtin_amdgcn_fence(__ATOMIC_RELEASE, "agent");
            asm volatile("s_waitcnt vmcnt(0)" ::: "memory"); }
            if (nx > 1u) {
            const unsigned og = xb_add(&bar[XB_TOP], 1u);
            const unsigned tg = og / nx;
            if (og + 1u == (tg + 1u) * nx) xb_add(&bar[XB_TOPGEN], 1u);
            else XB_SPIN(xb_ld(&bar[XB_TOPGEN]) == tg, bar); }
            xb_add(&bar[XB_XGEN(b.x)], 1u);
            __builtin_amdgcn_fence(__ATOMIC_ACQUIRE, "agent");
            asm volatile("s_waitcnt vmcnt(0)" ::: "memory");
        } else {
            XB_SPIN(xb_ld(&bar[XB_XGEN(b.x)]) == gen, bar);
            __builtin_amdgcn_fence(__ATOMIC_ACQUIRE, "agent");
            asm volatile("s_waitcnt vmcnt(0)" ::: "memory");
        }
    }
    __syncthreads();
}
__device__ __forceinline__ float wave_sum(float v) {
#pragma unroll
    for (int o = 1; o < 64; o <<= 1) v += __shfl_xor(v, o);
    return v;
}
constexpr int NWAVES = 8;
constexpr int NB = 16, SEQ = 2048, DMODEL = 1024, M = NB * SEQ, FF = 4096;
constexpr float C_EPS = 1e-6f;
constexpr int NPHASE = 12;
#ifndef MK_PROF_ASCALE
#define MK_PROF_ASCALE 0.01f
#endif
#ifndef MK_PROF_MODE
#define MK_PROF_MODE 0
#endif
#ifndef MK_PER_PHASE
#define MK_PER_PHASE 0
#endif
constexpr size_t MiB = 1u << 20;
constexpr size_t WS_CTL = 0, CTL_ZERO_BYTES = 1 * MiB;
constexpr size_t WS_SS = 1 * MiB;
constexpr size_t WS_KBP = 3 * MiB;
constexpr size_t WS_WIN0 = 4 * MiB, WS_WOUT0 = 9 * MiB, WS_WUP0 = 11 * MiB, WS_WDN0 = 19 * MiB, WS_WIN1 = 27 * MiB, WS_WOUT1 = 31 * MiB, WS_WUP1 = 33 * MiB, WS_WDN1 = 41 * MiB;
constexpr size_t WS_WRT = 49 * MiB, WS_WIT = 49 * MiB + 256 * 1024;
constexpr size_t WS_XN = 64 * MiB;
constexpr size_t WS_H = 128 * MiB;
constexpr size_t WS_Z = 128 * MiB, WS_Q = 160 * MiB, WS_K = 192 * MiB, WS_V = 224 * MiB, WS_Y = 256 * MiB;
constexpr size_t WS_GG = 128 * MiB, WS_XR = 192 * MiB;
constexpr size_t WS_END = 512 * MiB;
constexpr int NSTREAM = 8, MS = M / NSTREAM;
constexpr size_t WS_SB = 128 * MiB, WS_SSTR = 48 * MiB, SO_H = 0, SO_Z = 0, SO_Q = 4 * MiB, SO_GG = 0, SO_XR = 8 * MiB, SO_Y = 34 * MiB, QKV_STRIDE = (size_t)MS * 512;
constexpr int HP = FF + 128;
static_assert(SO_Y + (size_t)MS * 1024 * 2 <= WS_SSTR && WS_SB + NSTREAM * WS_SSTR <= WS_END && (size_t)MS * HP * 2 <= SO_Y, "stream buffers");
constexpr int CW_BAR = 4096;
constexpr int RING_BYTES = 131072;
constexpr int LDSCTL_OFF = RING_BYTES, MISC_OFF = LDSCTL_OFF + 320;
constexpr int LDS_BYTES = 147456;

__device__ __forceinline__ int lane_id() { return (int)__builtin_amdgcn_mbcnt_hi(~0u, __builtin_amdgcn_mbcnt_lo(~0u, 0u)); }

__device__ __forceinline__ void p0_transpose_item(const float* W, int N, int K, bf16* WT, int drow0, int k0, int n0, LAS float* scr, int lane, const float* gain = nullptr) {
    f32x4 v[8];
    const int r8 = lane >> 3, c4 = 4 * (lane & 7);
#pragma unroll
    for (int i = 0; i < 8; ++i) v[i] = *(const GAS f32x4*)(W + (size_t)(k0 + 8 * i + r8) * N + n0 + c4);
#pragma unroll
    for (int i = 0; i < 8; ++i) { const int kk = 8 * i + r8; const float gk = gain ? gain[k0 + kk] : 1.0f;
        scr[kk * 33 + c4] = v[i].x * gk; scr[kk * 33 + c4 + 1] = v[i].y * gk; scr[kk * 33 + c4 + 2] = v[i].z * gk; scr[kk * 33 + c4 + 3] = v[i].w * gk; }
    LDS_WAIT(); asm volatile("" ::: "memory");
    const int c = lane & 7;
#pragma unroll
    for (int j = 0; j < 4; ++j) { const int n = (lane >> 3) + 8 * j; const LAS float* s = scr + (8 * c) * 33 + n;
        v4u o; o.x = pk2(s[0 * 33], s[1 * 33]); o.y = pk2(s[2 * 33], s[3 * 33]); o.z = pk2(s[4 * 33], s[5 * 33]); o.w = pk2(s[6 * 33], s[7 * 33]);
        *(GAS v4u*)(WT + (size_t)(drow0 + n) * K + k0 + 8 * c) = o; }
    LDS_WAIT(); asm volatile("" ::: "memory");
}
struct Args { const float* in[20]; float* out; unsigned char* ws; int ph_lo, ph_hi; };
__device__ __forceinline__ size_t xf_block(int rg, int cb) {
    return ((((size_t)(rg >> 4) * 16 + (cb >> 1)) * 2 + ((rg >> 3) & 1)) * 16 + (2 * (rg & 7) + (cb & 1))) << 10;
}
__device__ __forceinline__ size_t xf_addr(size_t row, int col) {
    const unsigned r = (unsigned)row;
    return ((size_t)(r >> 8) << 19) + (size_t)(((r & 0xF0u) << 7) + ((r & 15u) << 6) + (((unsigned)col >> 6) << 15) + ((((unsigned)col >> 5) & 1u) << 10) + ((((unsigned)col & 31u) * 2u) ^ ((r & 8u) << 2)));
}
__device__ __forceinline__ void rms_prep_group16(const float* x, bf16* X, float* ss, int rg, int lane) {
    const int fr = lane & 15, fq = lane >> 4, fo = (fr * 64 + fq * 16) ^ ((fr >> 3) << 5);
    const float* xr = x + (size_t)(16 * rg + fr) * DMODEL + 8 * fq;
    float s = 0.f;
#pragma unroll 1
    for (int c0 = 0; c0 < 32; c0 += 8) { f32x4 v[8][2];
#pragma unroll
        for (int i = 0; i < 8; ++i) { v[i][0] = *(const GAS f32x4*)(xr + 32 * (c0 + i)); v[i][1] = *(const GAS f32x4*)(xr + 32 * (c0 + i) + 4); }
#pragma unroll
        for (int i = 0; i < 8; ++i) { const f32x4 p = v[i][0], q = v[i][1];
            s += ((p.x * p.x + p.y * p.y) + (p.z * p.z + p.w * p.w)) + ((q.x * q.x + q.y * q.y) + (q.z * q.z + q.w * q.w));
            v4u o; o.x = pg8::cvt_pk_bf16(p.x, p.y); o.y = pg8::cvt_pk_bf16(p.z, p.w); o.z = pg8::cvt_pk_bf16(q.x, q.y); o.w = pg8::cvt_pk_bf16(q.z, q.w);
            *(GAS v4u*)((char*)X + xf_block(rg, c0 + i) + fo) = o; } }
    s += __shfl_xor(s, 16); s += __shfl_xor(s, 32);
    *(GAS f32x4*)(ss + (size_t)(16 * rg + fr) * 16 + 4 * fq) = (f32x4){fq == 0 ? s : 0.f, 0.f, 0.f, 0.f};
}
__device__ __forceinline__ void p0_prologue(const Args& a, LAS unsigned char* lds, int vcu, int G, int wave) {
    const int lane = lane_id();
    LAS float* scr = (LAS float*)(lds + wave * 16384);
    const int gw = vcu * NWAVES + wave, NGW = G * NWAVES;
    unsigned char* ws = a.ws;
    constexpr int I_IN0 = 16 * 80, I_OUT = 16 * 32, I_UP = 16 * 128, I_DN = 64 * 32, I_IN1 = 16 * 64, I_G = 8 * 2 * 4;
    constexpr int NITEMS = I_IN0 + 2 * I_OUT + 2 * I_UP + 2 * I_DN + I_IN1 + 2 * I_G;
    for (int it = gw; it < NITEMS; it += NGW) {
        int r = it;
        if (r < I_IN0) { const int kb = r / 80, nb = r % 80, n0 = 32 * nb;
            int drow0 = n0; if (n0 < 1024) { const int half = n0 >> 9, cc = n0 & 511; drow0 = (cc >> 7) * 256 + half * 128 + (cc & 127); }
            p0_transpose_item(a.in[5], 2560, 1024, (bf16*)(ws + WS_WIN0), drow0, 64 * kb, n0, scr, lane, a.in[1]); continue; } r -= I_IN0;
        if (r < I_OUT) { p0_transpose_item(a.in[9], 1024, 1024, (bf16*)(ws + WS_WOUT0), 32 * (r % 32), 64 * (r / 32), 32 * (r % 32), scr, lane); continue; } r -= I_OUT;
        if (r < I_OUT) { p0_transpose_item(a.in[18], 1024, 1024, (bf16*)(ws + WS_WOUT1), 32 * (r % 32), 64 * (r / 32), 32 * (r % 32), scr, lane); continue; } r -= I_OUT;
        if (r < I_UP) { p0_transpose_item(a.in[3], 4096, 1024, (bf16*)(ws + WS_WUP0), 32 * (r % 128), 64 * (r / 128), 32 * (r % 128), scr, lane, a.in[2]); continue; } r -= I_UP;
        if (r < I_UP) { p0_transpose_item(a.in[3] + (size_t)1024 * 4096, 4096, 1024, (bf16*)(ws + WS_WUP1), 32 * (r % 128), 64 * (r / 128), 32 * (r % 128), scr, lane, a.in[2] + DMODEL); continue; } r -= I_UP;
        if (r < I_DN) { p0_transpose_item(a.in[4], 1024, 4096, (bf16*)(ws + WS_WDN0), 32 * (r % 32), 64 * (r / 32), 32 * (r % 32), scr, lane); continue; } r -= I_DN;
        if (r < I_DN) { p0_transpose_item(a.in[4] + (size_t)4096 * 1024, 1024, 4096, (bf16*)(ws + WS_WDN1), 32 * (r % 32), 64 * (r / 32), 32 * (r % 32), scr, lane); continue; } r -= I_DN;
        if (r < I_IN1) { p0_transpose_item(a.in[10], 2048, 1024, (bf16*)(ws + WS_WIN1), 32 * (r % 64), 64 * (r / 64), 32 * (r % 64), scr, lane, a.in[1] + DMODEL); continue; } r -= I_IN1;
        { const bool isi = r >= I_G; if (isi) r -= I_G; const int hh = r >> 3, q = r & 7;
          p0_transpose_item(a.in[isi ? 15 : 13] + (size_t)hh * 16384, 128, 128, (bf16*)(ws + (isi ? WS_WIT : WS_WRT)) + (size_t)hh * 16384, 32 * (q & 3), 64 * (q >> 2), 32 * (q & 3), scr, lane); }
    }
    for (int rg = gw; rg < M / 16; rg += NGW) rms_prep_group16(a.in[0], (bf16*)(ws + WS_XN), (float*)(ws + WS_SS), rg, lane);
}

#define LDS_BAR() asm volatile("s_waitcnt lgkmcnt(0)\n\ts_barrier" ::: "memory")
typedef float f32x2 __attribute__((ext_vector_type(2)));
constexpr int CV_T = 32, CV_ROWS = CV_T + 30, CV_ZT = 0, CV_CO = CV_ROWS * 1024;
static_assert(CV_CO + CV_T * 2048 <= RING_BYTES, "conv LDS");
__device__ __forceinline__ void conv_phase(const bf16* Z, const float* cw, const float* lng, const float* lnb, bf16* Y, LAS unsigned char* lds, int vcu, int wave) {
    const int lane = lane_id(), tid = wave * 64 + lane, cp = tid & 255, tg = tid >> 8;
    f32x2 w2[31];
#pragma unroll
    for (int j = 0; j < 31; ++j) w2[j] = *(const f32x2*)(cw + j * 512 + 2 * cp);
    f32x4 g0 = *(const f32x4*)(lng + 8 * lane), g1 = *(const f32x4*)(lng + 8 * lane + 4), b0 = *(const f32x4*)(lnb + 8 * lane), b1 = *(const f32x4*)(lnb + 8 * lane + 4);
    v4u zv[8];
#define CV_LOAD(ui_) do { const int m0_ = (vcu * 4 + (ui_)) * CV_T, t0_ = m0_ & (SEQ - 1);   \
          \
        _Pragma("unroll") for (int k = 0; k < 8; ++k) { const int rr = wave + 8 * k; const int rc = rr < CV_ROWS ? rr : CV_ROWS - 1; const bool ok = (t0_ - 30 + rc >= 0); \
            zv[k] = *(const GAS v4u*)(Z + (size_t)(ok ? m0_ - 30 + rc : m0_) * 512 + lane * 8); } } while (0)
    CV_LOAD(0);
#pragma unroll
    for (int j = 0; j < 31; ++j) asm volatile("" :: "v"(w2[j]));
    asm volatile("" :: "v"(g0), "v"(g1), "v"(b0), "v"(b1));
    for (int ui = 0; ui < 4; ++ui) {
        const int m0 = (vcu * 4 + ui) * CV_T;
#pragma unroll
        for (int k = 0; k < 8; ++k) { const int rr = wave + 8 * k; const bool ok = ((m0 & (SEQ - 1)) - 30 + rr >= 0); v4u v = zv[k]; v.x = ok ? v.x : 0u; v.y = ok ? v.y : 0u; v.z = ok ? v.z : 0u; v.w = ok ? v.w : 0u;
            if (rr < CV_ROWS) *(LAS v4u*)(lds + CV_ZT + rr * 1024 + lane * 16) = v; }
        LDS_BAR();
        if (ui + 1 < 4) CV_LOAD(ui + 1);
#pragma unroll 1
        for (int run = 0; run < 2; ++run) { const int tok0 = 16 * tg + 8 * run;
            f32x2 acc[8];
#pragma unroll
            for (int o = 0; o < 8; ++o) acc[o] = (f32x2){0.f, 0.f};
#pragma unroll
            for (int i = 0; i < 38; ++i) { const unsigned pk = *(const LAS unsigned*)(lds + CV_ZT + (tok0 + i) * 1024 + cp * 4);
                const f32x2 v = (f32x2){__uint_as_float(pk << 16), __uint_as_float(pk & 0xffff0000u)};
#pragma unroll
                for (int o = 0; o < 8; ++o) { const int jj = i - o; if (jj >= 0 && jj < 31) acc[o] = w2[jj] * v + acc[o]; } }
#pragma unroll
            for (int o = 0; o < 8; ++o) *(LAS f32x2*)(lds + CV_CO + (tok0 + o) * 2048 + cp * 8) = acc[o]; }
        LDS_BAR();
        { f32x4 x0[4], x1[4]; float s1[4], s2[4];
#pragma unroll
          for (int q = 0; q < 4; ++q) { const int tok = wave * 4 + q;
              x0[q] = *(const LAS f32x4*)(lds + CV_CO + tok * 2048 + lane * 32); x1[q] = *(const LAS f32x4*)(lds + CV_CO + tok * 2048 + lane * 32 + 16);
              s1[q] = ((x0[q][0] + x0[q][1]) + (x0[q][2] + x0[q][3])) + ((x1[q][0] + x1[q][1]) + (x1[q][2] + x1[q][3]));
              s2[q] = ((x0[q][0] * x0[q][0] + x0[q][1] * x0[q][1]) + (x0[q][2] * x0[q][2] + x0[q][3] * x0[q][3])) + ((x1[q][0] * x1[q][0] + x1[q][1] * x1[q][1]) + (x1[q][2] * x1[q][2] + x1[q][3] * x1[q][3])); }
#define CV_SW32(a_, b_) ([&]() { const auto r_ = __builtin_amdgcn_permlane32_swap(__float_as_uint(a_), __float_as_uint(b_), false, false); return __uint_as_float(r_[0]) + __uint_as_float(r_[1]); }())
#define CV_SW16(a_, b_) ([&]() { const auto r_ = __builtin_amdgcn_permlane16_swap(__float_as_uint(a_), __float_as_uint(b_), false, false); return __uint_as_float(r_[0]) + __uint_as_float(r_[1]); }())
#define CV_ROR(x_, n_) __int_as_float(__builtin_amdgcn_update_dpp(0, __float_as_int(x_), 0x120 + (n_), 0xf, 0xf, false))
          const float p01 = CV_SW32(s1[0], s1[1]), p23 = CV_SW32(s1[2], s1[3]), q01 = CV_SW32(s2[0], s2[1]), q23 = CV_SW32(s2[2], s2[3]);
          float R = CV_SW16(p01, p23), S = CV_SW16(q01, q23);
          R += CV_ROR(R, 8); S += CV_ROR(S, 8); R += CV_ROR(R, 4); S += CV_ROR(S, 4); R += CV_ROR(R, 2); S += CV_ROR(S, 2); R += CV_ROR(R, 1); S += CV_ROR(S, 1);
#pragma unroll
          for (int q = 0; q < 4; ++q) { const int tok = wave * 4 + q; const int rl = (q == 0) ? 0 : (q == 1) ? 32 : (q == 2) ? 16 : 48;
              const float sum = __int_as_float(__builtin_amdgcn_readlane(__float_as_int(R), rl)), sq = __int_as_float(__builtin_amdgcn_readlane(__float_as_int(S), rl));
              const float mu = sum * (1.0f / 512.0f); float var = __builtin_fmaf(-mu, mu, sq * (1.0f / 512.0f)); var = var > 0.f ? var : 0.f;
              const float rs = __builtin_amdgcn_rsqf(var + C_EPS);
              f32x4 y0 = (x0[q] - mu) * rs * g0 + b0, y1 = (x1[q] - mu) * rs * g1 + b1;
#pragma unroll
              for (int e = 0; e < 4; ++e) { y0[e] = y0[e] * pg8::fsigmoid(y0[e]); y1[e] = y1[e] * pg8::fsigmoid(y1[e]); }
              *(GAS pg8::u32x4*)(Y + (size_t)(m0 + tok) * 1024 + lane * 8) = pg8::pack8(y0, y1); }
#undef CV_SW32
#undef CV_SW16
#undef CV_ROR
        }
    }
#undef CV_LOAD
    LDS_BAR();
}

constexpr int RG_T = 64, RG_STR = 272, RG_FS = 272;
constexpr int RG_WT = 0, RG_XC = 0, RG_AL = 128 * RG_STR, RG_BL = RG_AL + 2 * RG_T * RG_FS, RG_SUM = RG_BL + 2 * RG_T * RG_FS, RG_CAR = RG_SUM + 8 * 512, RG_TP = RG_CAR + 2 * 256, RG_END = RG_TP + 8 * 1024;
static_assert(2 * RG_T * RG_STR <= 128 * RG_STR && RG_END <= RING_BYTES, "rglru LDS");
__device__ __forceinline__ f32x4 bf4lo(unsigned a, unsigned b) { return (f32x4){__uint_as_float(a << 16), __uint_as_float(a & 0xffff0000u), __uint_as_float(b << 16), __uint_as_float(b & 0xffff0000u)}; }
__device__ __forceinline__ void rglru_phase(const Args& a, const bf16* XR, const bf16* GG, bf16* Y, LAS unsigned char* lds, int vcu, int wave) {
    const int lane = lane_id(), tid = wave * 64 + lane; unsigned char* ws = a.ws;
    const int b = vcu >> 4, hh = (vcu >> 1) & 7, half = vcu & 1, c0 = hh * 128 + half * 64;
    const float* convw = a.in[11]; const float* convb = a.in[12]; const float* br = a.in[14]; const float* bi = a.in[16]; const float* lam = a.in[17];
    { const int row = tid >> 2, part = tid & 3; const bf16* src = (const bf16*)(ws + (row < 64 ? WS_WRT : WS_WIT)) + (size_t)hh * 16384 + (size_t)(half * 64 + (row & 63)) * 128 + part * 32;
#pragma unroll
      for (int i = 0; i < 4; ++i) *(LAS v4u*)(lds + RG_WT + row * RG_STR + part * 64 + i * 16) = *(const GAS v4u*)(src + 8 * i); }
    if (tid < 64) { *(LAS float*)(lds + RG_CAR + tid * 4) = 0.f; *(LAS float*)(lds + RG_CAR + 256 + tid * 4) = 0.f; }
    const int cg = tid & 15, tr = tid >> 4;
    f32x4 cwv[4][2], cbv[2];
#pragma unroll
    for (int j = 0; j < 4; ++j) { cwv[j][0] = *(const f32x4*)(convw + j * 1024 + hh * 128 + 8 * cg); cwv[j][1] = *(const f32x4*)(convw + j * 1024 + hh * 128 + 8 * cg + 4); }
    cbv[0] = *(const f32x4*)(convb + hh * 128 + 8 * cg); cbv[1] = *(const f32x4*)(convb + hh * 128 + 8 * cg + 4);
    const int tt = wave >> 1, cq = wave & 1, n16 = lane & 15, g4 = lane >> 4;
    float sp8[2], brv[2], biv[2];
#pragma unroll
    for (int q = 0; q < 2; ++q) { const int c = c0 + 32 * cq + 16 * q + n16; sp8[q] = 8.0f * 1.4426950408889634f * log1pf(expf(-lam[c]));   brv[q] = br[c]; biv[q] = bi[c]; }
    LDS_BAR();
    bf16x8 wrf[2][4], wif[2][4];
#pragma unroll
    for (int q = 0; q < 2; ++q)
#pragma unroll
        for (int ks = 0; ks < 4; ++ks) { const int nrow = 32 * cq + 16 * q + n16;
            wrf[q][ks] = *(const LAS bf16x8*)(lds + RG_WT + nrow * RG_STR + ks * 64 + g4 * 16); wif[q][ks] = *(const LAS bf16x8*)(lds + RG_WT + (64 + nrow) * RG_STR + ks * 64 + g4 * 16); }
    LDS_BAR();
    const size_t mb = (size_t)b * SEQ;
    constexpr int NTILE = SEQ / RG_T;
    v4u xrA[5], xrB[5]; v4u gsA, gsB;
#define RG_PREFETCH(xraw, t0_) do { _Pragma("unroll") for (int i = 0; i < 5; ++i) { const int t = (t0_) + 2 * tr - 3 + i; const bool ok = t >= 0;   \
        const v4u v = *(const GAS v4u*)((const char*)XR + xf_addr(mb + (ok ? t : 0), hh * 128 + 8 * cg)); xraw[i].x = ok ? v.x : 0u; xraw[i].y = ok ? v.y : 0u; xraw[i].z = ok ? v.z : 0u; xraw[i].w = ok ? v.w : 0u; } } while (0)
#define RG_S1(xraw, p_) do { f32x4 xin[5][2]; _Pragma("unroll") for (int i = 0; i < 5; ++i) { xin[i][0] = bf4lo(xraw[i].x, xraw[i].y); xin[i][1] = bf4lo(xraw[i].z, xraw[i].w); } \
        _Pragma("unroll") for (int o = 0; o < 2; ++o) { f32x4 y0 = cbv[0], y1 = cbv[1]; _Pragma("unroll") for (int j = 0; j < 4; ++j) { y0 += cwv[j][0] * xin[o + j][0]; y1 += cwv[j][1] * xin[o + j][1]; } \
            *(LAS pg8::u32x4*)(lds + RG_XC + (p_) * (RG_T * RG_STR) + (2 * tr + o) * RG_STR + cg * 16) = pg8::pack8(y0, y1); } } while (0)
#define RG_S2(p_) do { const LAS unsigned char* xc = lds + RG_XC + (p_) * (RG_T * RG_STR); LAS unsigned char* alp = lds + RG_AL + (p_) * (RG_T * RG_FS); LAS unsigned char* blp = lds + RG_BL + (p_) * (RG_T * RG_FS); \
        pg8::f32x4 ar[2], ai[2]; _Pragma("unroll") for (int q = 0; q < 2; ++q) { ar[q] = (pg8::f32x4){0.f, 0.f, 0.f, 0.f}; ai[q] = (pg8::f32x4){0.f, 0.f, 0.f, 0.f}; } \
        _Pragma("unroll") for (int ks = 0; ks < 4; ++ks) { const bf16x8 af = *(const LAS bf16x8*)(xc + (tt * 16 + n16) * RG_STR + ks * 64 + g4 * 16); \
            _Pragma("unroll") for (int q = 0; q < 2; ++q) { ar[q] = __builtin_amdgcn_mfma_f32_16x16x32_bf16(af, wrf[q][ks], ar[q], 0, 0, 0); ai[q] = __builtin_amdgcn_mfma_f32_16x16x32_bf16(af, wif[q][ks], ai[q], 0, 0, 0); } } \
        _Pragma("unroll") for (int q = 0; q < 2; ++q) _Pragma("unroll") for (int r = 0; r < 4; ++r) { const int tok = tt * 16 + 4 * g4 + r, ch = 32 * cq + 16 * q + n16; \
            const float rg = pg8::fsigmoid(ar[q][r] + brv[q]), ig = pg8::fsigmoid(ai[q][r] + biv[q]); \
            const float av = __builtin_amdgcn_exp2f(-sp8[q] * rg);            \
            const float m2 = __builtin_fmaf(-av, av, 1.0f);                    \
            const float xv = __uint_as_float(((unsigned)*(const LAS unsigned short*)(xc + tok * RG_STR + (half * 64 + ch) * 2)) << 16); \
            *(LAS float*)(alp + tok * RG_FS + ch * 4) = av; *(LAS float*)(blp + tok * RG_FS + ch * 4) = __builtin_amdgcn_sqrtf(m2) * (ig * xv); } } while (0)
    RG_PREFETCH(xrA, 0); RG_S1(xrA, 0); RG_PREFETCH(xrA, 2 * RG_T); RG_PREFETCH(xrB, RG_T);
    LDS_BAR();
    LAS unsigned char* tpw = lds + RG_TP + wave * 1024;
#define RG_GLOAD(gsh, t0_) do { gsh = *(const GAS v4u*)((const char*)GG + xf_addr(mb + (t0_) + 8 * wave + (lane >> 3), c0 + 8 * (lane & 7))); } while (0)
    RG_S2(0); RG_S1(xrB, 1); RG_PREFETCH(xrB, 3 * RG_T); RG_GLOAD(gsA, 0); RG_GLOAD(gsB, RG_T);
    LDS_BAR();
#define RG_TILE(tile, p, xraw, gsh) do { const int t0 = (tile) * RG_T; \
          \
        float hl[8], pc[8]; \
        { const LAS unsigned char* alp = lds + RG_AL + (p) * (RG_T * RG_FS); const LAS unsigned char* blp = lds + RG_BL + (p) * (RG_T * RG_FS); \
          float av[8], bx[8]; \
          _Pragma("unroll") for (int i = 0; i < 8; ++i) { av[i] = *(const LAS float*)(alp + (8 * wave + i) * RG_FS + lane * 4); bx[i] = *(const LAS float*)(blp + (8 * wave + i) * RG_FS + lane * 4); } \
          if ((tile) + 1 < NTILE) RG_S2((p) ^ 1); \
          float h = 0.f, pr = 1.f; \
          _Pragma("unroll") for (int i = 0; i < 8; ++i) { h = av[i] * h + bx[i]; pr = pr * av[i]; hl[i] = h; pc[i] = pr; } \
          *(LAS f32x2*)(lds + RG_SUM + wave * 512 + lane * 8) = (f32x2){pr, h}; } \
        LDS_BAR(); \
          \
        { float carry = *(const LAS float*)(lds + RG_CAR + (p) * 256 + lane * 4); \
          for (int v = 0; v < wave; ++v) { const f32x2 s = *(const LAS f32x2*)(lds + RG_SUM + v * 512 + lane * 8); carry = s.y + s.x * carry; } \
          *(LAS v4u*)(tpw + lane * 16) = gsh; asm volatile("s_waitcnt lgkmcnt(0)" ::: "memory");              \
          unsigned short gv[8]; _Pragma("unroll") for (int i = 0; i < 8; ++i) gv[i] = *(const LAS unsigned short*)(tpw + (i * 64 + lane) * 2); \
          asm volatile("s_waitcnt lgkmcnt(0)" ::: "memory"); \
          _Pragma("unroll") for (int i = 0; i < 8; ++i) { const float hv = hl[i] + pc[i] * carry; if (i == 7) hl[7] = hv; \
              const float y = hv * __uint_as_float((unsigned)gv[i] << 16); \
              *(LAS unsigned short*)(tpw + (i * 64 + lane) * 2) = (unsigned short)(pg8::cvt_pk_bf16(y, y) & 0xffffu); } \
          asm volatile("s_waitcnt lgkmcnt(0)" ::: "memory"); \
          *(GAS v4u*)((char*)Y + xf_addr(mb + t0 + 8 * wave + (lane >> 3), c0 + 8 * (lane & 7))) = *(const LAS v4u*)(tpw + lane * 16); \
          if (wave == 7) *(LAS float*)(lds + RG_CAR + ((p) ^ 1) * 256 + lane * 4) = hl[7]; } \
        RG_GLOAD(gsh, ((tile) + 2 < NTILE) ? t0 + 2 * RG_T : t0);     \
        if ((tile) + 2 < NTILE) RG_S1(xraw, p); \
        RG_PREFETCH(xraw, ((tile) + 4 < NTILE) ? t0 + 4 * RG_T : t0); \
        LDS_BAR(); } while (0)
#pragma unroll 1
    for (int tile = 0; tile < NTILE; tile += 2) { RG_TILE(tile, 0, xrA, gsA); RG_TILE(tile + 1, 1, xrB, gsB); }
#undef RG_TILE
#undef RG_PREFETCH
#undef RG_GLOAD
#undef RG_S1
#undef RG_S2
}

__device__ __forceinline__ void final_phase(const Args& a, int vcu, int G, int wave, int m0, int mrows) {
    const int lane = lane_id(), r8 = lane >> 3, g8 = lane & 7;
    const int gw = vcu * NWAVES + wave, NGW = G * NWAVES; const float* ss = (const float*)(a.ws + WS_SS); const float* g = a.in[19]; const char* X = (const char*)(a.ws + WS_XN);
    for (int rg = m0 / 16 + gw; rg < (m0 + mrows) / 16; rg += NGW) {
        const int row0 = 16 * rg + r8, row1 = row0 + 8;
        const float rs0 = pg8::row_rstd(ss, row0), rs1 = pg8::row_rstd(ss, row1);
        const int ob0 = r8 * 64 + g8 * 8, ob1 = ((r8 + 8) * 64 + g8 * 8) ^ 32;
        float* o0 = a.out + (size_t)row0 * DMODEL + 4 * g8; float* o1 = a.out + (size_t)row1 * DMODEL + 4 * g8;
#pragma unroll 1
        for (int c0 = 0; c0 < 32; c0 += 4) { unsigned long long w0[4], w1[4]; f32x4 gv[4];
#pragma unroll
            for (int i = 0; i < 4; ++i) { const char* blk = X + xf_block(rg, c0 + i); w0[i] = *(const GAS unsigned long long*)(blk + ob0); w1[i] = *(const GAS unsigned long long*)(blk + ob1); gv[i] = *(const f32x4*)(g + 32 * (c0 + i) + 4 * g8); }
#pragma unroll
            for (int i = 0; i < 4; ++i) {
                *(GAS f32x4*)(o0 + 32 * (c0 + i)) = pg8::bf4((unsigned)w0[i], (unsigned)(w0[i] >> 32)) * rs0 * gv[i];
                *(GAS f32x4*)(o1 + 32 * (c0 + i)) = pg8::bf4((unsigned)w1[i], (unsigned)(w1[i] >> 32)) * rs1 * gv[i]; } } }
}

__global__ void __launch_bounds__(NWAVES * 64, 2) mk_fwd(Args args) {
    extern __shared__ __attribute__((aligned(16))) unsigned char lds_raw[];
    LAS unsigned char* lds = (LAS unsigned char*)lds_raw;
    volatile LAS unsigned* MISC = (volatile LAS unsigned*)(lds + MISC_OFF);
    const int wave = __builtin_amdgcn_readfirstlane((int)threadIdx.x >> 6);
    const int G = gridDim.x; const int bx = blockIdx.x; const int vcu = (G % 8 == 0) ? (bx % 8) * (G / 8) + bx / 8 : bx;
    unsigned char* ws = args.ws;
    gu32* ctl = (gu32*)(ws + WS_CTL);
    for (int u = (int)threadIdx.x; u < (LDS_BYTES - LDSCTL_OFF) / 4; u += NWAVES * 64) ((LAS unsigned*)(lds + LDSCTL_OFF))[u] = 0u;
    __syncthreads();
    const int sid = bx & 7, G2 = G / NSTREAM, c = bx >> 3, vcl = c, vcs = sid * G2 + vcl, M0 = sid * MS;
    XcdBarrier bar = xcd_barrier_post((unsigned*)(ctl + CW_BAR), MISC + 8, (unsigned)G);
    XcdBarrier sbar = xcd_barrier_post((unsigned*)(ctl + CW_BAR + 4096 * (1 + sid)), MISC + 10, (unsigned)G2);
    const int lo = args.ph_lo, hi = args.ph_hi;
#define IN(k) (lo <= (k) && (k) < hi)
#define SEAM(k) do { if (IN(k) && IN((k) + 1)) xcd_barrier(sbar); } while (0)
    unsigned char* sb = ws + WS_SB + (size_t)sid * WS_SSTR;
    bf16* XNl = (bf16*)(ws + WS_XN) + (size_t)M0 * 1024; float* SSl = (float*)(ws + WS_SS) + (size_t)M0 * 16;
    bf16* Hl = (bf16*)(sb + SO_H); bf16* Yl = (bf16*)(sb + SO_Y); bf16* Zl = (bf16*)(sb + SO_Z); bf16* Ql = (bf16*)(sb + SO_Q); bf16* GGl = (bf16*)(sb + SO_GG); bf16* XRl = (bf16*)(sb + SO_XR);
    bf16* Yg = Yl - (size_t)M0 * 1024; const bf16* Zg = Zl - (size_t)M0 * 512; const bf16* Qg = Ql - (size_t)M0 * 512; const bf16* Kg = Qg + QKV_STRIDE; const bf16* Vg = Kg + QKV_STRIDE;
    const bf16* GGg = GGl - (size_t)M0 * 1024; const bf16* XRg = XRl - (size_t)M0 * 1024;
    LAS float* RTAB = (LAS float*)(lds + pg8::RTAB_OFF);
    static_assert(pg8::RTAB_OFF >= MISC_OFF + 128 && pg8::RTAB_OFF + 2048 <= LDS_BYTES, "rtab inside the LDS control area");

    if (IN(0)) { p0_prologue(args, lds, vcu, G, wave); }
    if (IN(0) && IN(1)) xcd_barrier(bar);
    if (IN(1)) {
        pg8::Gemm g{XNl, (const bf16*)(ws + WS_WIN0), MS, 2560, DMODEL, 0, 1}; pg8::StaticOrder S; S.init1(MS, 2560, G2, c);
        pg8::EpiInAB E{Zl, Ql, RTAB, mo::C2, QKV_STRIDE};
        pg8::gemm_phase<pg8::EpiInAB, pg8::StaticOrder, true, true>(lds, g, S, E, wave, SSl);
    }
    SEAM(1);
    if (IN(2)) {
        conv_phase(Zg, args.in[6], args.in[7], args.in[8], Yg, lds, vcs, wave);
        const int bh = vcs >> 1, hf = vcs & 1;
        mo::moba_kbar(bh >> 3, bh & 7, Kg, (LAS char*)lds, wave);
#pragma unroll 1
        for (int i = 0; i < 4; ++i) { const int j = hf ? ((i == 0) ? 2 : (i == 1) ? 5 : (i == 2) ? 3 : 4) : ((i == 0) ? 0 : (i == 1) ? 7 : (i == 2) ? 1 : 6);
            mo::moba_unit(bh >> 3, bh & 7, j, Qg, Kg, Vg, Yg, (LAS char*)lds, wave, i == 0, i < 3); }
    }
    SEAM(2);
    if (IN(3)) {
        pg8::Gemm g{Yl, (const bf16*)(ws + WS_WOUT0), MS, DMODEL, DMODEL}; pg8::StaticOrder S; S.init1(MS, DMODEL, G2, c);
        pg8::EpiResB E{XNl, nullptr, SSl};
        pg8::gemm_phase<pg8::EpiResB, pg8::StaticOrder, true, true>(lds, g, S, E, wave);
    }
    SEAM(3);
    if (IN(4)) {
        pg8::Gemm g{XNl, (const bf16*)(ws + WS_WUP0), MS, FF, DMODEL, 0, 1}; pg8::StaticOrder S; S.init1(MS, FF, G2, c);
        pg8::EpiUp E{Hl, RTAB};
        pg8::gemm_phase<pg8::EpiUp, pg8::StaticOrder, true, true>(lds, g, S, E, wave, SSl);
    }
    SEAM(4);
    if (IN(5)) {
        pg8::Gemm g{Hl, (const bf16*)(ws + WS_WDN0), MS, DMODEL, FF, 0, 1}; pg8::StaticOrder S; S.init1(MS, DMODEL, G2, c);
        pg8::EpiResB E{XNl, nullptr, SSl};
        pg8::gemm_phase<pg8::EpiResB, pg8::StaticOrder, true, true>(lds, g, S, E, wave);
    }
    SEAM(5);
    if (IN(6)) {
        pg8::Gemm g{XNl, (const bf16*)(ws + WS_WIN1), MS, 2048, DMODEL, 0, 1}; pg8::StaticOrder S; S.init1(MS, 2048, G2, c);
        pg8::EpiInC E{GGl, XRl, RTAB};
        pg8::gemm_phase<pg8::EpiInC, pg8::StaticOrder, true, true>(lds, g, S, E, wave, SSl);
    }
    SEAM(6);
    if (IN(7)) { rglru_phase(args, XRg, GGg, Yg, lds, vcs, wave); }
    SEAM(7);
    if (IN(8)) {
        pg8::Gemm g{Yl, (const bf16*)(ws + WS_WOUT1), MS, DMODEL, DMODEL, 0, 1};     pg8::StaticOrder S; S.init1(MS, DMODEL, G2, c);
        pg8::EpiResB E{XNl, nullptr, SSl};
        pg8::gemm_phase<pg8::EpiResB, pg8::StaticOrder, true, true>(lds, g, S, E, wave);
    }
    SEAM(8);
    if (IN(9)) {
        pg8::Gemm g{XNl, (const bf16*)(ws + WS_WUP1), MS, FF, DMODEL, 0, 1}; pg8::StaticOrder S; S.init1(MS, FF, G2, c);
        pg8::EpiUp E{Hl, RTAB};
        pg8::gemm_phase<pg8::EpiUp, pg8::StaticOrder, true, true>(lds, g, S, E, wave, SSl);
    }
    SEAM(9);
    if (IN(10)) {
        pg8::Gemm g{Hl, (const bf16*)(ws + WS_WDN1), MS, DMODEL, FF, 0, 1}; pg8::StaticOrder S; S.init1(MS, DMODEL, G2, c);
        pg8::EpiResB E{XNl, nullptr, SSl};
        pg8::gemm_phase<pg8::EpiResB, pg8::StaticOrder, true, true>(lds, g, S, E, wave);
    }
    SEAM(10);
    if (IN(11)) { final_phase(args, vcl, G2, wave, M0, MS); }
#ifdef MK_PROF
    if (IN(11)) { xcd_barrier(sbar);
        if (bx == 0) { const unsigned long long* pr = (const unsigned long long*)(ws + WS_CTL + 512 * 1024); const float cnt = (float)pr[6];
            const float A = (float)pr[MK_PROF_A] / cnt, B = (float)pr[MK_PROF_B] / cnt; const float c = sqrtf(B * 1e-5f * 128.0f);
            for (int i = (int)threadIdx.x; i < (1 << 18); i += 512) args.out[(size_t)i * 128 + 64] += c;
            if (threadIdx.x == 0) args.out[0] += A * MK_PROF_ASCALE; } }
#endif
#undef IN
#undef SEAM
}

extern "C" void kernel_launch(void* const* d_in, const int* in_sizes, int n_in, void* d_out, int out_size, void* d_ws, size_t ws_size, hipStream_t stream) {
    static int grid = 0;
    if (grid == 0) {
        if (n_in != 20 || in_sizes[0] != M * DMODEL || out_size != M * DMODEL || ws_size < WS_END) { fprintf(stderr, "kernel_launch: unexpected shapes (n_in %d, in0 %d, out %d, ws %zu); nothing launched\n", n_in, n_in > 0 ? in_sizes[0] : -1, out_size, ws_size); grid = -1; return; }
        int dev = 0, cus = 0, per_cu = 0;
        if (hipGetDevice(&dev) != hipSuccess || hipDeviceGetAttribute(&cus, hipDeviceAttributeMultiprocessorCount, dev) != hipSuccess) { grid = -1; return; }
        if (hipFuncSetAttribute((const void*)mk_fwd, hipFuncAttributeMaxDynamicSharedMemorySize, LDS_BYTES) != hipSuccess) { fprintf(stderr, "kernel_launch: hipFuncSetAttribute failed\n"); grid = -1; return; }
        if (hipOccupancyMaxActiveBlocksPerMultiprocessor(&per_cu, (const void*)mk_fwd, NWAVES * 64, LDS_BYTES) != hipSuccess || per_cu < 1) fprintf(stderr, "kernel_launch: note: occupancy query reports %d\n", per_cu);
        (void)hipGetLastError();
        grid = cus;
        if (grid != 256) fprintf(stderr, "kernel_launch: %d CUs (the static schedules assume 256)\n", grid);
    }
    if (grid < 0) return;
    if (hipMemsetAsync((char*)d_ws + WS_CTL, 0, CTL_ZERO_BYTES, stream) != hipSuccess) return;
    Args a{};
    for (int i = 0; i < 20; ++i) a.in[i] = (const float*)d_in[i];
    a.out = (float*)d_out; a.ws = (unsigned char*)d_ws;
#if MK_PER_PHASE
    for (int p = 0; p < NPHASE; ++p) { a.ph_lo = p; a.ph_hi = p + 1; hipLaunchKernelGGL(mk_fwd, dim3(grid), dim3(NWAVES * 64), LDS_BYTES, stream, a); }
#else
    a.ph_lo = 0; a.ph_hi = NPHASE;
    hipLaunchKernelGGL(mk_fwd, dim3(grid), dim3(NWAVES * 64), LDS_BYTES, stream, a);
#endif
}
```

```cpp
#include <hip/hip_runtime.h>
#include <hip/hip_bf16.h>
#include <cstdio>
#include <cstdint>
#include <cmath>
namespace pg8 {
#define PG8_LAS __attribute__((address_space(3)))
typedef unsigned short bf16_t;
typedef short bf16x8 __attribute__((ext_vector_type(8)));
typedef float f32x4 __attribute__((ext_vector_type(4)));
typedef unsigned u32x4 __attribute__((ext_vector_type(4)));
constexpr int BM = 256, BK = 64, HALF = 128, HTB = HALF * BK * 2  , STAGE_BYTES = 8 * HTB, NXCD = 8, WGM = 8;

__host__ __device__ __forceinline__ int lds_byte(int r, int c) { const int st = (r >> 4) * 2 + (c >> 5), rr = r & 15, cc = c & 31, ob = rr * 64 + cc * 2; return st * 1024 + (ob ^ (((ob >> 9) & 1) << 5)); }
__host__ __device__ __forceinline__ void stage_rc(int b, int& R, int& C) { const int st = b / 1024, sb = b % 1024, swz = sb ^ (((sb >> 9) & 1) << 5); R = (st >> 1) * 16 + swz / 64; C = (st & 1) * 32 + (swz % 64) / 2; }
__host__ __device__ __forceinline__ int perm32(int rho) { const int n = rho >> 4, i = rho & 15; return 8 * (i >> 2) + 4 * n + (i & 3); }

struct Unit { int pm, pn; };
struct Gemm { const bf16_t* A; const bf16_t* Bt; int M, N, K; int lda = 0; int afrag = 0; };

struct StaticOrder {
    int nM, nN, nwg, G, c, remap = 1;
    __host__ __device__ void init(int M, int N, int G_, int c_) { nM = M / BM; nN = N / BM; nwg = nM * nN; G = G_; c = c_; }
    __host__ __device__ void init1(int M, int N, int G_, int c_) { init(M, N, G_, c_); remap = 0; }
    __host__ __device__ bool next(int i, Unit& u) const {
        const long L = (long)i * G + c; if (L >= nwg) return false;
        int wgid = (int)L; if (remap) { const int q = nwg / NXCD, r = nwg % NXCD, xcd = wgid % NXCD, off = wgid / NXCD; wgid = (xcd < r ? xcd * (q + 1) : r * (q + 1) + (xcd - r) * q) + off; }
        const int nig = WGM * nN, gid = wgid / nig, fm = gid * WGM, gsz = (nM - fm) < WGM ? (nM - fm) : WGM;
        u.pm = fm + ((wgid % nig) % gsz); u.pn = (wgid % nig) / gsz; return true;
    }
    __device__ __forceinline__ void a_ready(const Unit&) const {}
    __device__ __forceinline__ void done(const Unit&) const {}
};
__device__ __forceinline__ unsigned cvt_pk_bf16(float lo, float hi) { unsigned r; asm volatile("v_cvt_pk_bf16_f32 %0, %1, %2" : "=v"(r) : "v"(lo), "v"(hi)); return r; }
typedef float f32x2 __attribute__((ext_vector_type(2)));
typedef unsigned u32x2 __attribute__((ext_vector_type(2)));
__device__ __forceinline__ float row_rstd(const float* ss, int row) {
    const f32x4* p = (const f32x4*)(ss + (size_t)row * 16);
    const f32x4 a = p[0], b = p[1], c = p[2], d = p[3];
    const float s = (((a[0] + a[1]) + (a[2] + a[3])) + ((b[0] + b[1]) + (b[2] + b[3]))) + (((c[0] + c[1]) + (c[2] + c[3])) + ((d[0] + d[1]) + (d[2] + d[3])));
    return 1.0f / sqrtf(s * (1.0f / 1024.0f) + 1e-6f);
}
constexpr int RTAB_OFF = 131072 + 1024;
__device__ __forceinline__ void rtab_fill(const StaticOrder& S, const float* ss, PG8_LAS float* rtab, int wid) {
    const int lane = (int)__builtin_amdgcn_mbcnt_hi(~0u, __builtin_amdgcn_mbcnt_lo(~0u, 0u)), t = wid * 64 + lane, row = t >> 1, h = t & 1;
    Unit u; int prev = -1;
    for (int i = 0; S.next(i, u); ++i) { if (u.pm == prev) continue; prev = u.pm;
        const f32x4* p = (const f32x4*)(ss + ((size_t)u.pm * BM + row) * 16 + h * 8);
        const f32x4 a = p[0], b = p[1];
        float s = ((a[0] + a[1]) + (a[2] + a[3])) + ((b[0] + b[1]) + (b[2] + b[3]));
        s += __shfl_xor(s, 1);
        const float r = 1.0f / sqrtf(s * (1.0f / 1024.0f) + 1e-6f);
        if (h == 0) rtab[((u.pm >> 3) & 1) * 256 + row] = r; }
    asm volatile("s_waitcnt lgkmcnt(0)\n\ts_barrier" ::: "memory");
}
__device__ __forceinline__ void row_scales(float (&rs)[2][4], const PG8_LAS float* rtab, const Unit& u, int wr, int fr, float mul) {
    const PG8_LAS float* t = rtab + ((u.pm >> 3) & 1) * 256 + wr * 64 + fr;
#pragma unroll
    for (int ai = 0; ai < 2; ++ai)
#pragma unroll
        for (int m = 0; m < 4; ++m) rs[ai][m] = t[ai * HALF + m * 16] * mul;
}
__device__ __forceinline__ float fsigmoid(float x) { return __builtin_amdgcn_rcpf(1.0f + __builtin_amdgcn_exp2f(-1.4426950408889634f * x)); }
__device__ __forceinline__ u32x4 pack8(const f32x4& v0, const f32x4& v1) { u32x4 w; w.x = cvt_pk_bf16(v0[0], v0[1]); w.y = cvt_pk_bf16(v0[2], v0[3]); w.z = cvt_pk_bf16(v1[0], v1[1]); w.w = cvt_pk_bf16(v1[2], v1[3]); return w; }

struct EpiInAB {
    static constexpr bool PERM = true, AFTER_DRAIN = false, ADJ = false;
    bf16_t* Z; bf16_t* QKV; const PG8_LAS float* rtab; float qscale; size_t qkv_stride;
    __device__ __forceinline__ void operator()(const f32x4 (&acc)[2][2][4][2], const Unit& u, int wr, int wc, int fr, int fq) const {
        const int row0 = u.pm * BM + wr * 64 + fr, cw = wc * 32 + 8 * fq;
        float rsv[2][4]; row_scales(rsv, rtab, u, wr, fr, (u.pn == 4 || u.pn == 5) ? qscale : 1.0f);
        if (u.pn < 4) {
#pragma unroll
            for (int ai = 0; ai < 2; ++ai)
#pragma unroll
                for (int m = 0; m < 4; ++m) { const int row = row0 + ai * HALF + m * 16; const float rs = rsv[ai][m];
                    f32x4 z0, z1;
#pragma unroll
                    for (int j = 0; j < 4; ++j) { z0[j] = (acc[ai][0][m][0][j] * rs) * fsigmoid(acc[ai][1][m][0][j] * rs); z1[j] = (acc[ai][0][m][1][j] * rs) * fsigmoid(acc[ai][1][m][1][j] * rs); }
                    *(u32x4*)(Z + (size_t)row * 512 + u.pn * 128 + cw) = pack8(z0, z1); __builtin_amdgcn_sched_barrier(0); }
        } else {
            const int t = (u.pn - 4) >> 1; bf16_t* dst = QKV + (size_t)t * qkv_stride;
            const int cb = ((u.pn - 4) & 1) * 256 + cw;
#pragma unroll
            for (int ai = 0; ai < 2; ++ai)
#pragma unroll
                for (int m = 0; m < 4; ++m) { const int row = row0 + ai * HALF + m * 16; const float rs = rsv[ai][m];
#pragma unroll
                    for (int bj = 0; bj < 2; ++bj) { const f32x4 v0 = acc[ai][bj][m][0] * rs, v1 = acc[ai][bj][m][1] * rs;
                        *(u32x4*)(dst + (size_t)row * 512 + cb + bj * HALF) = pack8(v0, v1); } __builtin_amdgcn_sched_barrier(0); }
        }
    }
};
__device__ __forceinline__ float irelu(float x) { const int i = __float_as_int(x); return __int_as_float(i > 0 ? i : 0); }
struct EpiUp {
    static constexpr bool PERM = true, AFTER_DRAIN = false, ADJ = true;
    bf16_t* H; const PG8_LAS float* rtab;
    static constexpr int FFT = 4096 / 64;
    __device__ __forceinline__ void operator()(const f32x4 (&acc)[2][2][4][2], const Unit& u, int wr, int wc, int fr, int fq) const {
        const int fo = (fr * 64 + fq * 16) ^ ((fr >> 3) << 5);
        float rsv[2][4]; row_scales(rsv, rtab, u, wr, fr, 1.0f);
#pragma unroll
        for (int ai = 0; ai < 2; ++ai)
#pragma unroll
            for (int m = 0; m < 4; ++m) { const float rs2 = rsv[ai][m] * rsv[ai][m];
                const f32x2 r2 = (f32x2){rs2, rs2};
#pragma unroll
                for (int bj = 0; bj < 2; ++bj) { f32x4 v0, v1;
#pragma unroll
                    for (int j = 0; j < 4; j += 2) {
                        const float x0 = acc[ai][bj][m][0][j], x1 = acc[ai][bj][m][0][j + 1], x2 = acc[ai][bj][m][1][j], x3 = acc[ai][bj][m][1][j + 1];
                        f32x2 a = (f32x2){irelu(x0), irelu(x1)}, b = (f32x2){irelu(x2), irelu(x3)};
                        a = (a * a) * r2; b = (b * b) * r2; v0[j] = a[0]; v0[j + 1] = a[1]; v1[j] = b[0]; v1[j + 1] = b[1]; }
                    *(u32x4*)((char*)H + ((((size_t)(u.pm * (FFT) + u.pn * 4 + wc) * 2 + ai) * 16 + (2 * (4 * wr + m) + bj)) << 10) + fo) = pack8(v0, v1); } __builtin_amdgcn_sched_barrier(0); }
    }
};
struct EpiInC {
    static constexpr bool PERM = true, AFTER_DRAIN = false, ADJ = true;
    bf16_t* GG; bf16_t* XR; const PG8_LAS float* rtab;
    __device__ __forceinline__ void operator()(const f32x4 (&acc)[2][2][4][2], const Unit& u, int wr, int wc, int fr, int fq) const {
        const int row0 = u.pm * BM + wr * 64 + fr, col0 = (u.pn & 3) * BM + wc * 64 + 8 * fq; const bool isg = u.pn < 4; bf16_t* dst = isg ? GG : XR;
        float rsv[2][4]; row_scales(rsv, rtab, u, wr, fr, 1.0f);
#pragma unroll
        for (int ai = 0; ai < 2; ++ai)
#pragma unroll
            for (int m = 0; m < 4; ++m) { const int row = row0 + ai * HALF + m * 16; const float rs = rsv[ai][m];
#pragma unroll
                for (int bj = 0; bj < 2; ++bj) { f32x4 v0 = acc[ai][bj][m][0] * rs, v1 = acc[ai][bj][m][1] * rs;
                    if (isg) {
                        const f32x2 c1 = (f32x2){-2.3022081983f, -2.3022081983f}, c2 = (f32x2){-0.10294324f, -0.10294324f}, one = (f32x2){1.0f, 1.0f};
#pragma unroll
                        for (int j = 0; j < 4; j += 2) {
                            f32x2 xa = (f32x2){v0[j], v0[j + 1]}, xb = (f32x2){v1[j], v1[j + 1]};
                            f32x2 ea = xa * (xa * xa * c2 + c1), eb = xb * (xb * xb * c2 + c1);
                            ea = (f32x2){__builtin_amdgcn_exp2f(ea[0]), __builtin_amdgcn_exp2f(ea[1])} + one; eb = (f32x2){__builtin_amdgcn_exp2f(eb[0]), __builtin_amdgcn_exp2f(eb[1])} + one;
                            xa = xa * (f32x2){__builtin_amdgcn_rcpf(ea[0]), __builtin_amdgcn_rcpf(ea[1])}; xb = xb * (f32x2){__builtin_amdgcn_rcpf(eb[0]), __builtin_amdgcn_rcpf(eb[1])};
                            v0[j] = xa[0]; v0[j + 1] = xa[1]; v1[j] = xb[0]; v1[j + 1] = xb[1]; } }
                    *(u32x4*)(dst + (size_t)row * 1024 + col0 + bj * 32) = pack8(v0, v1); } __builtin_amdgcn_sched_barrier(0); }
    }
};
__device__ __forceinline__ f32x4 bf4(unsigned a, unsigned b) { return (f32x4){__uint_as_float(a << 16), __uint_as_float(a & 0xffff0000u), __uint_as_float(b << 16), __uint_as_float(b & 0xffff0000u)}; }
struct EpiResB {
    static constexpr bool PERM = true, AFTER_DRAIN = false, ADJ = true;
    bf16_t* X; float* outf; float* ssout;
    __device__ __forceinline__ void operator()(const f32x4 (&acc)[2][2][4][2], const Unit& u, int wr, int wc, int fr, int fq) const {
        const int row0 = u.pm * BM + wr * 64 + fr;
        const int fo = (fr * 64 + fq * 16) ^ ((fr >> 3) << 5);
        char* xb = (char*)X + (((size_t)(u.pm * 16 + u.pn * 4 + wc) * 2) << 14) + fo;
        u32x4 raw[2][4][2];
#pragma unroll
        for (int ai = 0; ai < 2; ++ai)
#pragma unroll
            for (int m = 0; m < 4; ++m)
#pragma unroll
                for (int bj = 0; bj < 2; ++bj) raw[ai][m][bj] = *(const u32x4*)(xb + ((ai * 16 + 2 * (4 * wr + m) + bj) << 10));
#pragma unroll
        for (int ai = 0; ai < 2; ++ai)
#pragma unroll
            for (int m = 0; m < 4; ++m) { const int row = row0 + ai * HALF + m * 16; float sq = 0.f;
                f32x2 sq2 = (f32x2){0.f, 0.f};
#pragma unroll
                for (int bj = 0; bj < 2; ++bj) { const u32x4 rw = raw[ai][m][bj];
                    const f32x4 x0 = bf4(rw.x, rw.y) + acc[ai][bj][m][0], x1 = bf4(rw.z, rw.w) + acc[ai][bj][m][1];
                    const f32x2 a0 = (f32x2){x0[0], x0[1]}, a1 = (f32x2){x0[2], x0[3]}, a2 = (f32x2){x1[0], x1[1]}, a3 = (f32x2){x1[2], x1[3]};
                    sq2 = a0 * a0 + sq2; sq2 = a1 * a1 + sq2; sq2 = a2 * a2 + sq2; sq2 = a3 * a3 + sq2;
                    *(u32x4*)(xb + ((ai * 16 + 2 * (4 * wr + m) + bj) << 10)) = pack8(x0, x1); }
                sq = sq2[0] + sq2[1];
                { const auto r16 = __builtin_amdgcn_permlane16_swap(__float_as_uint(sq), __float_as_uint(sq), false, false); sq = __uint_as_float(r16[0]) + __uint_as_float(r16[1]);
                  const auto r32 = __builtin_amdgcn_permlane32_swap(__float_as_uint(sq), __float_as_uint(sq), false, false); sq = __uint_as_float(r32[0]) + __uint_as_float(r32[1]); }
                if (fq == 0) ssout[(size_t)row * 16 + u.pn * 4 + wc] = sq;
                __builtin_amdgcn_sched_barrier(0); }
    }
};

template <class Epi, class Sched, bool ALIGN_EPI = false, bool SP2 = false>
__device__ __forceinline__ void gemm_phase(PG8_LAS unsigned char* lds, const Gemm g, const Sched& S, const Epi& E, const int wid, const float* ssfill = nullptr) {
    const int lane = (int)__builtin_amdgcn_mbcnt_hi(~0u, __builtin_amdgcn_mbcnt_lo(~0u, 0u)), tid = wid * 64 + lane, wr = wid >> 2, wc = wid & 3, fr = lane & 15, fq = lane >> 4;
    const int K = g.K, nt = K / BK, lda = g.lda ? g.lda : K;
    unsigned voffA[2], voffB[2];
#pragma unroll
    for (int i = 0; i < 2; ++i) { int R, C; stage_rc(tid * 16 + i * 8192, R, C);
        const int Rb = Epi::ADJ ? ((R >> 5) * 64 + perm32(R & 31)) : Epi::PERM ? ((R & ~31) + perm32(R & 31)) : R;
        voffA[i] = g.afrag ? (unsigned)((wid + 8 * i) * 1024 + lane * 16) : (unsigned)(R * lda + C) * 2u; voffB[i] = (unsigned)(Rb * K + C) * 2u; }
    const size_t kstep = (size_t)(BK * 2);
    const size_t hstep = (size_t)HALF * K * 2;
    const size_t bhstep = Epi::ADJ ? (size_t)32 * K * 2 : hstep;
    const size_t tstep = 2 * hstep;
    const bool afrag = g.afrag != 0;
    const size_t ahstep = afrag ? (size_t)HTB : (size_t)HALF * lda * 2, akstep = afrag ? (size_t)(2 * HTB) : kstep, atstep = afrag ? (size_t)(K / BK) * 2 * HTB : 2 * (size_t)HALF * lda * 2;
    const unsigned ldsw = (unsigned)wid * 1024u;
    const int aoff = lds_byte(wr * 64 + fr, fq * 8), boff = lds_byte(wc * 32 + fr, fq * 8);
#define PG8_SA(b, h) (((b) * 2 + (h)) * HTB)
#define PG8_SB(b, h) ((4 + (b) * 2 + (h)) * HTB)
#define PG8_STAGE(bufoff, gbase, voff) do { _Pragma("unroll") for (int _i = 0; _i < 2; ++_i) \
        __builtin_amdgcn_global_load_lds((const unsigned*)((const char*)(gbase) + (voff)[_i]), (PG8_LAS unsigned*)(lds + (bufoff) + ldsw + _i * 8192), 16, 0, 0); } while (0)
#define PG8_LDA(dst, b, h) do { _Pragma("unroll") for (int m = 0; m < 4; ++m) _Pragma("unroll") for (int k = 0; k < 2; ++k) dst[m][k] = *(const PG8_LAS bf16x8*)(lds + PG8_SA(b, h) + aoff + m * 2048 + k * 1024); } while (0)
#define PG8_LDB(dst, b, h) do { _Pragma("unroll") for (int n = 0; n < 2; ++n) _Pragma("unroll") for (int k = 0; k < 2; ++k) dst[n][k] = *(const PG8_LAS bf16x8*)(lds + PG8_SB(b, h) + boff + n * 2048 + k * 1024); } while (0)
#define PG8_MMA(ai, bj, At, Bt) do { __builtin_amdgcn_s_setprio(1); _Pragma("unroll") for (int m = 0; m < 4; ++m) _Pragma("unroll") for (int n = 0; n < 2; ++n) _Pragma("unroll") for (int k = 0; k < 2; ++k) \
        acc[ai][bj][m][n] = __builtin_amdgcn_mfma_f32_16x16x32_bf16(Bt[n][k], At[m][k], acc[ai][bj][m][n], 0, 0, 0); __builtin_amdgcn_s_setprio(0); } while (0)
#define PG8_WAIT_V(n) asm volatile("s_waitcnt vmcnt(" #n ")" ::: "memory")
#define PG8_WAIT_L(n) asm volatile("s_waitcnt lgkmcnt(" #n ")" ::: "memory")
#define PG8_BAR __builtin_amdgcn_s_barrier()
#define PG8_SCHED __builtin_amdgcn_sched_barrier(0)
    Unit cur, nxt; int ui = 0;
    if (!S.next(0, cur)) return;
    f32x4 acc[2][2][4][2];
#pragma unroll
    for (int a = 0; a < 2; ++a)
#pragma unroll
        for (int b = 0; b < 2; ++b)
#pragma unroll
            for (int m = 0; m < 4; ++m)
#pragma unroll
                for (int n = 0; n < 2; ++n) acc[a][b][m][n] = (f32x4){0.f, 0.f, 0.f, 0.f};
    bf16x8 At[4][2], B0[2][2], B1[2][2];
    const char* cA = (const char*)g.A + (size_t)cur.pm * atstep; const char* cB = (const char*)g.Bt + (size_t)cur.pn * tstep;
    S.a_ready(cur);
    if constexpr (SP2) {
        PG8_STAGE(PG8_SB(0, 0), cB, voffB); PG8_STAGE(PG8_SB(0, 1), cB + bhstep, voffB); PG8_STAGE(PG8_SA(0, 0), cA, voffA); PG8_STAGE(PG8_SA(0, 1), cA + ahstep, voffA);
        if (ssfill) rtab_fill(S, ssfill, (PG8_LAS float*)(lds + RTAB_OFF), wid);
        if (wr == 1) PG8_BAR;
        PG8_WAIT_V(2); PG8_BAR;
        PG8_STAGE(PG8_SB(1, 0), cB + kstep, voffB); PG8_STAGE(PG8_SA(1, 0), cA + akstep, voffA); PG8_STAGE(PG8_SB(1, 1), cB + bhstep + kstep, voffB);
        PG8_WAIT_V(6); PG8_BAR;
    } else {
        PG8_STAGE(PG8_SB(0, 0), cB, voffB); PG8_STAGE(PG8_SA(0, 0), cA, voffA); PG8_STAGE(PG8_SB(0, 1), cB + bhstep, voffB); PG8_STAGE(PG8_SA(0, 1), cA + ahstep, voffA);
        if (wr == 1) PG8_BAR;
        PG8_WAIT_V(4); PG8_BAR;
        PG8_STAGE(PG8_SB(1, 0), cB + kstep, voffB); PG8_STAGE(PG8_SA(1, 0), cA + akstep, voffA); PG8_STAGE(PG8_SB(1, 1), cB + bhstep + kstep, voffB);
        PG8_WAIT_V(6); PG8_BAR;
    }
    for (;;) {
        const bool has_next = S.next(ui + 1, nxt);
        const char* nA = has_next ? (const char*)g.A + (size_t)nxt.pm * atstep : cA; const char* nB = has_next ? (const char*)g.Bt + (size_t)nxt.pn * tstep : cB;
        for (int t = 0; t < nt; t += 2) {
            const bool last = (t == nt - 2);
            const char* a1 = cA + (size_t)(t + 1) * akstep;
            const char* a2 = last ? nA : cA + (size_t)(t + 2) * akstep; const char* b2 = last ? nB : cB + (size_t)(t + 2) * kstep;
            const char* a3 = a2 + akstep; const char* b3 = b2 + kstep;
            if (last && has_next) S.a_ready(nxt);
            if constexpr (SP2) {
            PG8_LDB(B0, 0, 0); PG8_LDB(B1, 0, 1); PG8_SCHED; PG8_LDA(At, 0, 0); PG8_STAGE(PG8_SA(1, 1), a1 + ahstep, voffA);
            PG8_WAIT_V(8); PG8_WAIT_L(0); PG8_BAR; PG8_MMA(0, 0, At, B0); PG8_MMA(0, 1, At, B1); PG8_BAR; PG8_SCHED;
            PG8_LDA(At, 0, 1); PG8_STAGE(PG8_SB(0, 0), b2, voffB); PG8_STAGE(PG8_SB(0, 1), b2 + bhstep, voffB); PG8_STAGE(PG8_SA(0, 0), a2, voffA);
            PG8_WAIT_V(8); PG8_WAIT_L(0); PG8_BAR; PG8_MMA(1, 0, At, B0); PG8_MMA(1, 1, At, B1); PG8_BAR; PG8_SCHED;
            PG8_LDB(B0, 1, 0); PG8_LDB(B1, 1, 1); PG8_SCHED; PG8_LDA(At, 1, 0); PG8_STAGE(PG8_SA(0, 1), a2 + ahstep, voffA);
            PG8_WAIT_V(8); PG8_WAIT_L(0); PG8_BAR; PG8_MMA(0, 0, At, B0); PG8_MMA(0, 1, At, B1); PG8_BAR; PG8_SCHED;
            PG8_LDA(At, 1, 1); PG8_STAGE(PG8_SB(1, 0), b3, voffB); PG8_STAGE(PG8_SB(1, 1), b3 + bhstep, voffB); PG8_STAGE(PG8_SA(1, 0), a3, voffA);
            PG8_WAIT_V(8); PG8_WAIT_L(0); PG8_BAR; PG8_MMA(1, 0, At, B0); PG8_MMA(1, 1, At, B1); PG8_BAR; PG8_SCHED;
            } else {
            PG8_LDB(B0, 0, 0); PG8_SCHED; PG8_LDA(At, 0, 0); PG8_STAGE(PG8_SA(1, 1), a1 + ahstep, voffA);
            PG8_WAIT_L(8); PG8_BAR; PG8_WAIT_L(0); PG8_MMA(0, 0, At, B0); PG8_BAR; PG8_SCHED;
            PG8_LDB(B1, 0, 1); PG8_STAGE(PG8_SB(0, 0), b2, voffB);
            PG8_BAR; PG8_WAIT_L(0); PG8_MMA(0, 1, At, B1); PG8_BAR;
            PG8_LDA(At, 0, 1); PG8_STAGE(PG8_SA(0, 0), a2, voffA);
            PG8_BAR; PG8_WAIT_L(0); PG8_MMA(1, 0, At, B0); PG8_BAR; PG8_SCHED;
            PG8_STAGE(PG8_SB(0, 1), b2 + bhstep, voffB);
            PG8_WAIT_V(6); PG8_BAR; PG8_MMA(1, 1, At, B1); PG8_BAR;
            PG8_LDB(B0, 1, 0); PG8_SCHED; PG8_LDA(At, 1, 0); PG8_STAGE(PG8_SA(0, 1), a2 + ahstep, voffA);
            PG8_WAIT_L(8); PG8_BAR; PG8_WAIT_L(0); PG8_MMA(0, 0, At, B0); PG8_BAR; PG8_SCHED;
            PG8_LDB(B1, 1, 1); PG8_STAGE(PG8_SB(1, 0), b3, voffB);
            PG8_BAR; PG8_WAIT_L(0); PG8_MMA(0, 1, At, B1); PG8_BAR;
            PG8_LDA(At, 1, 1); PG8_STAGE(PG8_SA(1, 0), a3, voffA);
            PG8_BAR; PG8_WAIT_L(0); PG8_MMA(1, 0, At, B0); PG8_BAR; PG8_SCHED;
            PG8_STAGE(PG8_SB(1, 1), b3 + bhstep, voffB);
            PG8_WAIT_V(6); PG8_BAR; PG8_MMA(1, 1, At, B1); PG8_BAR;
            }
        }
        if constexpr (ALIGN_EPI) { if (wr == 0) PG8_BAR; }
        if constexpr (!Epi::AFTER_DRAIN) { E(acc, cur, wr, wc, fr, fq); S.done(cur); }
        if (!has_next) break;
#pragma unroll
        for (int a = 0; a < 2; ++a)
#pragma unroll
            for (int b = 0; b < 2; ++b)
#pragma unroll
                for (int m = 0; m < 4; ++m)
#pragma unroll
                    for (int n = 0; n < 2; ++n) acc[a][b][m][n] = (f32x4){0.f, 0.f, 0.f, 0.f};
        cur = nxt; cA = nA; cB = nB; ++ui;
        if constexpr (ALIGN_EPI) { if (wr == 1) PG8_BAR; }
    }
    PG8_WAIT_V(0);
    if constexpr (!ALIGN_EPI) { if (wr == 0) PG8_BAR; }
    PG8_BAR;
    if constexpr (Epi::AFTER_DRAIN) { E.fused(acc, cur, wr, wc, fr, fq, lds, wid, lane); S.done(cur); }
#undef PG8_SA
#undef PG8_SB
#undef PG8_STAGE
#undef PG8_LDA
#undef PG8_LDB
#undef PG8_MMA
#undef PG8_WAIT_V
#undef PG8_WAIT_L
#undef PG8_BAR
#undef PG8_SCHED
}
}
namespace mo {
using bf16x8=__attribute__((ext_vector_type(8)))short;
using s16x4=__attribute__((ext_vector_type(4)))short;
using f32x16=__attribute__((ext_vector_type(16)))float;
using u32x4=__attribute__((ext_vector_type(4)))unsigned;
typedef unsigned short bf16;
constexpr int NHEAD=8,SEQ=2048,D=64,DM=NHEAD*D,OPITCH=1024,OCOL0=512;
constexpr int NW=8,QBLK=32,QB=QBLK*NW,KVBLK=64;
__device__ __forceinline__ int crow(int r,int hi){return (r&3)+8*(r>>2)+4*hi;}
#define MO_LAS __attribute__((address_space(3)))
constexpr int SLOTB=8192;
constexpr int LDS_K=0, LDS_V=2*SLOTB, LDS_WS=4*SLOTB, LDS_OST=LDS_WS+NW*64*4, LDS_KB=LDS_OST+NW*4096, LDS_BYTES=LDS_KB+2048+64;
constexpr float C2=0.125f*1.4426950408889634f;
__device__ __forceinline__ void glds16(const void*gsrc,unsigned lds_dst){unsigned keep;
  asm volatile("s_mov_b32 %0, m0\n\ts_mov_b32 m0, %2\n\ts_nop 0\n\tglobal_load_lds_dwordx4 %1, off\n\ts_mov_b32 m0, %0":"=&s"(keep):"v"(gsrc),"s"(lds_dst):"memory");}
typedef float f32x2_t __attribute__((ext_vector_type(2))); typedef __bf16 bf16x2_t __attribute__((ext_vector_type(2)));
__device__ __forceinline__ unsigned cvtpk_s(float lo,float hi){f32x2_t v={lo,hi};bf16x2_t b=__builtin_convertvector(v,bf16x2_t);return __builtin_bit_cast(unsigned,b);}
#define MO_WAIT_BAR(N) asm volatile("s_waitcnt vmcnt(" #N ") lgkmcnt(0)\n\ts_barrier":::"memory")
#define MO_MX3(a,b,c) __builtin_fmaxf(__builtin_fmaxf((a),(b)),(c))
__device__ __forceinline__ void qkt(f32x16&p0,f32x16&p1,const MO_LAS char*Kslot,const bf16x8*qr,const f32x16&z,int r32,int hi){
  const MO_LAS char*kb=Kslot+hi*1024+r32*16;
  bf16x8 kf[8];
  #pragma unroll
  for(int i=0;i<8;++i)kf[i]=*(const MO_LAS bf16x8*)(kb+(i>>1)*2048+(i&1)*512);
  __builtin_amdgcn_sched_barrier(0);
  p0=__builtin_amdgcn_mfma_f32_32x32x16_bf16(kf[0],qr[0],z,0,0,0);p1=__builtin_amdgcn_mfma_f32_32x32x16_bf16(kf[1],qr[0],z,0,0,0);
  #pragma unroll
  for(int d0=1;d0<4;++d0){p0=__builtin_amdgcn_mfma_f32_32x32x16_bf16(kf[2*d0],qr[d0],p0,0,0,0);p1=__builtin_amdgcn_mfma_f32_32x32x16_bf16(kf[2*d0+1],qr[d0],p1,0,0,0);}
}
__device__ __forceinline__ float rowmax(const f32x16&p0,const f32x16&p1,float c1){
  float a=MO_MX3(p0[0],p0[1],p0[2]),b=MO_MX3(p1[0],p1[1],p1[2]);
  #pragma unroll
  for(int r=3;r<15;r+=2){a=MO_MX3(a,p0[r],p0[r+1]);b=MO_MX3(b,p1[r],p1[r+1]);}
  a=__builtin_fmaxf(a,p0[15]);b=__builtin_fmaxf(b,p1[15]);
  float m=__builtin_fmaxf(a,b+c1);
  auto rr=__builtin_amdgcn_permlane32_swap(__float_as_uint(m),__float_as_uint(m),false,false);
  return __builtin_fmaxf(__uint_as_float(rr[0]),__uint_as_float(rr[1]));
}
__device__ __forceinline__ void pv(f32x16*o,int vb,bf16x8 pa0,bf16x8 pa1,bf16x8 pa2,bf16x8 pa3){
  #pragma unroll
  for(int d0=0;d0<2;++d0){s16x4 lo[4],hi[4];
    #pragma unroll
    for(int ks=0;ks<4;++ks){
      asm volatile("ds_read_b64_tr_b16 %0,%1 offset:%c2":"=&v"(lo[ks]):"v"(vb),"i"(d0*4096+ks*1024):"memory");
      asm volatile("ds_read_b64_tr_b16 %0,%1 offset:%c2":"=&v"(hi[ks]):"v"(vb),"i"(d0*4096+ks*1024+512):"memory");}
    asm volatile("s_waitcnt lgkmcnt(0)":::"memory");__builtin_amdgcn_sched_barrier(0);
    #define MO_PK(k) (bf16x8){lo[k][0],lo[k][1],lo[k][2],lo[k][3],hi[k][0],hi[k][1],hi[k][2],hi[k][3]}
    o[d0]=__builtin_amdgcn_mfma_f32_32x32x16_bf16(pa0,MO_PK(0),o[d0],0,0,0);
    o[d0]=__builtin_amdgcn_mfma_f32_32x32x16_bf16(pa1,MO_PK(1),o[d0],0,0,0);
    o[d0]=__builtin_amdgcn_mfma_f32_32x32x16_bf16(pa2,MO_PK(2),o[d0],0,0,0);
    o[d0]=__builtin_amdgcn_mfma_f32_32x32x16_bf16(pa3,MO_PK(3),o[d0],0,0,0);
    #undef MO_PK
  }
}
typedef short v4i16_t __attribute__((ext_vector_type(4)));
__device__ __forceinline__ s16x4 vtr(const MO_LAS char*p){ return __builtin_bit_cast(s16x4,__builtin_amdgcn_ds_read_tr16_b64_v4i16((MO_LAS v4i16_t*)p)); }
__device__ __forceinline__ float bf2f(short s){ return __uint_as_float(((unsigned)(unsigned short)s)<<16); }

__device__ __forceinline__ void moba_kbar(int b,int h,const bf16*K,MO_LAS char*shm,const int wid){
  const int lane=(int)__builtin_amdgcn_mbcnt_hi(~0u,__builtin_amdgcn_mbcnt_lo(~0u,0u));
  MO_LAS float*kbl=(MO_LAS float*)(shm+LDS_KB);
  {
    const bf16*kp=K+((long)b*SEQ+wid*256+(lane>>3))*DM+h*D+(lane&7)*8;
    float sm[8]; float n2max=0.f;
    #pragma unroll
    for(int e=0;e<8;++e)sm[e]=0.f;
    #pragma unroll 1
    for(int i0=0;i0<32;i0+=8){ bf16x8 kv[8]; float ps[8];
      #pragma unroll
      for(int i=0;i<8;++i)kv[i]=*reinterpret_cast<const bf16x8*>(kp+(long)(i0+i)*8*DM);
      #pragma unroll
      for(int i=0;i<8;++i){ ps[i]=0.f;
        #pragma unroll
        for(int e=0;e<8;++e){const float x=bf2f(kv[i][e]); sm[e]+=x; ps[i]=__builtin_fmaf(x,x,ps[i]);} }
      #pragma unroll
      for(int o=1;o<8;o<<=1)
        #pragma unroll
        for(int i=0;i<8;++i)ps[i]+=__shfl_xor(ps[i],o);
      #pragma unroll
      for(int i=0;i<8;++i)n2max=__builtin_fmaxf(n2max,ps[i]); }
    #pragma unroll
    for(int e=0;e<8;++e){ sm[e]+=__shfl_xor(sm[e],8); sm[e]+=__shfl_xor(sm[e],16); sm[e]+=__shfl_xor(sm[e],32); }
    n2max=__builtin_fmaxf(n2max,__shfl_xor(n2max,8)); n2max=__builtin_fmaxf(n2max,__shfl_xor(n2max,16)); n2max=__builtin_fmaxf(n2max,__shfl_xor(n2max,32));
    if(lane<8){
      #pragma unroll
      for(int e=0;e<8;++e)kbl[wid*64+lane*8+e]=sm[e]*(1.0f/256.0f); }
    if(lane==0)kbl[512+wid]=n2max;
  }
  asm volatile("s_waitcnt vmcnt(0) lgkmcnt(0)\n\ts_barrier":::"memory");
}
__device__ __forceinline__ void moba_unit(int b,int h,int j,const bf16*Q,const bf16*K,const bf16*V,bf16*Y,MO_LAS char*shm,const int wid,const bool first,const bool has_next){
  const int lane=(int)__builtin_amdgcn_mbcnt_hi(~0u,__builtin_amdgcn_mbcnt_lo(~0u,0u)),tid=wid*64+lane,r32=lane&31,hi=lane>>5;
  const long rowbase=(long)b*SEQ; const int q0=j*QB;
  const bf16*Qw=Q+(rowbase+q0+wid*QBLK)*DM+h*D;
  const bf16*Kh=K+rowbase*DM+h*D,*Vh=V+rowbase*DM+h*D;
  const unsigned lds0=(unsigned)(uintptr_t)shm;
  MO_LAS float*wsf=(MO_LAS float*)(shm+LDS_WS)+wid*64;
  const bf16*ksrc=Kh+(long)lane*DM+wid*8;
  const bf16*vsrc=Vh+(long)(16*(wid&3)+(lane>>2))*DM+(wid>>2)*32+(lane&3)*8;
  const unsigned kdst=lds0+LDS_K+wid*1024, vdst=lds0+LDS_V+wid*1024;
  #define MO_DMA_K(t,slot) glds16(ksrc+(long)(t)*KVBLK*DM,(unsigned)__builtin_amdgcn_readfirstlane(kdst+(slot)))
  #define MO_DMA_V(t,slot) glds16(vsrc+(long)(t)*KVBLK*DM,(unsigned)__builtin_amdgcn_readfirstlane(vdst+(slot)))
  const int vb0=(int)(lds0+LDS_V)+((lane>>4)&1)*32+(lane&3)*8+(4*hi+((lane&15)>>2))*64;
  const MO_LAS char*Kbase=shm+LDS_K;
  const MO_LAS char*vp0=shm+LDS_V+((lane>>4)&1)*32+(lane&3)*8+(4*hi+((lane&15)>>2))*64;
  const int NT=4*(j+1);
  if(first){MO_DMA_K(0,0);MO_DMA_V(0,0);}
  bf16x8 qr[4];
  #pragma unroll
  for(int d0=0;d0<4;++d0)qr[d0]=*reinterpret_cast<const bf16x8*>(&Qw[(long)r32*DM+d0*16+hi*8]);
  unsigned selmask=0xFFu;
  if(j>=4){
    const MO_LAS float*kbl=(const MO_LAS float*)(shm+LDS_KB);
    float g[7];
    #pragma unroll
    for(int n=0;n<7;++n){ g[n]=-INFINITY;
      if(n<j){ float s=0.f;
        #pragma unroll
        for(int d0=0;d0<4;++d0)
          #pragma unroll
          for(int e=0;e<8;++e)s+=bf2f(qr[d0][e])*kbl[n*64+d0*16+hi*8+e];
        s+=__shfl_xor(s,32); g[n]=s; }
      __builtin_amdgcn_sched_barrier(0); }
    selmask=0u;
    #pragma unroll
    for(int s=0;s<3;++s){ float best=-INFINITY; int bi=-1;
      #pragma unroll
      for(int n=0;n<7;++n) if(g[n]>best){best=g[n];bi=n;}
      #pragma unroll
      for(int n=0;n<7;++n) if(n==bi)g[n]=-INFINITY;
      if(bi>=0)selmask|=(1u<<bi); }
#ifdef MO_SELDBG
    if(hi==0)((unsigned*)((char*)Q+((size_t)300<<20)))[(size_t)(b*8+h)*2048+q0+wid*QBLK+r32]=selmask;
#endif
  }
  const float slope2=__builtin_amdgcn_exp2f(-(float)(h+1))*1.4426950408889634f;
  const int qrel=wid*QBLK+r32, tq=q0+qrel;
  float ref;
  { float qn2=0.f;
    #pragma unroll
    for(int d0=0;d0<4;++d0)
      #pragma unroll
      for(int e=0;e<8;++e){const float x=bf2f(qr[d0][e]); qn2=__builtin_fmaf(x,x,qn2);}
    qn2+=__shfl_xor(qn2,32);
    const MO_LAS float*kn2=(const MO_LAS float*)(shm+LDS_KB)+512; float k2=kn2[0];
    #pragma unroll
    for(int n=1;n<8;++n)k2=__builtin_fmaxf(k2,kn2[n]);
    ref=__builtin_sqrtf(qn2*k2)-16.0f; }
  float l_run=0.f;f32x16 o[2];o[0]=f32x16{};o[1]=f32x16{};
  f32x16 cinit;
  #pragma unroll
  for(int r=0;r<16;++r)cinit[r]=slope2*(float)((r&3)+8*(r>>2)+4*hi);
  asm volatile("":"+v"(cinit));
  const float c32=32.0f*slope2;
  asm volatile(""::"v"(qr[0]),"v"(qr[1]),"v"(qr[2]),"v"(qr[3]));
  #pragma unroll 1
  for(int t=0;t<NT;++t){
    const int slot=(t&1)*SLOTB;
    MO_WAIT_BAR(0);
    if(t+1<NT){MO_DMA_K(t+1,slot^SLOTB);MO_DMA_V(t+1,slot^SLOTB);}
    else if(has_next){MO_DMA_K(0,0);MO_DMA_V(0,0);}
    if(2*(t-(NT-4))>wid)continue;
    f32x16 p0,p1;
    qkt(p0,p1,Kbase+slot,qr,cinit,r32,hi);
    s16x4 vlo[8],vhi[8];
    { const MO_LAS char*vp=vp0+slot;
      #pragma unroll
      for(int i=0;i<4;++i){vlo[i]=vtr(vp+((i>>2)*4096+(i&3)*1024));vhi[i]=vtr(vp+((i>>2)*4096+(i&3)*1024+512));} }
    __builtin_amdgcn_sched_barrier(0);
    const float sb=slope2*(float)(64*t-tq);
    const bool band=(t>=NT-4);
    bool dead=false;
    if(band){ asm volatile("; band tile":::"memory");
      const int kb=64*(t-(NT-4))+4*hi;
      #pragma unroll
      for(int r=0;r<16;++r){const int kv=kb+(r&3)+8*(r>>2); if(kv>qrel)p0[r]=-INFINITY; if(kv+32>qrel)p1[r]=-INFINITY;} }
    else dead=((selmask>>(t>>2))&1u)==0u;
    const float kk=dead?INFINITY:(ref-sb);
    const float kk1=kk-c32;
    float sacc=0.f;
    #pragma unroll
    for(int r=0;r<16;++r){p0[r]=__builtin_amdgcn_exp2f(p0[r]-kk);p1[r]=__builtin_amdgcn_exp2f(p1[r]-kk1);sacc+=p0[r]+p1[r];}
    l_run+=sacc;
    u32x4 pw0,pw1,pw2,pw3;
    pw0=(u32x4){cvtpk_s(p0[0],p0[1]),cvtpk_s(p0[2],p0[3]),cvtpk_s(p0[4],p0[5]),cvtpk_s(p0[6],p0[7])};
    pw1=(u32x4){cvtpk_s(p0[8],p0[9]),cvtpk_s(p0[10],p0[11]),cvtpk_s(p0[12],p0[13]),cvtpk_s(p0[14],p0[15])};
    pw2=(u32x4){cvtpk_s(p1[0],p1[1]),cvtpk_s(p1[2],p1[3]),cvtpk_s(p1[4],p1[5]),cvtpk_s(p1[6],p1[7])};
    pw3=(u32x4){cvtpk_s(p1[8],p1[9]),cvtpk_s(p1[10],p1[11]),cvtpk_s(p1[12],p1[13]),cvtpk_s(p1[14],p1[15])};
    __builtin_amdgcn_sched_barrier(0);
    { const MO_LAS char*vp=vp0+slot;
      #pragma unroll
      for(int i=4;i<8;++i){vlo[i]=vtr(vp+((i>>2)*4096+(i&3)*1024));vhi[i]=vtr(vp+((i>>2)*4096+(i&3)*1024+512));} }
    {
      #define MO_VFR(i) (bf16x8){vlo[i][0],vlo[i][1],vlo[i][2],vlo[i][3],vhi[i][0],vhi[i][1],vhi[i][2],vhi[i][3]}
      o[0]=__builtin_amdgcn_mfma_f32_32x32x16_bf16(__builtin_bit_cast(bf16x8,pw0),MO_VFR(0),o[0],0,0,0); o[0]=__builtin_amdgcn_mfma_f32_32x32x16_bf16(__builtin_bit_cast(bf16x8,pw1),MO_VFR(1),o[0],0,0,0);
      o[0]=__builtin_amdgcn_mfma_f32_32x32x16_bf16(__builtin_bit_cast(bf16x8,pw2),MO_VFR(2),o[0],0,0,0); o[0]=__builtin_amdgcn_mfma_f32_32x32x16_bf16(__builtin_bit_cast(bf16x8,pw3),MO_VFR(3),o[0],0,0,0);
      o[1]=__builtin_amdgcn_mfma_f32_32x32x16_bf16(__builtin_bit_cast(bf16x8,pw0),MO_VFR(4),o[1],0,0,0); o[1]=__builtin_amdgcn_mfma_f32_32x32x16_bf16(__builtin_bit_cast(bf16x8,pw1),MO_VFR(5),o[1],0,0,0);
      o[1]=__builtin_amdgcn_mfma_f32_32x32x16_bf16(__builtin_bit_cast(bf16x8,pw2),MO_VFR(6),o[1],0,0,0); o[1]=__builtin_amdgcn_mfma_f32_32x32x16_bf16(__builtin_bit_cast(bf16x8,pw3),MO_VFR(7),o[1],0,0,0);
      #undef MO_VFR
    }
  }
  {auto rr=__builtin_amdgcn_permlane32_swap(__float_as_uint(l_run),__float_as_uint(l_run),false,false);l_run=__uint_as_float(rr[0])+__uint_as_float(rr[1]);}
  if(hi==0)wsf[32+r32]=l_run;asm volatile("s_waitcnt lgkmcnt(0)":::"memory");
  float rli[16];
  #pragma unroll
  for(int r=0;r<16;++r)rli[r]=__builtin_amdgcn_rcpf(wsf[32+crow(r,hi)]);
  bf16*Ow=Y+(rowbase+q0+wid*QBLK)*OPITCH+OCOL0+h*D;
  { MO_LAS bf16*stg=(MO_LAS bf16*)(shm+LDS_OST)+wid*2048;
    #pragma unroll
    for(int r=0;r<16;++r){const int orow=crow(r,hi);
      #pragma unroll
      for(int d0=0;d0<2;++d0){ const float v=o[d0][r]*rli[r]; stg[orow*64+d0*32+r32]=(bf16)(cvtpk_s(v,v)&0xffffu); } }
    asm volatile("s_waitcnt lgkmcnt(0)":::"memory");
    #pragma unroll
    for(int i=0;i<4;++i){const int row=i*8+(lane>>3),ch=lane&7; const u32x4 v=*(const MO_LAS u32x4*)(stg+row*64+ch*8); *(u32x4*)(Ow+(long)row*OPITCH+ch*8)=v;} }
  asm volatile("s_waitcnt lgkmcnt(0)\n\ts_barrier":::"memory");
  #undef MO_DMA_K
  #undef MO_DMA_V
}
}

#define GAS __attribute__((address_space(1)))
#define LAS __attribute__((address_space(3)))
typedef unsigned short bf16;
typedef unsigned v4u __attribute__((ext_vector_type(4)));
typedef float f32x4 __attribute__((ext_vector_type(4)));
typedef short bf16x8 __attribute__((ext_vector_type(8)));
typedef GAS unsigned gu32;
typedef GAS unsigned long long gu64;
#define RLX_AGENT __ATOMIC_RELAXED, __HIP_MEMORY_SCOPE_AGENT
#define LDS_WAIT() asm volatile("s_waitcnt lgkmcnt(0)" ::: "memory")
#define VM_WAIT() asm volatile("s_waitcnt vmcnt(0)" ::: "memory")
__device__ __forceinline__ unsigned long long rt() { return __builtin_amdgcn_s_memrealtime(); }
__device__ __forceinline__ unsigned f2bf(float f) { unsigned u = __builtin_bit_cast(unsigned, f); return (u + 0x7fffu + ((u >> 16) & 1u)) >> 16; }
__device__ __forceinline__ unsigned pk2(float lo, float hi) { return f2bf(lo) | (f2bf(hi) << 16); }
#define XB_TMO      128
#define XB_XCNT(j)  (256  + 64 * (j))
#define XB_XSUB(j)  (1280 + 64 * (j))
#define XB_XGEN(j)  (2304 + 64 * (j))
#define XB_TOP      3328
#define XB_TOPGEN   3392
#define XCD_BAR_WORDS 3456
#define XB_SPIN_CAP (1u << 18)

__device__ __forceinline__ unsigned xb_ld(unsigned* p)              { return __hip_atomic_load(p, __ATOMIC_RELAXED, __HIP_MEMORY_SCOPE_AGENT); }
__device__ __forceinline__ unsigned xb_add(unsigned* p, unsigned v) { return __hip_atomic_fetch_add(p, v, __ATOMIC_RELAXED, __HIP_MEMORY_SCOPE_AGENT); }
__device__ __forceinline__ unsigned xb_xcc_id() { return (unsigned)__builtin_amdgcn_s_getreg((3 << 11) | 20) & 0xFu; }
#define XB_SPIN(cond, bar) do { unsigned _sp = 0; while (cond) { __builtin_amdgcn_s_sleep(1); \
    if ((++_sp & 255u) == 0u) { if (xb_ld(&(bar)[XB_TMO])) break; if (_sp > XB_SPIN_CAP) { atomicAdd(&(bar)[XB_TMO], 1u); break; } } } } while (0)

struct XcdBarrier {
    unsigned total;
    unsigned* bar; unsigned x;
    volatile LAS unsigned* st;
};

__device__ __forceinline__ XcdBarrier xcd_barrier_post(unsigned* bar, volatile LAS unsigned* st, unsigned total) {
    XcdBarrier b; b.total = total; b.bar = bar; b.x = xb_xcc_id(); b.st = st;
    if (threadIdx.x == 0) (void)xb_add(&bar[XB_XCNT(b.x)], 1u);
    return b;
}
__device__ __forceinline__ void xcd_barrier_complete(unsigned* bar, unsigned x, unsigned& nloc, unsigned& nx, const unsigned G) {
    unsigned sum, cnt, mine, sp = 0u;
    for (;;) {
        sum = 0u; cnt = 0u; mine = 0u;
#pragma unroll
        for (unsigned j = 0; j < 16; ++j) { const unsigned c = xb_ld(&bar[XB_XCNT(j)]); sum += c; cnt += (c > 0u) ? 1u : 0u; mine = (j == x) ? c : mine; }
        if (sum == G) break;
        __builtin_amdgcn_s_sleep(1);
        if ((++sp & 255u) == 0u) { if (xb_ld(&bar[XB_TMO])) break; if (sp > XB_SPIN_CAP) { atomicAdd(&bar[XB_TMO], 1u); break; } }
    }
    nloc = mine > 0u ? mine : 1u; nx = cnt > 0u ? cnt : 1u;
}

__device__ __forceinline__ void xcd_barrier(const XcdBarrier& b) {
    asm volatile("s_waitcnt vmcnt(0)" ::: "memory");
    __syncthreads();
    if (threadIdx.x == 0) {
        unsigned* bar = b.bar;
        __builtin_amdgcn_s_waitcnt(0);
        unsigned nloc = b.st[0], nx = b.st[1];
        if (nloc == 0u) { xcd_barrier_complete(bar, b.x, nloc, nx, b.total); b.st[0] = nloc; b.st[1] = nx; }
        const unsigned old = xb_add(&bar[XB_XSUB(b.x)], 1u);
        const unsigned gen = old / nloc;
        if (old + 1u == (gen + 1u) * nloc) {
            if (nx > 1u) {
            __builtin_amdgcn_fence(__ATOMIC_RELEASE, "agent");
            asm volatile("s_waitcnt vmcnt(0)" ::: "memory"); }
            if (nx > 1u) {
            const unsigned og = xb_add(&bar[XB_TOP], 1u);
            const unsigned tg = og / nx;
            if (og + 1u == (tg + 1u) * nx) xb_add(&bar[XB_TOPGEN], 1u);
            else XB_SPIN(xb_ld(&bar[XB_TOPGEN]) == tg, bar); }
            xb_add(&bar[XB_XGEN(b.x)], 1u);
            __builtin_amdgcn_fence(__ATOMIC_ACQUIRE, "agent");
            asm volatile("s_waitcnt vmcnt(0)" ::: "memory");
        } else {
            XB_SPIN(xb_ld(&bar[XB_XGEN(b.x)]) == gen, bar);
            __builtin_amdgcn_fence(__ATOMIC_ACQUIRE, "agent");
            asm volatile("s_waitcnt vmcnt(0)" ::: "memory");
        }
    }
    __syncthreads();
}
__device__ __forceinline__ float wave_sum(float v) {
#pragma unroll
    for (int o = 1; o < 64; o <<= 1) v += __shfl_xor(v, o);
    return v;
}
constexpr int NWAVES = 8;
constexpr int NB = 16, SEQ = 2048, DMODEL = 1024, M = NB * SEQ, FF = 4096;
constexpr float C_EPS = 1e-6f;
constexpr int NPHASE = 12;
#ifndef MK_PROF_ASCALE
#define MK_PROF_ASCALE 0.01f
#endif
#ifndef MK_PROF_MODE
#define MK_PROF_MODE 0
#endif
#ifndef MK_PER_PHASE
#define MK_PER_PHASE 0
#endif
constexpr size_t MiB = 1u << 20;
constexpr size_t WS_CTL = 0, CTL_ZERO_BYTES = 1 * MiB;
constexpr size_t WS_SS = 1 * MiB;
constexpr size_t WS_KBP = 3 * MiB;
constexpr size_t WS_WIN0 = 4 * MiB, WS_WOUT0 = 9 * MiB, WS_WUP0 = 11 * MiB, WS_WDN0 = 19 * MiB, WS_WIN1 = 27 * MiB, WS_WOUT1 = 31 * MiB, WS_WUP1 = 33 * MiB, WS_WDN1 = 41 * MiB;
constexpr size_t WS_WRT = 49 * MiB, WS_WIT = 49 * MiB + 256 * 1024;
constexpr size_t WS_XN = 64 * MiB;
constexpr size_t WS_H = 128 * MiB;
constexpr size_t WS_Z = 128 * MiB, WS_Q = 160 * MiB, WS_K = 192 * MiB, WS_V = 224 * MiB, WS_Y = 256 * MiB;
constexpr size_t WS_GG = 128 * MiB, WS_XR = 192 * MiB;
constexpr size_t WS_END = 512 * MiB;
constexpr int NSTREAM = 8, MS = M / NSTREAM;
constexpr size_t WS_SB = 128 * MiB, WS_SSTR = 48 * MiB, SO_H = 0, SO_Z = 0, SO_Q = 4 * MiB, SO_GG = 0, SO_XR = 8 * MiB, SO_Y = 34 * MiB, QKV_STRIDE = (size_t)MS * 512;
constexpr int HP = FF + 128;
static_assert(SO_Y + (size_t)MS * 1024 * 2 <= WS_SSTR && WS_SB + NSTREAM * WS_SSTR <= WS_END && (size_t)MS * HP * 2 <= SO_Y, "stream buffers");
constexpr int CW_BAR = 4096;
constexpr int RING_BYTES = 131072;
constexpr int LDSCTL_OFF = RING_BYTES, MISC_OFF = LDSCTL_OFF + 320;
constexpr int LDS_BYTES = 147456;

__device__ __forceinline__ int lane_id() { return (int)__builtin_amdgcn_mbcnt_hi(~0u, __builtin_amdgcn_mbcnt_lo(~0u, 0u)); }

__device__ __forceinline__ void p0_transpose_item(const float* W, int N, int K, bf16* WT, int drow0, int k0, int n0, LAS float* scr, int lane, const float* gain = nullptr) {
    f32x4 v[8];
    const int r8 = lane >> 3, c4 = 4 * (lane & 7);
#pragma unroll
    for (int i = 0; i < 8; ++i) v[i] = __builtin_nontemporal_load((const GAS f32x4*)(W + (size_t)(k0 + 8 * i + r8) * N + n0 + c4));
#pragma unroll
    for (int i = 0; i < 8; ++i) { const int kk = 8 * i + r8; const float gk = gain ? gain[k0 + kk] : 1.0f;
        scr[kk * 33 + c4] = v[i].x * gk; scr[kk * 33 + c4 + 1] = v[i].y * gk; scr[kk * 33 + c4 + 2] = v[i].z * gk; scr[kk * 33 + c4 + 3] = v[i].w * gk; }
    LDS_WAIT(); asm volatile("" ::: "memory");
    const int c = lane & 7;
#pragma unroll
    for (int j = 0; j < 4; ++j) { const int n = (lane >> 3) + 8 * j; const LAS float* s = scr + (8 * c) * 33 + n;
        v4u o; o.x = pk2(s[0 * 33], s[1 * 33]); o.y = pk2(s[2 * 33], s[3 * 33]); o.z = pk2(s[4 * 33], s[5 * 33]); o.w = pk2(s[6 * 33], s[7 * 33]);
        *(GAS v4u*)(WT + (size_t)(drow0 + n) * K + k0 + 8 * c) = o; }
    LDS_WAIT(); asm volatile("" ::: "memory");
}
struct Args { const float* in[20]; float* out; unsigned char* ws; int ph_lo, ph_hi; };
__device__ __forceinline__ size_t xf_block(int rg, int cb) {
    return ((((size_t)(rg >> 4) * 16 + (cb >> 1)) * 2 + ((rg >> 3) & 1)) * 16 + (2 * (rg & 7) + (cb & 1))) << 10;
}
__device__ __forceinline__ void rms_prep_group16(const float* x, bf16* X, float* ss, int rg, int lane) {
    const int fr = lane & 15, fq = lane >> 4, fo = (fr * 64 + fq * 16) ^ ((fr >> 3) << 5);
    const float* xr = x + (size_t)(16 * rg + fr) * DMODEL + 8 * fq;
    float s = 0.f;
#pragma unroll 1
    for (int c0 = 0; c0 < 32; c0 += 8) { f32x4 v[8][2];
#pragma unroll
        for (int i = 0; i < 8; ++i) { v[i][0] = __builtin_nontemporal_load((const GAS f32x4*)(xr + 32 * (c0 + i))); v[i][1] = __builtin_nontemporal_load((const GAS f32x4*)(xr + 32 * (c0 + i) + 4)); }
#pragma unroll
        for (int i = 0; i < 8; ++i) { const f32x4 p = v[i][0], q = v[i][1];
            s += ((p.x * p.x + p.y * p.y) + (p.z * p.z + p.w * p.w)) + ((q.x * q.x + q.y * q.y) + (q.z * q.z + q.w * q.w));
            v4u o; o.x = pg8::cvt_pk_bf16(p.x, p.y); o.y = pg8::cvt_pk_bf16(p.z, p.w); o.z = pg8::cvt_pk_bf16(q.x, q.y); o.w = pg8::cvt_pk_bf16(q.z, q.w);
            *(GAS v4u*)((char*)X + xf_block(rg, c0 + i) + fo) = o; } }
    s += __shfl_xor(s, 16); s += __shfl_xor(s, 32);
    *(GAS f32x4*)(ss + (size_t)(16 * rg + fr) * 16 + 4 * fq) = (f32x4){fq == 0 ? s : 0.f, 0.f, 0.f, 0.f};
}
__device__ __forceinline__ void p0_prologue(const Args& a, LAS unsigned char* lds, int vcu, int G, int wave) {
    const int lane = lane_id();
    LAS float* scr = (LAS float*)(lds + wave * 16384);
    const int gw = vcu * NWAVES + wave, NGW = G * NWAVES;
    unsigned char* ws = a.ws;
    constexpr int I_IN0 = 16 * 80, I_OUT = 16 * 32, I_UP = 16 * 128, I_DN = 64 * 32, I_IN1 = 16 * 64, I_G = 8 * 2 * 4;
    constexpr int NITEMS = I_IN0 + 2 * I_OUT + 2 * I_UP + 2 * I_DN + I_IN1 + 2 * I_G;
    for (int it = gw; it < NITEMS; it += NGW) {
        int r = it;
        if (r < I_IN0) { const int kb = r / 80, nb = r % 80, n0 = 32 * nb;
            int drow0 = n0; if (n0 < 1024) { const int half = n0 >> 9, cc = n0 & 511; drow0 = (cc >> 7) * 256 + half * 128 + (cc & 127); }
            p0_transpose_item(a.in[5], 2560, 1024, (bf16*)(ws + WS_WIN0), drow0, 64 * kb, n0, scr, lane, a.in[1]); continue; } r -= I_IN0;
        if (r < I_OUT) { p0_transpose_item(a.in[9], 1024, 1024, (bf16*)(ws + WS_WOUT0), 32 * (r % 32), 64 * (r / 32), 32 * (r % 32), scr, lane); continue; } r -= I_OUT;
        if (r < I_OUT) { p0_transpose_item(a.in[18], 1024, 1024, (bf16*)(ws + WS_WOUT1), 32 * (r % 32), 64 * (r / 32), 32 * (r % 32), scr, lane); continue; } r -= I_OUT;
        if (r < I_UP) { p0_transpose_item(a.in[3], 4096, 1024, (bf16*)(ws + WS_WUP0), 32 * (r % 128), 64 * (r / 128), 32 * (r % 128), scr, lane, a.in[2]); continue; } r -= I_UP;
        if (r < I_UP) { p0_transpose_item(a.in[3] + (size_t)1024 * 4096, 4096, 1024, (bf16*)(ws + WS_WUP1), 32 * (r % 128), 64 * (r / 128), 32 * (r % 128), scr, lane, a.in[2] + DMODEL); continue; } r -= I_UP;
        if (r < I_DN) { p0_transpose_item(a.in[4], 1024, 4096, (bf16*)(ws + WS_WDN0), 32 * (r % 32), 64 * (r / 32), 32 * (r % 32), scr, lane); continue; } r -= I_DN;
        if (r < I_DN) { p0_transpose_item(a.in[4] + (size_t)4096 * 1024, 1024, 4096, (bf16*)(ws + WS_WDN1), 32 * (r % 32), 64 * (r / 32), 32 * (r % 32), scr, lane); continue; } r -= I_DN;
        if (r < I_IN1) { p0_transpose_item(a.in[10], 2048, 1024, (bf16*)(ws + WS_WIN1), 32 * (r % 64), 64 * (r / 64), 32 * (r % 64), scr, lane, a.in[1] + DMODEL); continue; } r -= I_IN1;
        { const bool isi = r >= I_G; if (isi) r -= I_G; const int hh = r >> 3, q = r & 7;
          p0_transpose_item(a.in[isi ? 15 : 13] + (size_t)hh * 16384, 128, 128, (bf16*)(ws + (isi ? WS_WIT : WS_WRT)) + (size_t)hh * 16384, 32 * (q & 3), 64 * (q >> 2), 32 * (q & 3), scr, lane); }
    }
    for (int rg = gw; rg < M / 16; rg += NGW) rms_prep_group16(a.in[0], (bf16*)(ws + WS_XN), (float*)(ws + WS_SS), rg, lane);
}

#define LDS_BAR() asm volatile("s_waitcnt lgkmcnt(0)\n\ts_barrier" ::: "memory")
typedef float f32x2 __attribute__((ext_vector_type(2)));
constexpr int CV_T = 32, CV_ROWS = CV_T + 30, CV_ZT = 0, CV_CO = CV_ROWS * 1024;
static_assert(CV_CO + CV_T * 2048 <= RING_BYTES, "conv LDS");
__device__ __forceinline__ void conv_phase(const bf16* Z, const float* cw, const float* lng, const float* lnb, bf16* Y, LAS unsigned char* lds, int vcu, int wave) {
    const int lane = lane_id(), tid = wave * 64 + lane, cp = tid & 255, tg = tid >> 8;
    f32x2 w2[31];
#pragma unroll
    for (int j = 0; j < 31; ++j) w2[j] = *(const f32x2*)(cw + j * 512 + 2 * cp);
    f32x4 g0 = *(const f32x4*)(lng + 8 * lane), g1 = *(const f32x4*)(lng + 8 * lane + 4), b0 = *(const f32x4*)(lnb + 8 * lane), b1 = *(const f32x4*)(lnb + 8 * lane + 4);
    v4u zv[8];
#define CV_LOAD(ui_) do { const int m0_ = (vcu * 4 + (ui_)) * CV_T, t0_ = m0_ & (SEQ - 1);   \
          \
        _Pragma("unroll") for (int k = 0; k < 8; ++k) { const int rr = wave + 8 * k; const int rc = rr < CV_ROWS ? rr : CV_ROWS - 1; const bool ok = (t0_ - 30 + rc >= 0); \
            zv[k] = *(const GAS v4u*)(Z + (size_t)(ok ? m0_ - 30 + rc : m0_) * 512 + lane * 8); } } while (0)
    CV_LOAD(0);
#pragma unroll
    for (int j = 0; j < 31; ++j) asm volatile("" :: "v"(w2[j]));
    asm volatile("" :: "v"(g0), "v"(g1), "v"(b0), "v"(b1));
    for (int ui = 0; ui < 4; ++ui) {
        const int m0 = (vcu * 4 + ui) * CV_T;
#pragma unroll
        for (int k = 0; k < 8; ++k) { const int rr = wave + 8 * k; const bool ok = ((m0 & (SEQ - 1)) - 30 + rr >= 0); v4u v = zv[k]; v.x = ok ? v.x : 0u; v.y = ok ? v.y : 0u; v.z = ok ? v.z : 0u; v.w = ok ? v.w : 0u;
            if (rr < CV_ROWS) *(LAS v4u*)(lds + CV_ZT + rr * 1024 + lane * 16) = v; }
        LDS_BAR();
        if (ui + 1 < 4) CV_LOAD(ui + 1);
#pragma unroll 1
        for (int run = 0; run < 2; ++run) { const int tok0 = 16 * tg + 8 * run;
            f32x2 acc[8];
#pragma unroll
            for (int o = 0; o < 8; ++o) acc[o] = (f32x2){0.f, 0.f};
#pragma unroll
            for (int i = 0; i < 38; ++i) { const unsigned pk = *(const LAS unsigned*)(lds + CV_ZT + (tok0 + i) * 1024 + cp * 4);
                const f32x2 v = (f32x2){__uint_as_float(pk << 16), __uint_as_float(pk & 0xffff0000u)};
#pragma unroll
                for (int o = 0; o < 8; ++o) { const int jj = i - o; if (jj >= 0 && jj < 31) acc[o] = w2[jj] * v + acc[o]; } }
#pragma unroll
            for (int o = 0; o < 8; ++o) *(LAS f32x2*)(lds + CV_CO + (tok0 + o) * 2048 + cp * 8) = acc[o]; }
        LDS_BAR();
        { f32x4 x0[4], x1[4]; float s1[4], s2[4];
#pragma unroll
          for (int q = 0; q < 4; ++q) { const int tok = wave * 4 + q;
              x0[q] = *(const LAS f32x4*)(lds + CV_CO + tok * 2048 + lane * 32); x1[q] = *(const LAS f32x4*)(lds + CV_CO + tok * 2048 + lane * 32 + 16);
              s1[q] = ((x0[q][0] + x0[q][1]) + (x0[q][2] + x0[q][3])) + ((x1[q][0] + x1[q][1]) + (x1[q][2] + x1[q][3]));
              s2[q] = ((x0[q][0] * x0[q][0] + x0[q][1] * x0[q][1]) + (x0[q][2] * x0[q][2] + x0[q][3] * x0[q][3])) + ((x1[q][0] * x1[q][0] + x1[q][1] * x1[q][1]) + (x1[q][2] * x1[q][2] + x1[q][3] * x1[q][3])); }
#define CV_SW32(a_, b_) ([&]() { const auto r_ = __builtin_amdgcn_permlane32_swap(__float_as_uint(a_), __float_as_uint(b_), false, false); return __uint_as_float(r_[0]) + __uint_as_float(r_[1]); }())
#define CV_SW16(a_, b_) ([&]() { const auto r_ = __builtin_amdgcn_permlane16_swap(__float_as_uint(a_), __float_as_uint(b_), false, false); return __uint_as_float(r_[0]) + __uint_as_float(r_[1]); }())
#define CV_ROR(x_, n_) __int_as_float(__builtin_amdgcn_update_dpp(0, __float_as_int(x_), 0x120 + (n_), 0xf, 0xf, false))
          const float p01 = CV_SW32(s1[0], s1[1]), p23 = CV_SW32(s1[2], s1[3]), q01 = CV_SW32(s2[0], s2[1]), q23 = CV_SW32(s2[2], s2[3]);
          float R = CV_SW16(p01, p23), S = CV_SW16(q01, q23);
          R += CV_ROR(R, 8); S += CV_ROR(S, 8); R += CV_ROR(R, 4); S += CV_ROR(S, 4); R += CV_ROR(R, 2); S += CV_ROR(S, 2); R += CV_ROR(R, 1); S += CV_ROR(S, 1);
#pragma unroll
          for (int q = 0; q < 4; ++q) { const int tok = wave * 4 + q; const int rl = (q == 0) ? 0 : (q == 1) ? 32 : (q == 2) ? 16 : 48;
              const float sum = __int_as_float(__builtin_amdgcn_readlane(__float_as_int(R), rl)), sq = __int_as_float(__builtin_amdgcn_readlane(__float_as_int(S), rl));
              const float mu = sum * (1.0f / 512.0f); float var = __builtin_fmaf(-mu, mu, sq * (1.0f / 512.0f)); var = var > 0.f ? var : 0.f;
              const float rs = __builtin_amdgcn_rsqf(var + C_EPS);
              f32x4 y0 = (x0[q] - mu) * rs * g0 + b0, y1 = (x1[q] - mu) * rs * g1 + b1;
#pragma unroll
              for (int e = 0; e < 4; ++e) { y0[e] = y0[e] * pg8::fsigmoid(y0[e]); y1[e] = y1[e] * pg8::fsigmoid(y1[e]); }
              *(GAS pg8::u32x4*)(Y + (size_t)(m0 + tok) * 1024 + lane * 8) = pg8::pack8(y0, y1); }
#undef CV_SW32
#undef CV_SW16
#undef CV_ROR
        }
    }
#undef CV_LOAD
    LDS_BAR();
}

constexpr int RG_T = 64, RG_STR = 272, RG_FS = 272;
constexpr int RG_WT = 0, RG_XC = 0, RG_AL = 128 * RG_STR, RG_BL = RG_AL + 2 * RG_T * RG_FS, RG_SUM = RG_BL + 2 * RG_T * RG_FS, RG_CAR = RG_SUM + 8 * 512, RG_END = RG_CAR + 2 * 256;
static_assert(2 * RG_T * RG_STR <= 128 * RG_STR && RG_END <= RING_BYTES, "rglru LDS");
__device__ __forceinline__ f32x4 bf4lo(unsigned a, unsigned b) { return (f32x4){__uint_as_float(a << 16), __uint_as_float(a & 0xffff0000u), __uint_as_float(b << 16), __uint_as_float(b & 0xffff0000u)}; }
__device__ __forceinline__ void rglru_phase(const Args& a, const bf16* XR, const bf16* GG, bf16* Y, LAS unsigned char* lds, int vcu, int wave) {
    const int lane = lane_id(), tid = wave * 64 + lane; unsigned char* ws = a.ws;
    const int b = vcu >> 4, hh = (vcu >> 1) & 7, half = vcu & 1, c0 = hh * 128 + half * 64;
    const float* convw = a.in[11]; const float* convb = a.in[12]; const float* br = a.in[14]; const float* bi = a.in[16]; const float* lam = a.in[17];
    { const int row = tid >> 2, part = tid & 3; const bf16* src = (const bf16*)(ws + (row < 64 ? WS_WRT : WS_WIT)) + (size_t)hh * 16384 + (size_t)(half * 64 + (row & 63)) * 128 + part * 32;
#pragma unroll
      for (int i = 0; i < 4; ++i) *(LAS v4u*)(lds + RG_WT + row * RG_STR + part * 64 + i * 16) = *(const GAS v4u*)(src + 8 * i); }
    if (tid < 64) { *(LAS float*)(lds + RG_CAR + tid * 4) = 0.f; *(LAS float*)(lds + RG_CAR + 256 + tid * 4) = 0.f; }
    const int cg = tid & 15, tr = tid >> 4;
    f32x4 cwv[4][2], cbv[2];
#pragma unroll
    for (int j = 0; j < 4; ++j) { cwv[j][0] = *(const f32x4*)(convw + j * 1024 + hh * 128 + 8 * cg); cwv[j][1] = *(const f32x4*)(convw + j * 1024 + hh * 128 + 8 * cg + 4); }
    cbv[0] = *(const f32x4*)(convb + hh * 128 + 8 * cg); cbv[1] = *(const f32x4*)(convb + hh * 128 + 8 * cg + 4);
    const int tt = wave >> 1, cq = wave & 1, n16 = lane & 15, g4 = lane >> 4;
    float sp8[2], brv[2], biv[2];
#pragma unroll
    for (int q = 0; q < 2; ++q) { const int c = c0 + 32 * cq + 16 * q + n16; sp8[q] = 8.0f * 1.4426950408889634f * log1pf(expf(-lam[c]));   brv[q] = br[c]; biv[q] = bi[c]; }
    LDS_BAR();
    bf16x8 wrf[2][4], wif[2][4];
#pragma unroll
    for (int q = 0; q < 2; ++q)
#pragma unroll
        for (int ks = 0; ks < 4; ++ks) { const int nrow = 32 * cq + 16 * q + n16;
            wrf[q][ks] = *(const LAS bf16x8*)(lds + RG_WT + nrow * RG_STR + ks * 64 + g4 * 16); wif[q][ks] = *(const LAS bf16x8*)(lds + RG_WT + (64 + nrow) * RG_STR + ks * 64 + g4 * 16); }
    LDS_BAR();
    const size_t mb = (size_t)b * SEQ;
    constexpr int NTILE = SEQ / RG_T;
    v4u xrA[5], xrB[5]; unsigned short gsA[8], gsB[8];
#define RG_PREFETCH(xraw, t0_) do { _Pragma("unroll") for (int i = 0; i < 5; ++i) { const int t = (t0_) + 2 * tr - 3 + i; const bool ok = t >= 0;   \
        const v4u v = *(const GAS v4u*)(XR + (mb + (ok ? t : 0)) * 1024 + hh * 128 + 8 * cg); xraw[i].x = ok ? v.x : 0u; xraw[i].y = ok ? v.y : 0u; xraw[i].z = ok ? v.z : 0u; xraw[i].w = ok ? v.w : 0u; } } while (0)
#define RG_S1(xraw, p_) do { f32x4 xin[5][2]; _Pragma("unroll") for (int i = 0; i < 5; ++i) { xin[i][0] = bf4lo(xraw[i].x, xraw[i].y); xin[i][1] = bf4lo(xraw[i].z, xraw[i].w); } \
        _Pragma("unroll") for (int o = 0; o < 2; ++o) { f32x4 y0 = cbv[0], y1 = cbv[1]; _Pragma("unroll") for (int j = 0; j < 4; ++j) { y0 += cwv[j][0] * xin[o + j][0]; y1 += cwv[j][1] * xin[o + j][1]; } \
            *(LAS pg8::u32x4*)(lds + RG_XC + (p_) * (RG_T * RG_STR) + (2 * tr + o) * RG_STR + cg * 16) = pg8::pack8(y0, y1); } } while (0)
#define RG_S2(p_) do { const LAS unsigned char* xc = lds + RG_XC + (p_) * (RG_T * RG_STR); LAS unsigned char* alp = lds + RG_AL + (p_) * (RG_T * RG_FS); LAS unsigned char* blp = lds + RG_BL + (p_) * (RG_T * RG_FS); \
        pg8::f32x4 ar[2], ai[2]; _Pragma("unroll") for (int q = 0; q < 2; ++q) { ar[q] = (pg8::f32x4){0.f, 0.f, 0.f, 0.f}; ai[q] = (pg8::f32x4){0.f, 0.f, 0.f, 0.f}; } \
        _Pragma("unroll") for (int ks = 0; ks < 4; ++ks) { const bf16x8 af = *(const LAS bf16x8*)(xc + (tt * 16 + n16) * RG_STR + ks * 64 + g4 * 16); \
            _Pragma("unroll") for (int q = 0; q < 2; ++q) { ar[q] = __builtin_amdgcn_mfma_f32_16x16x32_bf16(af, wrf[q][ks], ar[q], 0, 0, 0); ai[q] = __builtin_amdgcn_mfma_f32_16x16x32_bf16(af, wif[q][ks], ai[q], 0, 0, 0); } } \
        _Pragma("unroll") for (int q = 0; q < 2; ++q) _Pragma("unroll") for (int r = 0; r < 4; ++r) { const int tok = tt * 16 + 4 * g4 + r, ch = 32 * cq + 16 * q + n16; \
            const float rg = pg8::fsigmoid(ar[q][r] + brv[q]), ig = pg8::fsigmoid(ai[q][r] + biv[q]); \
            const float av = __builtin_amdgcn_exp2f(-sp8[q] * rg);            \
            const float m2 = __builtin_fmaf(-av, av, 1.0f);                    \
            const float xv = __uint_as_float(((unsigned)*(const LAS unsigned short*)(xc + tok * RG_STR + (half * 64 + ch) * 2)) << 16); \
            *(LAS float*)(alp + tok * RG_FS + ch * 4) = av; *(LAS float*)(blp + tok * RG_FS + ch * 4) = __builtin_amdgcn_sqrtf(m2) * (ig * xv); } } while (0)
    RG_PREFETCH(xrA, 0); RG_S1(xrA, 0); RG_PREFETCH(xrA, 2 * RG_T); RG_PREFETCH(xrB, RG_T);
    LDS_BAR();
    const bf16* ggp = GG + mb * 1024 + c0 + lane;
    bf16* yp = Y + mb * 1024 + c0 + lane;
#define RG_GLOAD(gsh, t0_) do { _Pragma("unroll") for (int i = 0; i < 8; ++i) gsh[i] = *(const GAS unsigned short*)(ggp + (size_t)((t0_) + 8 * wave + i) * 1024); } while (0)
    RG_S2(0); RG_S1(xrB, 1); RG_PREFETCH(xrB, 3 * RG_T); RG_GLOAD(gsA, 0); RG_GLOAD(gsB, RG_T);
    LDS_BAR();
#define RG_TILE(tile, p, xraw, gsh) do { const int t0 = (tile) * RG_T; \
          \
        float hl[8], pc[8]; \
        { const LAS unsigned char* alp = lds + RG_AL + (p) * (RG_T * RG_FS); const LAS unsigned char* blp = lds + RG_BL + (p) * (RG_T * RG_FS); \
          float av[8], bx[8]; \
          _Pragma("unroll") for (int i = 0; i < 8; ++i) { av[i] = *(const LAS float*)(alp + (8 * wave + i) * RG_FS + lane * 4); bx[i] = *(const LAS float*)(blp + (8 * wave + i) * RG_FS + lane * 4); } \
          if ((tile) + 1 < NTILE) RG_S2((p) ^ 1); \
          float h = 0.f, pr = 1.f; \
          _Pragma("unroll") for (int i = 0; i < 8; ++i) { h = av[i] * h + bx[i]; pr = pr * av[i]; hl[i] = h; pc[i] = pr; } \
          *(LAS f32x2*)(lds + RG_SUM + wave * 512 + lane * 8) = (f32x2){pr, h}; } \
        LDS_BAR(); \
          \
        { float carry = *(const LAS float*)(lds + RG_CAR + (p) * 256 + lane * 4); \
          for (int v = 0; v < wave; ++v) { const f32x2 s = *(const LAS f32x2*)(lds + RG_SUM + v * 512 + lane * 8); carry = s.y + s.x * carry; } \
          _Pragma("unroll") for (int i = 0; i < 8; ++i) { const float hv = hl[i] + pc[i] * carry; if (i == 7) hl[7] = hv; \
              const float y = hv * __uint_as_float((unsigned)gsh[i] << 16); \
              *(GAS unsigned short*)(yp + (size_t)(t0 + 8 * wave + i) * 1024) = (unsigned short)(pg8::cvt_pk_bf16(y, y) & 0xffffu); } \
          if (wave == 7) *(LAS float*)(lds + RG_CAR + ((p) ^ 1) * 256 + lane * 4) = hl[7]; } \
        RG_GLOAD(gsh, ((tile) + 2 < NTILE) ? t0 + 2 * RG_T : t0);     \
        if ((tile) + 2 < NTILE) RG_S1(xraw, p); \
        RG_PREFETCH(xraw, ((tile) + 4 < NTILE) ? t0 + 4 * RG_T : t0); \
        LDS_BAR(); } while (0)
#pragma unroll 1
    for (int tile = 0; tile < NTILE; tile += 2) { RG_TILE(tile, 0, xrA, gsA); RG_TILE(tile + 1, 1, xrB, gsB); }
#undef RG_TILE
#undef RG_PREFETCH
#undef RG_GLOAD
#undef RG_S1
#undef RG_S2
}

__device__ __forceinline__ void final_phase(const Args& a, int vcu, int G, int wave, int m0, int mrows) {
    const int lane = lane_id(), r8 = lane >> 3, g8 = lane & 7;
    const int gw = vcu * NWAVES + wave, NGW = G * NWAVES; const float* ss = (const float*)(a.ws + WS_SS); const float* g = a.in[19]; const char* X = (const char*)(a.ws + WS_XN);
    for (int rg = m0 / 16 + gw; rg < (m0 + mrows) / 16; rg += NGW) {
        const int row0 = 16 * rg + r8, row1 = row0 + 8;
        const float rs0 = pg8::row_rstd(ss, row0), rs1 = pg8::row_rstd(ss, row1);
        const int ob0 = r8 * 64 + g8 * 8, ob1 = ((r8 + 8) * 64 + g8 * 8) ^ 32;
        float* o0 = a.out + (size_t)row0 * DMODEL + 4 * g8; float* o1 = a.out + (size_t)row1 * DMODEL + 4 * g8;
#pragma unroll 1
        for (int c0 = 0; c0 < 32; c0 += 4) { unsigned long long w0[4], w1[4]; f32x4 gv[4];
#pragma unroll
            for (int i = 0; i < 4; ++i) { const char* blk = X + xf_block(rg, c0 + i); w0[i] = *(const GAS unsigned long long*)(blk + ob0); w1[i] = *(const GAS unsigned long long*)(blk + ob1); gv[i] = *(const f32x4*)(g + 32 * (c0 + i) + 4 * g8); }
#pragma unroll
            for (int i = 0; i < 4; ++i) {
                __builtin_nontemporal_store(pg8::bf4((unsigned)w0[i], (unsigned)(w0[i] >> 32)) * rs0 * gv[i], (GAS f32x4*)(o0 + 32 * (c0 + i)));
                __builtin_nontemporal_store(pg8::bf4((unsigned)w1[i], (unsigned)(w1[i] >> 32)) * rs1 * gv[i], (GAS f32x4*)(o1 + 32 * (c0 + i))); } } }
}

__global__ void __launch_bounds__(NWAVES * 64, 2) mk_fwd(Args args) {
    extern __shared__ __attribute__((aligned(16))) unsigned char lds_raw[];
    LAS unsigned char* lds = (LAS unsigned char*)lds_raw;
    volatile LAS unsigned* MISC = (volatile LAS unsigned*)(lds + MISC_OFF);
    const int wave = __builtin_amdgcn_readfirstlane((int)threadIdx.x >> 6);
    const int G = gridDim.x; const int bx = blockIdx.x; const int vcu = (G % 8 == 0) ? (bx % 8) * (G / 8) + bx / 8 : bx;
    unsigned char* ws = args.ws;
    gu32* ctl = (gu32*)(ws + WS_CTL);
    for (int u = (int)threadIdx.x; u < (LDS_BYTES - LDSCTL_OFF) / 4; u += NWAVES * 64) ((LAS unsigned*)(lds + LDSCTL_OFF))[u] = 0u;
    __syncthreads();
    const int sid = bx & 7, G2 = G / NSTREAM, c = bx >> 3, vcl = c, vcs = sid * G2 + vcl, M0 = sid * MS;
    XcdBarrier bar = xcd_barrier_post((unsigned*)(ctl + CW_BAR), MISC + 8, (unsigned)G);
    XcdBarrier sbar = xcd_barrier_post((unsigned*)(ctl + CW_BAR + 4096 * (1 + sid)), MISC + 10, (unsigned)G2);
    const int lo = args.ph_lo, hi = args.ph_hi;
#define IN(k) (lo <= (k) && (k) < hi)
#define SEAM(k) do { if (IN(k) && IN((k) + 1)) xcd_barrier(sbar); } while (0)
    unsigned char* sb = ws + WS_SB + (size_t)sid * WS_SSTR;
    bf16* XNl = (bf16*)(ws + WS_XN) + (size_t)M0 * 1024; float* SSl = (float*)(ws + WS_SS) + (size_t)M0 * 16;
    bf16* Hl = (bf16*)(sb + SO_H); bf16* Yl = (bf16*)(sb + SO_Y); bf16* Zl = (bf16*)(sb + SO_Z); bf16* Ql = (bf16*)(sb + SO_Q); bf16* GGl = (bf16*)(sb + SO_GG); bf16* XRl = (bf16*)(sb + SO_XR);
    bf16* Yg = Yl - (size_t)M0 * 1024; const bf16* Zg = Zl - (size_t)M0 * 512; const bf16* Qg = Ql - (size_t)M0 * 512; const bf16* Kg = Qg + QKV_STRIDE; const bf16* Vg = Kg + QKV_STRIDE;
    const bf16* GGg = GGl - (size_t)M0 * 1024; const bf16* XRg = XRl - (size_t)M0 * 1024;
    LAS float* RTAB = (LAS float*)(lds + pg8::RTAB_OFF);
    static_assert(pg8::RTAB_OFF >= MISC_OFF + 128 && pg8::RTAB_OFF + 2048 <= LDS_BYTES, "rtab inside the LDS control area");

    if (IN(0)) { p0_prologue(args, lds, vcu, G, wave); }
    if (IN(0) && IN(1)) xcd_barrier(bar);
    if (IN(1)) {
        pg8::Gemm g{XNl, (const bf16*)(ws + WS_WIN0), MS, 2560, DMODEL, 0, 1}; pg8::StaticOrder S; S.init1(MS, 2560, G2, c);
        pg8::EpiInAB E{Zl, Ql, RTAB, mo::C2, QKV_STRIDE};
        pg8::gemm_phase<pg8::EpiInAB, pg8::StaticOrder, true, true>(lds, g, S, E, wave, SSl);
    }
    SEAM(1);
    if (IN(2)) {
        conv_phase(Zg, args.in[6], args.in[7], args.in[8], Yg, lds, vcs, wave);
        const int bh = vcs >> 1, hf = vcs & 1;
        mo::moba_kbar(bh >> 3, bh & 7, Kg, (LAS char*)lds, wave);
#pragma unroll 1
        for (int i = 0; i < 4; ++i) { const int j = hf ? ((i == 0) ? 2 : (i == 1) ? 5 : (i == 2) ? 3 : 4) : ((i == 0) ? 0 : (i == 1) ? 7 : (i == 2) ? 1 : 6);
            mo::moba_unit(bh >> 3, bh & 7, j, Qg, Kg, Vg, Yg, (LAS char*)lds, wave, i == 0, i < 3); }
    }
    SEAM(2);
    if (IN(3)) {
        pg8::Gemm g{Yl, (const bf16*)(ws + WS_WOUT0), MS, DMODEL, DMODEL}; pg8::StaticOrder S; S.init1(MS, DMODEL, G2, c);
        pg8::EpiResB E{XNl, nullptr, SSl};
        pg8::gemm_phase<pg8::EpiResB, pg8::StaticOrder, true, true>(lds, g, S, E, wave);
    }
    SEAM(3);
    if (IN(4)) {
        pg8::Gemm g{XNl, (const bf16*)(ws + WS_WUP0), MS, FF, DMODEL, 0, 1}; pg8::StaticOrder S; S.init1(MS, FF, G2, c);
        pg8::EpiUp E{Hl, RTAB};
        pg8::gemm_phase<pg8::EpiUp, pg8::StaticOrder, true, true>(lds, g, S, E, wave, SSl);
    }
    SEAM(4);
    if (IN(5)) {
        pg8::Gemm g{Hl, (const bf16*)(ws + WS_WDN0), MS, DMODEL, FF, 0, 1}; pg8::StaticOrder S; S.init1(MS, DMODEL, G2, c);
        pg8::EpiResB E{XNl, nullptr, SSl};
        pg8::gemm_phase<pg8::EpiResB, pg8::StaticOrder, true, true>(lds, g, S, E, wave);
    }
    SEAM(5);
    if (IN(6)) {
        pg8::Gemm g{XNl, (const bf16*)(ws + WS_WIN1), MS, 2048, DMODEL, 0, 1}; pg8::StaticOrder S; S.init1(MS, 2048, G2, c);
        pg8::EpiInC E{GGl, XRl, RTAB};
        pg8::gemm_phase<pg8::EpiInC, pg8::StaticOrder, true, true>(lds, g, S, E, wave, SSl);
    }
    SEAM(6);
    if (IN(7)) { rglru_phase(args, XRg, GGg, Yg, lds, vcs, wave); }
    SEAM(7);
    if (IN(8)) {
        pg8::Gemm g{Yl, (const bf16*)(ws + WS_WOUT1), MS, DMODEL, DMODEL}; pg8::StaticOrder S; S.init1(MS, DMODEL, G2, c);
        pg8::EpiResB E{XNl, nullptr, SSl};
        pg8::gemm_phase<pg8::EpiResB, pg8::StaticOrder, true, true>(lds, g, S, E, wave);
    }
    SEAM(8);
    if (IN(9)) {
        pg8::Gemm g{XNl, (const bf16*)(ws + WS_WUP1), MS, FF, DMODEL, 0, 1}; pg8::StaticOrder S; S.init1(MS, FF, G2, c);
        pg8::EpiUp E{Hl, RTAB};
        pg8::gemm_phase<pg8::EpiUp, pg8::StaticOrder, true, true>(lds, g, S, E, wave, SSl);
    }
    SEAM(9);
    if (IN(10)) {
        pg8::Gemm g{Hl, (const bf16*)(ws + WS_WDN1), MS, DMODEL, FF, 0, 1}; pg8::StaticOrder S; S.init1(MS, DMODEL, G2, c);
        pg8::EpiResB E{XNl, nullptr, SSl};
        pg8::gemm_phase<pg8::EpiResB, pg8::StaticOrder, true, true>(lds, g, S, E, wave);
    }
    SEAM(10);
    if (IN(11)) { final_phase(args, vcl, G2, wave, M0, MS); }
#ifdef MK_PROF
    if (IN(11)) { xcd_barrier(sbar);
        if (bx == 0) { const unsigned long long* pr = (const unsigned long long*)(ws + WS_CTL + 512 * 1024); const float cnt = (float)pr[6];
            const float A = (float)pr[MK_PROF_A] / cnt, B = (float)pr[MK_PROF_B] / cnt; const float c = sqrtf(B * 1e-5f * 128.0f);
            for (int i = (int)threadIdx.x; i < (1 << 18); i += 512) args.out[(size_t)i * 128 + 64] += c;
            if (threadIdx.x == 0) args.out[0] += A * MK_PROF_ASCALE; } }
#endif
#undef IN
#undef SEAM
}

extern "C" void kernel_launch(void* const* d_in, const int* in_sizes, int n_in, void* d_out, int out_size, void* d_ws, size_t ws_size, hipStream_t stream) {
    static int grid = 0;
    if (grid == 0) {
        if (n_in != 20 || in_sizes[0] != M * DMODEL || out_size != M * DMODEL || ws_size < WS_END) { fprintf(stderr, "kernel_launch: unexpected shapes (n_in %d, in0 %d, out %d, ws %zu); nothing launched\n", n_in, n_in > 0 ? in_sizes[0] : -1, out_size, ws_size); grid = -1; return; }
        int dev = 0, cus = 0, per_cu = 0;
        if (hipGetDevice(&dev) != hipSuccess || hipDeviceGetAttribute(&cus, hipDeviceAttributeMultiprocessorCount, dev) != hipSuccess) { grid = -1; return; }
        if (hipFuncSetAttribute((const void*)mk_fwd, hipFuncAttributeMaxDynamicSharedMemorySize, LDS_BYTES) != hipSuccess) { fprintf(stderr, "kernel_launch: hipFuncSetAttribute failed\n"); grid = -1; return; }
        if (hipOccupancyMaxActiveBlocksPerMultiprocessor(&per_cu, (const void*)mk_fwd, NWAVES * 64, LDS_BYTES) != hipSuccess || per_cu < 1) fprintf(stderr, "kernel_launch: note: occupancy query reports %d\n", per_cu);
        (void)hipGetLastError();
        grid = cus;
        if (grid != 256) fprintf(stderr, "kernel_launch: %d CUs (the static schedules assume 256)\n", grid);
    }
    if (grid < 0) return;
    if (hipMemsetAsync((char*)d_ws + WS_CTL, 0, CTL_ZERO_BYTES, stream) != hipSuccess) return;
    Args a{};
    for (int i = 0; i < 20; ++i) a.in[i] = (const float*)d_in[i];
    a.out = (float*)d_out; a.ws = (unsigned char*)d_ws;
#if MK_PER_PHASE
    for (int p = 0; p < NPHASE; ++p) { a.ph_lo = p; a.ph_hi = p + 1; hipLaunchKernelGGL(mk_fwd, dim3(grid), dim3(NWAVES * 64), LDS_BYTES, stream, a); }
#else
    a.ph_lo = 0; a.ph_hi = NPHASE;
    hipLaunchKernelGGL(mk_fwd, dim3(grid), dim3(NWAVES * 64), LDS_BYTES, stream, a);
#endif
}
```

```cpp
#include <hip/hip_runtime.h>
#include <hip/hip_bf16.h>
#include <cstdio>
#include <cstdint>
#include <cmath>
namespace pg8 {
#define PG8_LAS __attribute__((address_space(3)))
typedef unsigned short bf16_t;
typedef short bf16x8 __attribute__((ext_vector_type(8)));
typedef float f32x4 __attribute__((ext_vector_type(4)));
typedef unsigned u32x4 __attribute__((ext_vector_type(4)));
constexpr int BM = 256, BK = 64, HALF = 128, HTB = HALF * BK * 2  , STAGE_BYTES = 8 * HTB, NXCD = 8, WGM = 8;

__host__ __device__ __forceinline__ int lds_byte(int r, int c) { const int st = (r >> 4) * 2 + (c >> 5), rr = r & 15, cc = c & 31, ob = rr * 64 + cc * 2; return st * 1024 + (ob ^ (((ob >> 9) & 1) << 5)); }
__host__ __device__ __forceinline__ void stage_rc(int b, int& R, int& C) { const int st = b / 1024, sb = b % 1024, swz = sb ^ (((sb >> 9) & 1) << 5); R = (st >> 1) * 16 + swz / 64; C = (st & 1) * 32 + (swz % 64) / 2; }
__host__ __device__ __forceinline__ int perm32(int rho) { const int n = rho >> 4, i = rho & 15; return 8 * (i >> 2) + 4 * n + (i & 3); }

struct Unit { int pm, pn; };
struct Gemm { const bf16_t* A; const bf16_t* Bt; int M, N, K; int lda = 0; int afrag = 0; };

struct StaticOrder {
    int nM, nN, nwg, G, c, remap = 1;
    __host__ __device__ void init(int M, int N, int G_, int c_) { nM = M / BM; nN = N / BM; nwg = nM * nN; G = G_; c = c_; }
    __host__ __device__ void init1(int M, int N, int G_, int c_) { init(M, N, G_, c_); remap = 0; }
    __host__ __device__ bool next(int i, Unit& u) const {
        const long L = (long)i * G + c; if (L >= nwg) return false;
        int wgid = (int)L; if (remap) { const int q = nwg / NXCD, r = nwg % NXCD, xcd = wgid % NXCD, off = wgid / NXCD; wgid = (xcd < r ? xcd * (q + 1) : r * (q + 1) + (xcd - r) * q) + off; }
        const int nig = WGM * nN, gid = wgid / nig, fm = gid * WGM, gsz = (nM - fm) < WGM ? (nM - fm) : WGM;
        u.pm = fm + ((wgid % nig) % gsz); u.pn = (wgid % nig) / gsz; return true;
    }
    __device__ __forceinline__ void a_ready(const Unit&) const {}
    __device__ __forceinline__ void done(const Unit&) const {}
};
__device__ __forceinline__ unsigned cvt_pk_bf16(float lo, float hi) { unsigned r; asm volatile("v_cvt_pk_bf16_f32 %0, %1, %2" : "=v"(r) : "v"(lo), "v"(hi)); return r; }
typedef float f32x2 __attribute__((ext_vector_type(2)));
typedef unsigned u32x2 __attribute__((ext_vector_type(2)));
__device__ __forceinline__ float row_rstd(const float* ss, int row) {
    const f32x4* p = (const f32x4*)(ss + (size_t)row * 16);
    const f32x4 a = p[0], b = p[1], c = p[2], d = p[3];
    const float s = (((a[0] + a[1]) + (a[2] + a[3])) + ((b[0] + b[1]) + (b[2] + b[3]))) + (((c[0] + c[1]) + (c[2] + c[3])) + ((d[0] + d[1]) + (d[2] + d[3])));
    return 1.0f / sqrtf(s * (1.0f / 1024.0f) + 1e-6f);
}
constexpr int RTAB_OFF = 131072 + 1024;
__device__ __forceinline__ void rtab_fill(const StaticOrder& S, const float* ss, PG8_LAS float* rtab, int wid) {
    const int lane = (int)__builtin_amdgcn_mbcnt_hi(~0u, __builtin_amdgcn_mbcnt_lo(~0u, 0u)), t = wid * 64 + lane, row = t >> 1, h = t & 1;
    Unit u; int prev = -1;
    for (int i = 0; S.next(i, u); ++i) { if (u.pm == prev) continue; prev = u.pm;
        const f32x4* p = (const f32x4*)(ss + ((size_t)u.pm * BM + row) * 16 + h * 8);
        const f32x4 a = p[0], b = p[1];
        float s = ((a[0] + a[1]) + (a[2] + a[3])) + ((b[0] + b[1]) + (b[2] + b[3]));
        s += __shfl_xor(s, 1);
        const float r = 1.0f / sqrtf(s * (1.0f / 1024.0f) + 1e-6f);
        if (h == 0) rtab[((u.pm >> 3) & 1) * 256 + row] = r; }
    asm volatile("s_waitcnt lgkmcnt(0)\n\ts_barrier" ::: "memory");
}
__device__ __forceinline__ void row_scales(float (&rs)[2][4], const PG8_LAS float* rtab, const Unit& u, int wr, int fr, float mul) {
    const PG8_LAS float* t = rtab + ((u.pm >> 3) & 1) * 256 + wr * 64 + fr;
#pragma unroll
    for (int ai = 0; ai < 2; ++ai)
#pragma unroll
        for (int m = 0; m < 4; ++m) rs[ai][m] = t[ai * HALF + m * 16] * mul;
}
__device__ __forceinline__ float fsigmoid(float x) { return __builtin_amdgcn_rcpf(1.0f + __builtin_amdgcn_exp2f(-1.4426950408889634f * x)); }
__device__ __forceinline__ u32x4 pack8(const f32x4& v0, const f32x4& v1) { u32x4 w; w.x = cvt_pk_bf16(v0[0], v0[1]); w.y = cvt_pk_bf16(v0[2], v0[3]); w.z = cvt_pk_bf16(v1[0], v1[1]); w.w = cvt_pk_bf16(v1[2], v1[3]); return w; }

struct EpiInAB {
    static constexpr bool PERM = true, AFTER_DRAIN = false, ADJ = false;
    bf16_t* Z; bf16_t* QKV; const PG8_LAS float* rtab; float qscale; size_t qkv_stride;
    __device__ __forceinline__ void operator()(const f32x4 (&acc)[2][2][4][2], const Unit& u, int wr, int wc, int fr, int fq) const {
        const int row0 = u.pm * BM + wr * 64 + fr, cw = wc * 32 + 8 * fq;
        float rsv[2][4]; row_scales(rsv, rtab, u, wr, fr, (u.pn == 4 || u.pn == 5) ? qscale : 1.0f);
        if (u.pn < 4) {
#pragma unroll
            for (int ai = 0; ai < 2; ++ai)
#pragma unroll
                for (int m = 0; m < 4; ++m) { const int row = row0 + ai * HALF + m * 16; const float rs = rsv[ai][m];
                    f32x4 z0, z1;
#pragma unroll
                    for (int j = 0; j < 4; ++j) { z0[j] = (acc[ai][0][m][0][j] * rs) * fsigmoid(acc[ai][1][m][0][j] * rs); z1[j] = (acc[ai][0][m][1][j] * rs) * fsigmoid(acc[ai][1][m][1][j] * rs); }
                    *(u32x4*)(Z + (size_t)row * 512 + u.pn * 128 + cw) = pack8(z0, z1); __builtin_amdgcn_sched_barrier(0); }
        } else {
            const int t = (u.pn - 4) >> 1; bf16_t* dst = QKV + (size_t)t * qkv_stride;
            const int cb = ((u.pn - 4) & 1) * 256 + cw;
#pragma unroll
            for (int ai = 0; ai < 2; ++ai)
#pragma unroll
                for (int m = 0; m < 4; ++m) { const int row = row0 + ai * HALF + m * 16; const float rs = rsv[ai][m];
#pragma unroll
                    for (int bj = 0; bj < 2; ++bj) { const f32x4 v0 = acc[ai][bj][m][0] * rs, v1 = acc[ai][bj][m][1] * rs;
                        *(u32x4*)(dst + (size_t)row * 512 + cb + bj * HALF) = pack8(v0, v1); } __builtin_amdgcn_sched_barrier(0); }
        }
    }
};
__device__ __forceinline__ float irelu(float x) { const int i = __float_as_int(x); return __int_as_float(i > 0 ? i : 0); }
struct EpiUp {
    static constexpr bool PERM = true, AFTER_DRAIN = false, ADJ = true;
    bf16_t* H; const PG8_LAS float* rtab;
    static constexpr int FFT = 4096 / 64;
    __device__ __forceinline__ void operator()(const f32x4 (&acc)[2][2][4][2], const Unit& u, int wr, int wc, int fr, int fq) const {
        const int fo = (fr * 64 + fq * 16) ^ ((fr >> 3) << 5);
        float rsv[2][4]; row_scales(rsv, rtab, u, wr, fr, 1.0f);
#pragma unroll
        for (int ai = 0; ai < 2; ++ai)
#pragma unroll
            for (int m = 0; m < 4; ++m) { const float rs2 = rsv[ai][m] * rsv[ai][m];
                const f32x2 r2 = (f32x2){rs2, rs2};
#pragma unroll
                for (int bj = 0; bj < 2; ++bj) { f32x4 v0, v1;
#pragma unroll
                    for (int j = 0; j < 4; j += 2) {
                        const float x0 = acc[ai][bj][m][0][j], x1 = acc[ai][bj][m][0][j + 1], x2 = acc[ai][bj][m][1][j], x3 = acc[ai][bj][m][1][j + 1];
                        f32x2 a = (f32x2){irelu(x0), irelu(x1)}, b = (f32x2){irelu(x2), irelu(x3)};
                        a = (a * a) * r2; b = (b * b) * r2; v0[j] = a[0]; v0[j + 1] = a[1]; v1[j] = b[0]; v1[j + 1] = b[1]; }
                    __builtin_nontemporal_store(pack8(v0, v1), (u32x4*)((char*)H + ((((size_t)(u.pm * (FFT) + u.pn * 4 + wc) * 2 + ai) * 16 + (2 * (4 * wr + m) + bj)) << 10) + fo));     } __builtin_amdgcn_sched_barrier(0); }
    }
};
struct EpiInC {
    static constexpr bool PERM = true, AFTER_DRAIN = false, ADJ = true;
    bf16_t* GG; bf16_t* XR; const PG8_LAS float* rtab;
    __device__ __forceinline__ void operator()(const f32x4 (&acc)[2][2][4][2], const Unit& u, int wr, int wc, int fr, int fq) const {
        const int row0 = u.pm * BM + wr * 64 + fr, col0 = (u.pn & 3) * BM + wc * 64 + 8 * fq; const bool isg = u.pn < 4; bf16_t* dst = isg ? GG : XR;
        float rsv[2][4]; row_scales(rsv, rtab, u, wr, fr, 1.0f);
#pragma unroll
        for (int ai = 0; ai < 2; ++ai)
#pragma unroll
            for (int m = 0; m < 4; ++m) { const int row = row0 + ai * HALF + m * 16; const float rs = rsv[ai][m];
#pragma unroll
                for (int bj = 0; bj < 2; ++bj) { f32x4 v0 = acc[ai][bj][m][0] * rs, v1 = acc[ai][bj][m][1] * rs;
                    if (isg) {
                        const f32x2 c1 = (f32x2){-2.3022081983f, -2.3022081983f}, c2 = (f32x2){-0.10294324f, -0.10294324f}, one = (f32x2){1.0f, 1.0f};
#pragma unroll
                        for (int j = 0; j < 4; j += 2) {
                            f32x2 xa = (f32x2){v0[j], v0[j + 1]}, xb = (f32x2){v1[j], v1[j + 1]};
                            f32x2 ea = xa * (xa * xa * c2 + c1), eb = xb * (xb * xb * c2 + c1);
                            ea = (f32x2){__builtin_amdgcn_exp2f(ea[0]), __builtin_amdgcn_exp2f(ea[1])} + one; eb = (f32x2){__builtin_amdgcn_exp2f(eb[0]), __builtin_amdgcn_exp2f(eb[1])} + one;
                            xa = xa * (f32x2){__builtin_amdgcn_rcpf(ea[0]), __builtin_amdgcn_rcpf(ea[1])}; xb = xb * (f32x2){__builtin_amdgcn_rcpf(eb[0]), __builtin_amdgcn_rcpf(eb[1])};
                            v0[j] = xa[0]; v0[j + 1] = xa[1]; v1[j] = xb[0]; v1[j + 1] = xb[1]; } }
                    *(u32x4*)(dst + (size_t)row * 1024 + col0 + bj * 32) = pack8(v0, v1); } __builtin_amdgcn_sched_barrier(0); }
    }
};
__device__ __forceinline__ f32x4 bf4(unsigned a, unsigned b) { return (f32x4){__uint_as_float(a << 16), __uint_as_float(a & 0xffff0000u), __uint_as_float(b << 16), __uint_as_float(b & 0xffff0000u)}; }
struct EpiResB {
    static constexpr bool PERM = true, AFTER_DRAIN = false, ADJ = true;
    bf16_t* X; float* outf; float* ssout;
    __device__ __forceinline__ void operator()(const f32x4 (&acc)[2][2][4][2], const Unit& u, int wr, int wc, int fr, int fq) const {
        const int row0 = u.pm * BM + wr * 64 + fr;
        const int fo = (fr * 64 + fq * 16) ^ ((fr >> 3) << 5);
        char* xb = (char*)X + (((size_t)(u.pm * 16 + u.pn * 4 + wc) * 2) << 14) + fo;
        u32x4 raw[2][4][2];
#pragma unroll
        for (int ai = 0; ai < 2; ++ai)
#pragma unroll
            for (int m = 0; m < 4; ++m)
#pragma unroll
                for (int bj = 0; bj < 2; ++bj) raw[ai][m][bj] = *(const u32x4*)(xb + ((ai * 16 + 2 * (4 * wr + m) + bj) << 10));
#pragma unroll
        for (int ai = 0; ai < 2; ++ai)
#pragma unroll
            for (int m = 0; m < 4; ++m) { const int row = row0 + ai * HALF + m * 16; float sq = 0.f;
                f32x2 sq2 = (f32x2){0.f, 0.f};
#pragma unroll
                for (int bj = 0; bj < 2; ++bj) { const u32x4 rw = raw[ai][m][bj];
                    const f32x4 x0 = bf4(rw.x, rw.y) + acc[ai][bj][m][0], x1 = bf4(rw.z, rw.w) + acc[ai][bj][m][1];
                    const f32x2 a0 = (f32x2){x0[0], x0[1]}, a1 = (f32x2){x0[2], x0[3]}, a2 = (f32x2){x1[0], x1[1]}, a3 = (f32x2){x1[2], x1[3]};
                    sq2 = a0 * a0 + sq2; sq2 = a1 * a1 + sq2; sq2 = a2 * a2 + sq2; sq2 = a3 * a3 + sq2;
                    *(u32x4*)(xb + ((ai * 16 + 2 * (4 * wr + m) + bj) << 10)) = pack8(x0, x1); }
                sq = sq2[0] + sq2[1];
                { const auto r16 = __builtin_amdgcn_permlane16_swap(__float_as_uint(sq), __float_as_uint(sq), false, false); sq = __uint_as_float(r16[0]) + __uint_as_float(r16[1]);
                  const auto r32 = __builtin_amdgcn_permlane32_swap(__float_as_uint(sq), __float_as_uint(sq), false, false); sq = __uint_as_float(r32[0]) + __uint_as_float(r32[1]); }
                if (fq == 0) ssout[(size_t)row * 16 + u.pn * 4 + wc] = sq;
                __builtin_amdgcn_sched_barrier(0); }
    }
};

template <class Epi, class Sched, bool ALIGN_EPI = false, bool SP2 = false, bool ANT = false>
__device__ __forceinline__ void gemm_phase(PG8_LAS unsigned char* lds, const Gemm g, const Sched& S, const Epi& E, const int wid, const float* ssfill = nullptr) {
    const int lane = (int)__builtin_amdgcn_mbcnt_hi(~0u, __builtin_amdgcn_mbcnt_lo(~0u, 0u)), tid = wid * 64 + lane, wr = wid >> 2, wc = wid & 3, fr = lane & 15, fq = lane >> 4;
    const int K = g.K, nt = K / BK, lda = g.lda ? g.lda : K;
    unsigned voffA[2], voffB[2];
#pragma unroll
    for (int i = 0; i < 2; ++i) { int R, C; stage_rc(tid * 16 + i * 8192, R, C);
        const int Rb = Epi::ADJ ? ((R >> 5) * 64 + perm32(R & 31)) : Epi::PERM ? ((R & ~31) + perm32(R & 31)) : R;
        voffA[i] = g.afrag ? (unsigned)((wid + 8 * i) * 1024 + lane * 16) : (unsigned)(R * lda + C) * 2u; voffB[i] = (unsigned)(Rb * K + C) * 2u; }
    const size_t kstep = (size_t)(BK * 2);
    const size_t hstep = (size_t)HALF * K * 2;
    const size_t bhstep = Epi::ADJ ? (size_t)32 * K * 2 : hstep;
    const size_t tstep = 2 * hstep;
    const bool afrag = g.afrag != 0;
    const size_t ahstep = afrag ? (size_t)HTB : (size_t)HALF * lda * 2, akstep = afrag ? (size_t)(2 * HTB) : kstep, atstep = afrag ? (size_t)(K / BK) * 2 * HTB : 2 * (size_t)HALF * lda * 2;
    const unsigned ldsw = (unsigned)wid * 1024u;
    const int aoff = lds_byte(wr * 64 + fr, fq * 8), boff = lds_byte(wc * 32 + fr, fq * 8);
#define PG8_SA(b, h) (((b) * 2 + (h)) * HTB)
#define PG8_SB(b, h) ((4 + (b) * 2 + (h)) * HTB)
#define PG8_STAGE(bufoff, gbase, voff) do { _Pragma("unroll") for (int _i = 0; _i < 2; ++_i) \
        __builtin_amdgcn_global_load_lds((const unsigned*)((const char*)(gbase) + (voff)[_i]), (PG8_LAS unsigned*)(lds + (bufoff) + ldsw + _i * 8192), 16, 0, 0); } while (0)
#define PG8_STAGEA(bufoff, gbase, voff) do { _Pragma("unroll") for (int _i = 0; _i < 2; ++_i) \
        __builtin_amdgcn_global_load_lds((const unsigned*)((const char*)(gbase) + (voff)[_i]), (PG8_LAS unsigned*)(lds + (bufoff) + ldsw + _i * 8192), 16, 0, ANT ? 2 : 0); } while (0)
#define PG8_LDA(dst, b, h) do { _Pragma("unroll") for (int m = 0; m < 4; ++m) _Pragma("unroll") for (int k = 0; k < 2; ++k) dst[m][k] = *(const PG8_LAS bf16x8*)(lds + PG8_SA(b, h) + aoff + m * 2048 + k * 1024); } while (0)
#define PG8_LDB(dst, b, h) do { _Pragma("unroll") for (int n = 0; n < 2; ++n) _Pragma("unroll") for (int k = 0; k < 2; ++k) dst[n][k] = *(const PG8_LAS bf16x8*)(lds + PG8_SB(b, h) + boff + n * 2048 + k * 1024); } while (0)
#define PG8_MMA(ai, bj, At, Bt) do { __builtin_amdgcn_s_setprio(1); _Pragma("unroll") for (int m = 0; m < 4; ++m) _Pragma("unroll") for (int n = 0; n < 2; ++n) _Pragma("unroll") for (int k = 0; k < 2; ++k) \
        acc[ai][bj][m][n] = __builtin_amdgcn_mfma_f32_16x16x32_bf16(Bt[n][k], At[m][k], acc[ai][bj][m][n], 0, 0, 0); __builtin_amdgcn_s_setprio(0); } while (0)
#define PG8_WAIT_V(n) asm volatile("s_waitcnt vmcnt(" #n ")" ::: "memory")
#define PG8_WAIT_L(n) asm volatile("s_waitcnt lgkmcnt(" #n ")" ::: "memory")
#define PG8_BAR __builtin_amdgcn_s_barrier()
#define PG8_SCHED __builtin_amdgcn_sched_barrier(0)
    Unit cur, nxt; int ui = 0;
    if (!S.next(0, cur)) return;
    f32x4 acc[2][2][4][2];
#pragma unroll
    for (int a = 0; a < 2; ++a)
#pragma unroll
        for (int b = 0; b < 2; ++b)
#pragma unroll
            for (int m = 0; m < 4; ++m)
#pragma unroll
                for (int n = 0; n < 2; ++n) acc[a][b][m][n] = (f32x4){0.f, 0.f, 0.f, 0.f};
    bf16x8 At[4][2], B0[2][2], B1[2][2];
    const char* cA = (const char*)g.A + (size_t)cur.pm * atstep; const char* cB = (const char*)g.Bt + (size_t)cur.pn * tstep;
    S.a_ready(cur);
    if constexpr (SP2) {
        PG8_STAGE(PG8_SB(0, 0), cB, voffB); PG8_STAGE(PG8_SB(0, 1), cB + bhstep, voffB); PG8_STAGEA(PG8_SA(0, 0), cA, voffA); PG8_STAGEA(PG8_SA(0, 1), cA + ahstep, voffA);
        if (ssfill) rtab_fill(S, ssfill, (PG8_LAS float*)(lds + RTAB_OFF), wid);
        if (wr == 1) PG8_BAR;
        PG8_WAIT_V(2); PG8_BAR;
        PG8_STAGE(PG8_SB(1, 0), cB + kstep, voffB); PG8_STAGEA(PG8_SA(1, 0), cA + akstep, voffA); PG8_STAGE(PG8_SB(1, 1), cB + bhstep + kstep, voffB);
        PG8_WAIT_V(6); PG8_BAR;
    } else {
        PG8_STAGE(PG8_SB(0, 0), cB, voffB); PG8_STAGEA(PG8_SA(0, 0), cA, voffA); PG8_STAGE(PG8_SB(0, 1), cB + bhstep, voffB); PG8_STAGEA(PG8_SA(0, 1), cA + ahstep, voffA);
        if (wr == 1) PG8_BAR;
        PG8_WAIT_V(4); PG8_BAR;
        PG8_STAGE(PG8_SB(1, 0), cB + kstep, voffB); PG8_STAGEA(PG8_SA(1, 0), cA + akstep, voffA); PG8_STAGE(PG8_SB(1, 1), cB + bhstep + kstep, voffB);
        PG8_WAIT_V(6); PG8_BAR;
    }
    for (;;) {
        const bool has_next = S.next(ui + 1, nxt);
        const char* nA = has_next ? (const char*)g.A + (size_t)nxt.pm * atstep : cA; const char* nB = has_next ? (const char*)g.Bt + (size_t)nxt.pn * tstep : cB;
        for (int t = 0; t < nt; t += 2) {
            const bool last = (t == nt - 2);
            const char* a1 = cA + (size_t)(t + 1) * akstep;
            const char* a2 = last ? nA : cA + (size_t)(t + 2) * akstep; const char* b2 = last ? nB : cB + (size_t)(t + 2) * kstep;
            const char* a3 = a2 + akstep; const char* b3 = b2 + kstep;
            if (last && has_next) S.a_ready(nxt);
            if constexpr (SP2) {
            PG8_LDB(B0, 0, 0); PG8_LDB(B1, 0, 1); PG8_SCHED; PG8_LDA(At, 0, 0); PG8_STAGEA(PG8_SA(1, 1), a1 + ahstep, voffA);
            PG8_WAIT_V(8); PG8_WAIT_L(0); PG8_BAR; PG8_MMA(0, 0, At, B0); PG8_MMA(0, 1, At, B1); PG8_BAR; PG8_SCHED;
            PG8_LDA(At, 0, 1); PG8_STAGE(PG8_SB(0, 0), b2, voffB); PG8_STAGE(PG8_SB(0, 1), b2 + bhstep, voffB); PG8_STAGEA(PG8_SA(0, 0), a2, voffA);
            PG8_WAIT_V(8); PG8_WAIT_L(0); PG8_BAR; PG8_MMA(1, 0, At, B0); PG8_MMA(1, 1, At, B1); PG8_BAR; PG8_SCHED;
            PG8_LDB(B0, 1, 0); PG8_LDB(B1, 1, 1); PG8_SCHED; PG8_LDA(At, 1, 0); PG8_STAGEA(PG8_SA(0, 1), a2 + ahstep, voffA);
            PG8_WAIT_V(8); PG8_WAIT_L(0); PG8_BAR; PG8_MMA(0, 0, At, B0); PG8_MMA(0, 1, At, B1); PG8_BAR; PG8_SCHED;
            PG8_LDA(At, 1, 1); PG8_STAGE(PG8_SB(1, 0), b3, voffB); PG8_STAGE(PG8_SB(1, 1), b3 + bhstep, voffB); PG8_STAGEA(PG8_SA(1, 0), a3, voffA);
            PG8_WAIT_V(8); PG8_WAIT_L(0); PG8_BAR; PG8_MMA(1, 0, At, B0); PG8_MMA(1, 1, At, B1); PG8_BAR; PG8_SCHED;
            } else {
            PG8_LDB(B0, 0, 0); PG8_SCHED; PG8_LDA(At, 0, 0); PG8_STAGEA(PG8_SA(1, 1), a1 + ahstep, voffA);
            PG8_WAIT_L(8); PG8_BAR; PG8_WAIT_L(0); PG8_MMA(0, 0, At, B0); PG8_BAR; PG8_SCHED;
            PG8_LDB(B1, 0, 1); PG8_STAGE(PG8_SB(0, 0), b2, voffB);
            PG8_BAR; PG8_WAIT_L(0); PG8_MMA(0, 1, At, B1); PG8_BAR;
            PG8_LDA(At, 0, 1); PG8_STAGEA(PG8_SA(0, 0), a2, voffA);
            PG8_BAR; PG8_WAIT_L(0); PG8_MMA(1, 0, At, B0); PG8_BAR; PG8_SCHED;
            PG8_STAGE(PG8_SB(0, 1), b2 + bhstep, voffB);
            PG8_WAIT_V(6); PG8_BAR; PG8_MMA(1, 1, At, B1); PG8_BAR;
            PG8_LDB(B0, 1, 0); PG8_SCHED; PG8_LDA(At, 1, 0); PG8_STAGEA(PG8_SA(0, 1), a2 + ahstep, voffA);
            PG8_WAIT_L(8); PG8_BAR; PG8_WAIT_L(0); PG8_MMA(0, 0, At, B0); PG8_BAR; PG8_SCHED;
            PG8_LDB(B1, 1, 1); PG8_STAGE(PG8_SB(1, 0), b3, voffB);
            PG8_BAR; PG8_WAIT_L(0); PG8_MMA(0, 1, At, B1); PG8_BAR;
            PG8_LDA(At, 1, 1); PG8_STAGEA(PG8_SA(1, 0), a3, voffA);
            PG8_BAR; PG8_WAIT_L(0); PG8_MMA(1, 0, At, B0); PG8_BAR; PG8_SCHED;
            PG8_STAGE(PG8_SB(1, 1), b3 + bhstep, voffB);
            PG8_WAIT_V(6); PG8_BAR; PG8_MMA(1, 1, At, B1); PG8_BAR;
            }
        }
        if constexpr (ALIGN_EPI) { if (wr == 0) PG8_BAR; }
        if constexpr (!Epi::AFTER_DRAIN) { E(acc, cur, wr, wc, fr, fq); S.done(cur); }
        if (!has_next) break;
#pragma unroll
        for (int a = 0; a < 2; ++a)
#pragma unroll
            for (int b = 0; b < 2; ++b)
#pragma unroll
                for (int m = 0; m < 4; ++m)
#pragma unroll
                    for (int n = 0; n < 2; ++n) acc[a][b][m][n] = (f32x4){0.f, 0.f, 0.f, 0.f};
        cur = nxt; cA = nA; cB = nB; ++ui;
        if constexpr (ALIGN_EPI) { if (wr == 1) PG8_BAR; }
    }
    PG8_WAIT_V(0);
    if constexpr (!ALIGN_EPI) { if (wr == 0) PG8_BAR; }
    PG8_BAR;
    if constexpr (Epi::AFTER_DRAIN) { E.fused(acc, cur, wr, wc, fr, fq, lds, wid, lane); S.done(cur); }
#undef PG8_SA
#undef PG8_SB
#undef PG8_STAGE
#undef PG8_STAGEA
#undef PG8_LDA
#undef PG8_LDB
#undef PG8_MMA
#undef PG8_WAIT_V
#undef PG8_WAIT_L
#undef PG8_BAR
#undef PG8_SCHED
}
}
namespace mo {
using bf16x8=__attribute__((ext_vector_type(8)))short;
using s16x4=__attribute__((ext_vector_type(4)))short;
using f32x16=__attribute__((ext_vector_type(16)))float;
using u32x4=__attribute__((ext_vector_type(4)))unsigned;
typedef unsigned short bf16;
constexpr int NHEAD=8,SEQ=2048,D=64,DM=NHEAD*D,OPITCH=1024,OCOL0=512;
constexpr int NW=8,QBLK=32,QB=QBLK*NW,KVBLK=64;
__device__ __forceinline__ int crow(int r,int hi){return (r&3)+8*(r>>2)+4*hi;}
#define MO_LAS __attribute__((address_space(3)))
constexpr int SLOTB=8192;
constexpr int LDS_K=0, LDS_V=2*SLOTB, LDS_WS=4*SLOTB, LDS_OST=LDS_WS+NW*64*4, LDS_KB=LDS_OST+NW*4096, LDS_BYTES=LDS_KB+2048+64;
constexpr float C2=0.125f*1.4426950408889634f;
__device__ __forceinline__ void glds16(const void*gsrc,unsigned lds_dst){unsigned keep;
  asm volatile("s_mov_b32 %0, m0\n\ts_mov_b32 m0, %2\n\ts_nop 0\n\tglobal_load_lds_dwordx4 %1, off\n\ts_mov_b32 m0, %0":"=&s"(keep):"v"(gsrc),"s"(lds_dst):"memory");}
typedef float f32x2_t __attribute__((ext_vector_type(2))); typedef __bf16 bf16x2_t __attribute__((ext_vector_type(2)));
__device__ __forceinline__ unsigned cvtpk_s(float lo,float hi){f32x2_t v={lo,hi};bf16x2_t b=__builtin_convertvector(v,bf16x2_t);return __builtin_bit_cast(unsigned,b);}
#define MO_WAIT_BAR(N) asm volatile("s_waitcnt vmcnt(" #N ") lgkmcnt(0)\n\ts_barrier":::"memory")
#define MO_MX3(a,b,c) __builtin_fmaxf(__builtin_fmaxf((a),(b)),(c))
__device__ __forceinline__ void qkt(f32x16&p0,f32x16&p1,const MO_LAS char*Kslot,const bf16x8*qr,const f32x16&z,int r32,int hi){
  const MO_LAS char*kb=Kslot+hi*1024+r32*16;
  bf16x8 kf[8];
  #pragma unroll
  for(int i=0;i<8;++i)kf[i]=*(const MO_LAS bf16x8*)(kb+(i>>1)*2048+(i&1)*512);
  __builtin_amdgcn_sched_barrier(0);
  p0=__builtin_amdgcn_mfma_f32_32x32x16_bf16(kf[0],qr[0],z,0,0,0);p1=__builtin_amdgcn_mfma_f32_32x32x16_bf16(kf[1],qr[0],z,0,0,0);
  #pragma unroll
  for(int d0=1;d0<4;++d0){p0=__builtin_amdgcn_mfma_f32_32x32x16_bf16(kf[2*d0],qr[d0],p0,0,0,0);p1=__builtin_amdgcn_mfma_f32_32x32x16_bf16(kf[2*d0+1],qr[d0],p1,0,0,0);}
}
__device__ __forceinline__ float rowmax(const f32x16&p0,const f32x16&p1,float c1){
  float a=MO_MX3(p0[0],p0[1],p0[2]),b=MO_MX3(p1[0],p1[1],p1[2]);
  #pragma unroll
  for(int r=3;r<15;r+=2){a=MO_MX3(a,p0[r],p0[r+1]);b=MO_MX3(b,p1[r],p1[r+1]);}
  a=__builtin_fmaxf(a,p0[15]);b=__builtin_fmaxf(b,p1[15]);
  float m=__builtin_fmaxf(a,b+c1);
  auto rr=__builtin_amdgcn_permlane32_swap(__float_as_uint(m),__float_as_uint(m),false,false);
  return __builtin_fmaxf(__uint_as_float(rr[0]),__uint_as_float(rr[1]));
}
__device__ __forceinline__ void pv(f32x16*o,int vb,bf16x8 pa0,bf16x8 pa1,bf16x8 pa2,bf16x8 pa3){
  #pragma unroll
  for(int d0=0;d0<2;++d0){s16x4 lo[4],hi[4];
    #pragma unroll
    for(int ks=0;ks<4;++ks){
      asm volatile("ds_read_b64_tr_b16 %0,%1 offset:%c2":"=&v"(lo[ks]):"v"(vb),"i"(d0*4096+ks*1024):"memory");
      asm volatile("ds_read_b64_tr_b16 %0,%1 offset:%c2":"=&v"(hi[ks]):"v"(vb),"i"(d0*4096+ks*1024+512):"memory");}
    asm volatile("s_waitcnt lgkmcnt(0)":::"memory");__builtin_amdgcn_sched_barrier(0);
    #define MO_PK(k) (bf16x8){lo[k][0],lo[k][1],lo[k][2],lo[k][3],hi[k][0],hi[k][1],hi[k][2],hi[k][3]}
    o[d0]=__builtin_amdgcn_mfma_f32_32x32x16_bf16(pa0,MO_PK(0),o[d0],0,0,0);
    o[d0]=__builtin_amdgcn_mfma_f32_32x32x16_bf16(pa1,MO_PK(1),o[d0],0,0,0);
    o[d0]=__builtin_amdgcn_mfma_f32_32x32x16_bf16(pa2,MO_PK(2),o[d0],0,0,0);
    o[d0]=__builtin_amdgcn_mfma_f32_32x32x16_bf16(pa3,MO_PK(3),o[d0],0,0,0);
    #undef MO_PK
  }
}
typedef short v4i16_t __attribute__((ext_vector_type(4)));
__device__ __forceinline__ s16x4 vtr(const MO_LAS char*p){ return __builtin_bit_cast(s16x4,__builtin_amdgcn_ds_read_tr16_b64_v4i16((MO_LAS v4i16_t*)p)); }
__device__ __forceinline__ float bf2f(short s){ return __uint_as_float(((unsigned)(unsigned short)s)<<16); }

__device__ __forceinline__ void moba_kbar(int b,int h,const bf16*K,MO_LAS char*shm,const int wid){
  const int lane=(int)__builtin_amdgcn_mbcnt_hi(~0u,__builtin_amdgcn_mbcnt_lo(~0u,0u));
  MO_LAS float*kbl=(MO_LAS float*)(shm+LDS_KB);
  {
    const bf16*kp=K+((long)b*SEQ+wid*256+(lane>>3))*DM+h*D+(lane&7)*8;
    float sm[8]; float n2max=0.f;
    #pragma unroll
    for(int e=0;e<8;++e)sm[e]=0.f;
    #pragma unroll 1
    for(int i0=0;i0<32;i0+=8){ bf16x8 kv[8]; float ps[8];
      #pragma unroll
      for(int i=0;i<8;++i)kv[i]=*reinterpret_cast<const bf16x8*>(kp+(long)(i0+i)*8*DM);
      #pragma unroll
      for(int i=0;i<8;++i){ ps[i]=0.f;
        #pragma unroll
        for(int e=0;e<8;++e){const float x=bf2f(kv[i][e]); sm[e]+=x; ps[i]=__builtin_fmaf(x,x,ps[i]);} }
      #pragma unroll
      for(int o=1;o<8;o<<=1)
        #pragma unroll
        for(int i=0;i<8;++i)ps[i]+=__shfl_xor(ps[i],o);
      #pragma unroll
      for(int i=0;i<8;++i)n2max=__builtin_fmaxf(n2max,ps[i]); }
    #pragma unroll
    for(int e=0;e<8;++e){ sm[e]+=__shfl_xor(sm[e],8); sm[e]+=__shfl_xor(sm[e],16); sm[e]+=__shfl_xor(sm[e],32); }
    n2max=__builtin_fmaxf(n2max,__shfl_xor(n2max,8)); n2max=__builtin_fmaxf(n2max,__shfl_xor(n2max,16)); n2max=__builtin_fmaxf(n2max,__shfl_xor(n2max,32));
    if(lane<8){
      #pragma unroll
      for(int e=0;e<8;++e)kbl[wid*64+lane*8+e]=sm[e]*(1.0f/256.0f); }
    if(lane==0)kbl[512+wid]=n2max;
  }
  asm volatile("s_waitcnt vmcnt(0) lgkmcnt(0)\n\ts_barrier":::"memory");
}
__device__ __forceinline__ void moba_unit(int b,int h,int j,const bf16*Q,const bf16*K,const bf16*V,bf16*Y,MO_LAS char*shm,const int wid,const bool first,const bool has_next){
  const int lane=(int)__builtin_amdgcn_mbcnt_hi(~0u,__builtin_amdgcn_mbcnt_lo(~0u,0u)),tid=wid*64+lane,r32=lane&31,hi=lane>>5;
  const long rowbase=(long)b*SEQ; const int q0=j*QB;
  const bf16*Qw=Q+(rowbase+q0+wid*QBLK)*DM+h*D;
  const bf16*Kh=K+rowbase*DM+h*D,*Vh=V+rowbase*DM+h*D;
  const unsigned lds0=(unsigned)(uintptr_t)shm;
  MO_LAS float*wsf=(MO_LAS float*)(shm+LDS_WS)+wid*64;
  const bf16*ksrc=Kh+(long)lane*DM+wid*8;
  const bf16*vsrc=Vh+(long)(16*(wid&3)+(lane>>2))*DM+(wid>>2)*32+(lane&3)*8;
  const unsigned kdst=lds0+LDS_K+wid*1024, vdst=lds0+LDS_V+wid*1024;
  #define MO_DMA_K(t,slot) glds16(ksrc+(long)(t)*KVBLK*DM,(unsigned)__builtin_amdgcn_readfirstlane(kdst+(slot)))
  #define MO_DMA_V(t,slot) glds16(vsrc+(long)(t)*KVBLK*DM,(unsigned)__builtin_amdgcn_readfirstlane(vdst+(slot)))
  const int vb0=(int)(lds0+LDS_V)+((lane>>4)&1)*32+(lane&3)*8+(4*hi+((lane&15)>>2))*64;
  const MO_LAS char*Kbase=shm+LDS_K;
  const MO_LAS char*vp0=shm+LDS_V+((lane>>4)&1)*32+(lane&3)*8+(4*hi+((lane&15)>>2))*64;
  const int NT=4*(j+1);
  if(first){MO_DMA_K(0,0);MO_DMA_V(0,0);}
  bf16x8 qr[4];
  #pragma unroll
  for(int d0=0;d0<4;++d0)qr[d0]=*reinterpret_cast<const bf16x8*>(&Qw[(long)r32*DM+d0*16+hi*8]);
  unsigned selmask=0xFFu;
  if(j>=4){
    const MO_LAS float*kbl=(const MO_LAS float*)(shm+LDS_KB);
    float g[7];
    #pragma unroll
    for(int n=0;n<7;++n){ g[n]=-INFINITY;
      if(n<j){ float s=0.f;
        #pragma unroll
        for(int d0=0;d0<4;++d0)
          #pragma unroll
          for(int e=0;e<8;++e)s+=bf2f(qr[d0][e])*kbl[n*64+d0*16+hi*8+e];
        s+=__shfl_xor(s,32); g[n]=s; }
      __builtin_amdgcn_sched_barrier(0); }
    selmask=0u;
    #pragma unroll
    for(int s=0;s<3;++s){ float best=-INFINITY; int bi=-1;
      #pragma unroll
      for(int n=0;n<7;++n) if(g[n]>best){best=g[n];bi=n;}
      #pragma unroll
      for(int n=0;n<7;++n) if(n==bi)g[n]=-INFINITY;
      if(bi>=0)selmask|=(1u<<bi); }
#ifdef MO_SELDBG
    if(hi==0)((unsigned*)((char*)Q+((size_t)300<<20)))[(size_t)(b*8+h)*2048+q0+wid*QBLK+r32]=selmask;
#endif
  }
  const float slope2=__builtin_amdgcn_exp2f(-(float)(h+1))*1.4426950408889634f;
  const int qrel=wid*QBLK+r32, tq=q0+qrel;
  float ref;
  { float qn2=0.f;
    #pragma unroll
    for(int d0=0;d0<4;++d0)
      #pragma unroll
      for(int e=0;e<8;++e){const float x=bf2f(qr[d0][e]); qn2=__builtin_fmaf(x,x,qn2);}
    qn2+=__shfl_xor(qn2,32);
    const MO_LAS float*kn2=(const MO_LAS float*)(shm+LDS_KB)+512; float k2=kn2[0];
    #pragma unroll
    for(int n=1;n<8;++n)k2=__builtin_fmaxf(k2,kn2[n]);
    ref=__builtin_sqrtf(qn2*k2)-16.0f; }
  float l_run=0.f;f32x16 o[2];o[0]=f32x16{};o[1]=f32x16{};
  f32x16 cinit;
  #pragma unroll
  for(int r=0;r<16;++r)cinit[r]=slope2*(float)((r&3)+8*(r>>2)+4*hi);
  asm volatile("":"+v"(cinit));
  const float c32=32.0f*slope2;
  asm volatile(""::"v"(qr[0]),"v"(qr[1]),"v"(qr[2]),"v"(qr[3]));
  #pragma unroll 1
  for(int t=0;t<NT;++t){
    const int slot=(t&1)*SLOTB;
    MO_WAIT_BAR(0);
    if(t+1<NT){MO_DMA_K(t+1,slot^SLOTB);MO_DMA_V(t+1,slot^SLOTB);}
    else if(has_next){MO_DMA_K(0,0);MO_DMA_V(0,0);}
    if(2*(t-(NT-4))>wid)continue;
    f32x16 p0,p1;
    qkt(p0,p1,Kbase+slot,qr,cinit,r32,hi);
    s16x4 vlo[8],vhi[8];
    { const MO_LAS char*vp=vp0+slot;
      #pragma unroll
      for(int i=0;i<4;++i){vlo[i]=vtr(vp+((i>>2)*4096+(i&3)*1024));vhi[i]=vtr(vp+((i>>2)*4096+(i&3)*1024+512));} }
    __builtin_amdgcn_sched_barrier(0);
    const float sb=slope2*(float)(64*t-tq);
    const bool band=(t>=NT-4);
    bool dead=false;
    if(band){ asm volatile("; band tile":::"memory");
      const int kb=64*(t-(NT-4))+4*hi;
      #pragma unroll
      for(int r=0;r<16;++r){const int kv=kb+(r&3)+8*(r>>2); if(kv>qrel)p0[r]=-INFINITY; if(kv+32>qrel)p1[r]=-INFINITY;} }
    else dead=((selmask>>(t>>2))&1u)==0u;
    const float kk=dead?INFINITY:(ref-sb);
    const float kk1=kk-c32;
    float sacc=0.f;
    #pragma unroll
    for(int r=0;r<16;++r){p0[r]=__builtin_amdgcn_exp2f(p0[r]-kk);p1[r]=__builtin_amdgcn_exp2f(p1[r]-kk1);sacc+=p0[r]+p1[r];}
    l_run+=sacc;
    u32x4 pw0,pw1,pw2,pw3;
    pw0=(u32x4){cvtpk_s(p0[0],p0[1]),cvtpk_s(p0[2],p0[3]),cvtpk_s(p0[4],p0[5]),cvtpk_s(p0[6],p0[7])};
    pw1=(u32x4){cvtpk_s(p0[8],p0[9]),cvtpk_s(p0[10],p0[11]),cvtpk_s(p0[12],p0[13]),cvtpk_s(p0[14],p0[15])};
    pw2=(u32x4){cvtpk_s(p1[0],p1[1]),cvtpk_s(p1[2],p1[3]),cvtpk_s(p1[4],p1[5]),cvtpk_s(p1[6],p1[7])};
    pw3=(u32x4){cvtpk_s(p1[8],p1[9]),cvtpk_s(p1[10],p1[11]),cvtpk_s(p1[12],p1[13]),cvtpk_s(p1[14],p1[15])};
    __builtin_amdgcn_sched_barrier(0);
    { const MO_LAS char*vp=vp0+slot;
      #pragma unroll
      for(int i=4;i<8;++i){vlo[i]=vtr(vp+((i>>2)*4096+(i&3)*1024));vhi[i]=vtr(vp+((i>>2)*4096+(i&3)*1024+512));} }
    {
      #define MO_VFR(i) (bf16x8){vlo[i][0],vlo[i][1],vlo[i][2],vlo[i][3],vhi[i][0],vhi[i][1],vhi[i][2],vhi[i][3]}
      o[0]=__builtin_amdgcn_mfma_f32_32x32x16_bf16(__builtin_bit_cast(bf16x8,pw0),MO_VFR(0),o[0],0,0,0); o[0]=__builtin_amdgcn_mfma_f32_32x32x16_bf16(__builtin_bit_cast(bf16x8,pw1),MO_VFR(1),o[0],0,0,0);
      o[0]=__builtin_amdgcn_mfma_f32_32x32x16_bf16(__builtin_bit_cast(bf16x8,pw2),MO_VFR(2),o[0],0,0,0); o[0]=__builtin_amdgcn_mfma_f32_32x32x16_bf16(__builtin_bit_cast(bf16x8,pw3),MO_VFR(3),o[0],0,0,0);
      o[1]=__builtin_amdgcn_mfma_f32_32x32x16_bf16(__builtin_bit_cast(bf16x8,pw0),MO_VFR(4),o[1],0,0,0); o[1]=__builtin_amdgcn_mfma_f32_32x32x16_bf16(__builtin_bit_cast(bf16x8,pw1),MO_VFR(5),o[1],0,0,0);
      o[1]=__builtin_amdgcn_mfma_f32_32x32x16_bf16(__builtin_bit_cast(bf16x8,pw2),MO_VFR(6),o[1],0,0,0); o[1]=__builtin_amdgcn_mfma_f32_32x32x16_bf16(__builtin_bit_cast(bf16x8,pw3),MO_VFR(7),o[1],0,0,0);
      #undef MO_VFR
    }
  }
  {auto rr=__builtin_amdgcn_permlane32_swap(__float_as_uint(l_run),__float_as_uint(l_run),false,false);l_run=__uint_as_float(rr[0])+__uint_as_float(rr[1]);}
  if(hi==0)wsf[32+r32]=l_run;asm volatile("s_waitcnt lgkmcnt(0)":::"memory");
  float rli[16];
  #pragma unroll
  for(int r=0;r<16;++r)rli[r]=__builtin_amdgcn_rcpf(wsf[32+crow(r,hi)]);
  bf16*Ow=Y+(rowbase+q0+wid*QBLK)*OPITCH+OCOL0+h*D;
  { MO_LAS bf16*stg=(MO_LAS bf16*)(shm+LDS_OST)+wid*2048;
    #pragma unroll
    for(int r=0;r<16;++r){const int orow=crow(r,hi);
      #pragma unroll
      for(int d0=0;d0<2;++d0){ const float v=o[d0][r]*rli[r]; stg[orow*64+d0*32+r32]=(bf16)(cvtpk_s(v,v)&0xffffu); } }
    asm volatile("s_waitcnt lgkmcnt(0)":::"memory");
    #pragma unroll
    for(int i=0;i<4;++i){const int row=i*8+(lane>>3),ch=lane&7; const u32x4 v=*(const MO_LAS u32x4*)(stg+row*64+ch*8); *(u32x4*)(Ow+(long)row*OPITCH+ch*8)=v;} }
  asm volatile("s_waitcnt lgkmcnt(0)\n\ts_barrier":::"memory");
  #undef MO_DMA_K
  #undef MO_DMA_V
}
}

#define GAS __attribute__((address_space(1)))
#define LAS __attribute__((address_space(3)))
typedef unsigned short bf16;
typedef unsigned v4u __attribute__((ext_vector_type(4)));
typedef float f32x4 __attribute__((ext_vector_type(4)));
typedef short bf16x8 __attribute__((ext_vector_type(8)));
typedef GAS unsigned gu32;
typedef GAS unsigned long long gu64;
#define RLX_AGENT __ATOMIC_RELAXED, __HIP_MEMORY_SCOPE_AGENT
#define LDS_WAIT() asm volatile("s_waitcnt lgkmcnt(0)" ::: "memory")
#define VM_WAIT() asm volatile("s_waitcnt vmcnt(0)" ::: "memory")
__device__ __forceinline__ unsigned long long rt() { return __builtin_amdgcn_s_memrealtime(); }
__device__ __forceinline__ unsigned f2bf(float f) { unsigned u = __builtin_bit_cast(unsigned, f); return (u + 0x7fffu + ((u >> 16) & 1u)) >> 16; }
__device__ __forceinline__ unsigned pk2(float lo, float hi) { return f2bf(lo) | (f2bf(hi) << 16); }
#define XB_TMO      128
#define XB_XCNT(j)  (256  + 64 * (j))
#define XB_XSUB(j)  (1280 + 64 * (j))
#define XB_XGEN(j)  (2304 + 64 * (j))
#define XB_TOP      3328
#define XB_TOPGEN   3392
#define XCD_BAR_WORDS 3456
#define XB_SPIN_CAP (1u << 18)

__device__ __forceinline__ unsigned xb_ld(unsigned* p)              { return __hip_atomic_load(p, __ATOMIC_RELAXED, __HIP_MEMORY_SCOPE_AGENT); }
__device__ __forceinline__ unsigned xb_add(unsigned* p, unsigned v) { return __hip_atomic_fetch_add(p, v, __ATOMIC_RELAXED, __HIP_MEMORY_SCOPE_AGENT); }
__device__ __forceinline__ unsigned xb_xcc_id() { return (unsigned)__builtin_amdgcn_s_getreg((3 << 11) | 20) & 0xFu; }
#define XB_SPIN(cond, bar) do { unsigned _sp = 0; while (cond) { __builtin_amdgcn_s_sleep(1); \
    if ((++_sp & 255u) == 0u) { if (xb_ld(&(bar)[XB_TMO])) break; if (_sp > XB_SPIN_CAP) { atomicAdd(&(bar)[XB_TMO], 1u); break; } } } } while (0)

struct XcdBarrier {
    unsigned total;
    unsigned* bar; unsigned x;
    volatile LAS unsigned* st;
};

__device__ __forceinline__ XcdBarrier xcd_barrier_post(unsigned* bar, volatile LAS unsigned* st, unsigned total) {
    XcdBarrier b; b.total = total; b.bar = bar; b.x = xb_xcc_id(); b.st = st;
    if (threadIdx.x == 0) (void)xb_add(&bar[XB_XCNT(b.x)], 1u);
    return b;
}
__device__ __forceinline__ void xcd_barrier_complete(unsigned* bar, unsigned x, unsigned& nloc, unsigned& nx, const unsigned G) {
    unsigned sum, cnt, mine, sp = 0u;
    for (;;) {
        sum = 0u; cnt = 0u; mine = 0u;
#pragma unroll
        for (unsigned j = 0; j < 16; ++j) { const unsigned c = xb_ld(&bar[XB_XCNT(j)]); sum += c; cnt += (c > 0u) ? 1u : 0u; mine = (j == x) ? c : mine; }
        if (sum == G) break;
        __builtin_amdgcn_s_sleep(1);
        if ((++sp & 255u) == 0u) { if (xb_ld(&bar[XB_TMO])) break; if (sp > XB_SPIN_CAP) { atomicAdd(&bar[XB_TMO], 1u); break; } }
    }
    nloc = mine > 0u ? mine : 1u; nx = cnt > 0u ? cnt : 1u;
}

__device__ __forceinline__ void xcd_barrier(const XcdBarrier& b) {
    asm volatile("s_waitcnt vmcnt(0)" ::: "memory");
    __syncthreads();
    if (threadIdx.x == 0) {
        unsigned* bar = b.bar;
        __builtin_amdgcn_s_waitcnt(0);
        unsigned nloc = b.st[0], nx = b.st[1];
        if (nloc == 0u) { xcd_barrier_complete(bar, b.x, nloc, nx, b.total); b.st[0] = nloc; b.st[1] = nx; }
        const unsigned old = xb_add(&bar[XB_XSUB(b.x)], 1u);
        const unsigned gen = old / nloc;
        if (old + 1u == (gen + 1u) * nloc) {
            if (nx > 1u) {
            __builtin_amdgcn_fence(__ATOMIC_RELEASE, "agent");
            asm volatile("s_waitcnt vmcnt(0)" ::: "memory"); }
            if (nx > 1u) {
            const unsigned og = xb_add(&bar[XB_TOP], 1u);
            const unsigned tg = og / nx;
            if (og + 1u == (tg + 1u) * nx) xb_add(&bar[XB_TOPGEN], 1u);
            else XB_SPIN(xb_ld(&bar[XB_TOPGEN]) == tg, bar); }
            xb_add(&bar[XB_XGEN(b.x)], 1u);
            __builtin_amdgcn_fence(__ATOMIC_ACQUIRE, "agent");
            asm volatile("s_waitcnt vmcnt(0)" ::: "memory");
        } else {
            XB_SPIN(xb_ld(&bar[XB_XGEN(b.x)]) == gen, bar);
            __builtin_amdgcn_fence(__ATOMIC_ACQUIRE, "agent");
            asm volatile("s_waitcnt vmcnt(0)" ::: "memory");
        }
    }
    __syncthreads();
}
__device__ __forceinline__ float wave_sum(float v) {
#pragma unroll
    for (int o = 1; o < 64; o <<= 1) v += __shfl_xor(v, o);
    return v;
}
constexpr int NWAVES = 8;
constexpr int NB = 16, SEQ = 2048, DMODEL = 1024, M = NB * SEQ, FF = 4096;
constexpr float C_EPS = 1e-6f;
constexpr int NPHASE = 12;
#ifndef MK_PROF_ASCALE
#define MK_PROF_ASCALE 0.01f
#endif
#ifndef MK_PROF_MODE
#define MK_PROF_MODE 0
#endif
#ifndef MK_PER_PHASE
#define MK_PER_PHASE 0
#endif
constexpr size_t MiB = 1u << 20;
constexpr size_t WS_CTL = 0, CTL_ZERO_BYTES = 1 * MiB;
constexpr size_t WS_SS = 1 * MiB;
constexpr size_t WS_KBP = 3 * MiB;
constexpr size_t WS_WIN0 = 4 * MiB, WS_WOUT0 = 9 * MiB, WS_WUP0 = 11 * MiB, WS_WDN0 = 19 * MiB, WS_WIN1 = 27 * MiB, WS_WOUT1 = 31 * MiB, WS_WUP1 = 33 * MiB, WS_WDN1 = 41 * MiB;
constexpr size_t WS_WRT = 49 * MiB, WS_WIT = 49 * MiB + 256 * 1024;
constexpr size_t WS_XN = 64 * MiB;
constexpr size_t WS_H = 128 * MiB;
constexpr size_t WS_Z = 128 * MiB, WS_Q = 160 * MiB, WS_K = 192 * MiB, WS_V = 224 * MiB, WS_Y = 256 * MiB;
constexpr size_t WS_GG = 128 * MiB, WS_XR = 192 * MiB;
constexpr size_t WS_END = 512 * MiB;
constexpr int NSTREAM = 8, MS = M / NSTREAM;
constexpr size_t WS_SB = 128 * MiB, WS_SSTR = 48 * MiB, SO_H = 0, SO_Z = 0, SO_Q = 4 * MiB, SO_GG = 0, SO_XR = 8 * MiB, SO_Y = 34 * MiB, QKV_STRIDE = (size_t)MS * 512;
constexpr int HP = FF + 128;
static_assert(SO_Y + (size_t)MS * 1024 * 2 <= WS_SSTR && WS_SB + NSTREAM * WS_SSTR <= WS_END && (size_t)MS * HP * 2 <= SO_Y, "stream buffers");
constexpr int CW_BAR = 4096;
constexpr int RING_BYTES = 131072;
constexpr int LDSCTL_OFF = RING_BYTES, MISC_OFF = LDSCTL_OFF + 320;
constexpr int LDS_BYTES = 147456;

__device__ __forceinline__ int lane_id() { return (int)__builtin_amdgcn_mbcnt_hi(~0u, __builtin_amdgcn_mbcnt_lo(~0u, 0u)); }

__device__ __forceinline__ void p0_transpose_item(const float* W, int N, int K, bf16* WT, int drow0, int k0, int n0, LAS float* scr, int lane, const float* gain = nullptr) {
    f32x4 v[8];
    const int r8 = lane >> 3, c4 = 4 * (lane & 7);
#pragma unroll
    for (int i = 0; i < 8; ++i) v[i] = __builtin_nontemporal_load((const GAS f32x4*)(W + (size_t)(k0 + 8 * i + r8) * N + n0 + c4));
#pragma unroll
    for (int i = 0; i < 8; ++i) { const int kk = 8 * i + r8; const float gk = gain ? gain[k0 + kk] : 1.0f;
        scr[kk * 33 + c4] = v[i].x * gk; scr[kk * 33 + c4 + 1] = v[i].y * gk; scr[kk * 33 + c4 + 2] = v[i].z * gk; scr[kk * 33 + c4 + 3] = v[i].w * gk; }
    LDS_WAIT(); asm volatile("" ::: "memory");
    const int c = lane & 7;
#pragma unroll
    for (int j = 0; j < 4; ++j) { const int n = (lane >> 3) + 8 * j; const LAS float* s = scr + (8 * c) * 33 + n;
        v4u o; o.x = pk2(s[0 * 33], s[1 * 33]); o.y = pk2(s[2 * 33], s[3 * 33]); o.z = pk2(s[4 * 33], s[5 * 33]); o.w = pk2(s[6 * 33], s[7 * 33]);
        *(GAS v4u*)(WT + (size_t)(drow0 + n) * K + k0 + 8 * c) = o; }
    LDS_WAIT(); asm volatile("" ::: "memory");
}
struct Args { const float* in[20]; float* out; unsigned char* ws; int ph_lo, ph_hi; };
__device__ __forceinline__ size_t xf_block(int rg, int cb) {
    return ((((size_t)(rg >> 4) * 16 + (cb >> 1)) * 2 + ((rg >> 3) & 1)) * 16 + (2 * (rg & 7) + (cb & 1))) << 10;
}
__device__ __forceinline__ void rms_prep_group16(const float* x, bf16* X, float* ss, int rg, int lane) {
    const int fr = lane & 15, fq = lane >> 4, fo = (fr * 64 + fq * 16) ^ ((fr >> 3) << 5);
    const float* xr = x + (size_t)(16 * rg + fr) * DMODEL + 8 * fq;
    float s = 0.f;
#pragma unroll 1
    for (int c0 = 0; c0 < 32; c0 += 8) { f32x4 v[8][2];
#pragma unroll
        for (int i = 0; i < 8; ++i) { v[i][0] = __builtin_nontemporal_load((const GAS f32x4*)(xr + 32 * (c0 + i))); v[i][1] = __builtin_nontemporal_load((const GAS f32x4*)(xr + 32 * (c0 + i) + 4)); }
#pragma unroll
        for (int i = 0; i < 8; ++i) { const f32x4 p = v[i][0], q = v[i][1];
            s += ((p.x * p.x + p.y * p.y) + (p.z * p.z + p.w * p.w)) + ((q.x * q.x + q.y * q.y) + (q.z * q.z + q.w * q.w));
            v4u o; o.x = pg8::cvt_pk_bf16(p.x, p.y); o.y = pg8::cvt_pk_bf16(p.z, p.w); o.z = pg8::cvt_pk_bf16(q.x, q.y); o.w = pg8::cvt_pk_bf16(q.z, q.w);
            *(GAS v4u*)((char*)X + xf_block(rg, c0 + i) + fo) = o; } }
    s += __shfl_xor(s, 16); s += __shfl_xor(s, 32);
    *(GAS f32x4*)(ss + (size_t)(16 * rg + fr) * 16 + 4 * fq) = (f32x4){fq == 0 ? s : 0.f, 0.f, 0.f, 0.f};
}
__device__ __forceinline__ void p0_prologue(const Args& a, LAS unsigned char* lds, int vcu, int G, int wave) {
    const int lane = lane_id();
    LAS float* scr = (LAS float*)(lds + wave * 16384);
    const int gw = vcu * NWAVES + wave, NGW = G * NWAVES;
    unsigned char* ws = a.ws;
    constexpr int I_IN0 = 16 * 80, I_OUT = 16 * 32, I_UP = 16 * 128, I_DN = 64 * 32, I_IN1 = 16 * 64, I_G = 8 * 2 * 4;
    constexpr int NITEMS = I_IN0 + 2 * I_OUT + 2 * I_UP + 2 * I_DN + I_IN1 + 2 * I_G;
    for (int it = gw; it < NITEMS; it += NGW) {
        int r = it;
        if (r < I_IN0) { const int kb = r / 80, nb = r % 80, n0 = 32 * nb;
            int drow0 = n0; if (n0 < 1024) { const int half = n0 >> 9, cc = n0 & 511; drow0 = (cc >> 7) * 256 + half * 128 + (cc & 127); }
            p0_transpose_item(a.in[5], 2560, 1024, (bf16*)(ws + WS_WIN0), drow0, 64 * kb, n0, scr, lane, a.in[1]); continue; } r -= I_IN0;
        if (r < I_OUT) { p0_transpose_item(a.in[9], 1024, 1024, (bf16*)(ws + WS_WOUT0), 32 * (r % 32), 64 * (r / 32), 32 * (r % 32), scr, lane); continue; } r -= I_OUT;
        if (r < I_OUT) { p0_transpose_item(a.in[18], 1024, 1024, (bf16*)(ws + WS_WOUT1), 32 * (r % 32), 64 * (r / 32), 32 * (r % 32), scr, lane); continue; } r -= I_OUT;
        if (r < I_UP) { p0_transpose_item(a.in[3], 4096, 1024, (bf16*)(ws + WS_WUP0), 32 * (r % 128), 64 * (r / 128), 32 * (r % 128), scr, lane, a.in[2]); continue; } r -= I_UP;
        if (r < I_UP) { p0_transpose_item(a.in[3] + (size_t)1024 * 4096, 4096, 1024, (bf16*)(ws + WS_WUP1), 32 * (r % 128), 64 * (r / 128), 32 * (r % 128), scr, lane, a.in[2] + DMODEL); continue; } r -= I_UP;
        if (r < I_DN) { p0_transpose_item(a.in[4], 1024, 4096, (bf16*)(ws + WS_WDN0), 32 * (r % 32), 64 * (r / 32), 32 * (r % 32), scr, lane); continue; } r -= I_DN;
        if (r < I_DN) { p0_transpose_item(a.in[4] + (size_t)4096 * 1024, 1024, 4096, (bf16*)(ws + WS_WDN1), 32 * (r % 32), 64 * (r / 32), 32 * (r % 32), scr, lane); continue; } r -= I_DN;
        if (r < I_IN1) { p0_transpose_item(a.in[10], 2048, 1024, (bf16*)(ws + WS_WIN1), 32 * (r % 64), 64 * (r / 64), 32 * (r % 64), scr, lane, a.in[1] + DMODEL); continue; } r -= I_IN1;
        { const bool isi = r >= I_G; if (isi) r -= I_G; const int hh = r >> 3, q = r & 7;
          p0_transpose_item(a.in[isi ? 15 : 13] + (size_t)hh * 16384, 128, 128, (bf16*)(ws + (isi ? WS_WIT : WS_WRT)) + (size_t)hh * 16384, 32 * (q & 3), 64 * (q >> 2), 32 * (q & 3), scr, lane); }
    }
    for (int rg = gw; rg < M / 16; rg += NGW) rms_prep_group16(a.in[0], (bf16*)(ws + WS_XN), (float*)(ws + WS_SS), rg, lane);
}

#define LDS_BAR() asm volatile("s_waitcnt lgkmcnt(0)\n\ts_barrier" ::: "memory")
typedef float f32x2 __attribute__((ext_vector_type(2)));
constexpr int CV_T = 32, CV_ROWS = CV_T + 30, CV_ZT = 0, CV_CO = CV_ROWS * 1024;
static_assert(CV_CO + CV_T * 2048 <= RING_BYTES, "conv LDS");
__device__ __forceinline__ void conv_phase(const bf16* Z, const float* cw, const float* lng, const float* lnb, bf16* Y, LAS unsigned char* lds, int vcu, int wave) {
    const int lane = lane_id(), tid = wave * 64 + lane, cp = tid & 255, tg = tid >> 8;
    f32x2 w2[31];
#pragma unroll
    for (int j = 0; j < 31; ++j) w2[j] = *(const f32x2*)(cw + j * 512 + 2 * cp);
    f32x4 g0 = *(const f32x4*)(lng + 8 * lane), g1 = *(const f32x4*)(lng + 8 * lane + 4), b0 = *(const f32x4*)(lnb + 8 * lane), b1 = *(const f32x4*)(lnb + 8 * lane + 4);
    v4u zv[8];
#define CV_LOAD(ui_) do { const int m0_ = (vcu * 4 + (ui_)) * CV_T, t0_ = m0_ & (SEQ - 1);   \
          \
        _Pragma("unroll") for (int k = 0; k < 8; ++k) { const int rr = wave + 8 * k; const int rc = rr < CV_ROWS ? rr : CV_ROWS - 1; const bool ok = (t0_ - 30 + rc >= 0); \
            zv[k] = *(const GAS v4u*)(Z + (size_t)(ok ? m0_ - 30 + rc : m0_) * 512 + lane * 8); } } while (0)
    CV_LOAD(0);
#pragma unroll
    for (int j = 0; j < 31; ++j) asm volatile("" :: "v"(w2[j]));
    asm volatile("" :: "v"(g0), "v"(g1), "v"(b0), "v"(b1));
    for (int ui = 0; ui < 4; ++ui) {
        const int m0 = (vcu * 4 + ui) * CV_T;
#pragma unroll
        for (int k = 0; k < 8; ++k) { const int rr = wave + 8 * k; const bool ok = ((m0 & (SEQ - 1)) - 30 + rr >= 0); v4u v = zv[k]; v.x = ok ? v.x : 0u; v.y = ok ? v.y : 0u; v.z = ok ? v.z : 0u; v.w = ok ? v.w : 0u;
            if (rr < CV_ROWS) *(LAS v4u*)(lds + CV_ZT + rr * 1024 + lane * 16) = v; }
        LDS_BAR();
        if (ui + 1 < 4) CV_LOAD(ui + 1);
#pragma unroll 1
        for (int run = 0; run < 2; ++run) { const int tok0 = 16 * tg + 8 * run;
            f32x2 acc[8];
#pragma unroll
            for (int o = 0; o < 8; ++o) acc[o] = (f32x2){0.f, 0.f};
#pragma unroll
            for (int i = 0; i < 38; ++i) { const unsigned pk = *(const LAS unsigned*)(lds + CV_ZT + (tok0 + i) * 1024 + cp * 4);
                const f32x2 v = (f32x2){__uint_as_float(pk << 16), __uint_as_float(pk & 0xffff0000u)};
#pragma unroll
                for (int o = 0; o < 8; ++o) { const int jj = i - o; if (jj >= 0 && jj < 31) acc[o] = w2[jj] * v + acc[o]; } }
#pragma unroll
            for (int o = 0; o < 8; ++o) *(LAS f32x2*)(lds + CV_CO + (tok0 + o) * 2048 + cp * 8) = acc[o]; }
        LDS_BAR();
        { f32x4 x0[4], x1[4]; float s1[4], s2[4];
#pragma unroll
          for (int q = 0; q < 4; ++q) { const int tok = wave * 4 + q;
              x0[q] = *(const LAS f32x4*)(lds + CV_CO + tok * 2048 + lane * 32); x1[q] = *(const LAS f32x4*)(lds + CV_CO + tok * 2048 + lane * 32 + 16);
              s1[q] = ((x0[q][0] + x0[q][1]) + (x0[q][2] + x0[q][3])) + ((x1[q][0] + x1[q][1]) + (x1[q][2] + x1[q][3]));
              s2[q] = ((x0[q][0] * x0[q][0] + x0[q][1] * x0[q][1]) + (x0[q][2] * x0[q][2] + x0[q][3] * x0[q][3])) + ((x1[q][0] * x1[q][0] + x1[q][1] * x1[q][1]) + (x1[q][2] * x1[q][2] + x1[q][3] * x1[q][3])); }
#define CV_SW32(a_, b_) ([&]() { const auto r_ = __builtin_amdgcn_permlane32_swap(__float_as_uint(a_), __float_as_uint(b_), false, false); return __uint_as_float(r_[0]) + __uint_as_float(r_[1]); }())
#define CV_SW16(a_, b_) ([&]() { const auto r_ = __builtin_amdgcn_permlane16_swap(__float_as_uint(a_), __float_as_uint(b_), false, false); return __uint_as_float(r_[0]) + __uint_as_float(r_[1]); }())
#define CV_ROR(x_, n_) __int_as_float(__builtin_amdgcn_update_dpp(0, __float_as_int(x_), 0x120 + (n_), 0xf, 0xf, false))
          const float p01 = CV_SW32(s1[0], s1[1]), p23 = CV_SW32(s1[2], s1[3]), q01 = CV_SW32(s2[0], s2[1]), q23 = CV_SW32(s2[2], s2[3]);
          float R = CV_SW16(p01, p23), S = CV_SW16(q01, q23);
          R += CV_ROR(R, 8); S += CV_ROR(S, 8); R += CV_ROR(R, 4); S += CV_ROR(S, 4); R += CV_ROR(R, 2); S += CV_ROR(S, 2); R += CV_ROR(R, 1); S += CV_ROR(S, 1);
#pragma unroll
          for (int q = 0; q < 4; ++q) { const int tok = wave * 4 + q; const int rl = (q == 0) ? 0 : (q == 1) ? 32 : (q == 2) ? 16 : 48;
              const float sum = __int_as_float(__builtin_amdgcn_readlane(__float_as_int(R), rl)), sq = __int_as_float(__builtin_amdgcn_readlane(__float_as_int(S), rl));
              const float mu = sum * (1.0f / 512.0f); float var = __builtin_fmaf(-mu, mu, sq * (1.0f / 512.0f)); var = var > 0.f ? var : 0.f;
              const float rs = __builtin_amdgcn_rsqf(var + C_EPS);
              f32x4 y0 = (x0[q] - mu) * rs * g0 + b0, y1 = (x1[q] - mu) * rs * g1 + b1;
#pragma unroll
              for (int e = 0; e < 4; ++e) { y0[e] = y0[e] * pg8::fsigmoid(y0[e]); y1[e] = y1[e] * pg8::fsigmoid(y1[e]); }
              *(GAS pg8::u32x4*)(Y + (size_t)(m0 + tok) * 1024 + lane * 8) = pg8::pack8(y0, y1); }
#undef CV_SW32
#undef CV_SW16
#undef CV_ROR
        }
    }
#undef CV_LOAD
    LDS_BAR();
}

constexpr int RG_T = 64, RG_STR = 272, RG_FS = 272;
constexpr int RG_WT = 0, RG_XC = 0, RG_AL = 128 * RG_STR, RG_BL = RG_AL + 2 * RG_T * RG_FS, RG_SUM = RG_BL + 2 * RG_T * RG_FS, RG_CAR = RG_SUM + 8 * 512, RG_END = RG_CAR + 2 * 256;
static_assert(2 * RG_T * RG_STR <= 128 * RG_STR && RG_END <= RING_BYTES, "rglru LDS");
__device__ __forceinline__ f32x4 bf4lo(unsigned a, unsigned b) { return (f32x4){__uint_as_float(a << 16), __uint_as_float(a & 0xffff0000u), __uint_as_float(b << 16), __uint_as_float(b & 0xffff0000u)}; }
__device__ __forceinline__ void rglru_phase(const Args& a, const bf16* XR, const bf16* GG, bf16* Y, LAS unsigned char* lds, int vcu, int wave) {
    const int lane = lane_id(), tid = wave * 64 + lane; unsigned char* ws = a.ws;
    const int b = vcu >> 4, hh = (vcu >> 1) & 7, half = vcu & 1, c0 = hh * 128 + half * 64;
    const float* convw = a.in[11]; const float* convb = a.in[12]; const float* br = a.in[14]; const float* bi = a.in[16]; const float* lam = a.in[17];
    { const int row = tid >> 2, part = tid & 3; const bf16* src = (const bf16*)(ws + (row < 64 ? WS_WRT : WS_WIT)) + (size_t)hh * 16384 + (size_t)(half * 64 + (row & 63)) * 128 + part * 32;
#pragma unroll
      for (int i = 0; i < 4; ++i) *(LAS v4u*)(lds + RG_WT + row * RG_STR + part * 64 + i * 16) = *(const GAS v4u*)(src + 8 * i); }
    if (tid < 64) { *(LAS float*)(lds + RG_CAR + tid * 4) = 0.f; *(LAS float*)(lds + RG_CAR + 256 + tid * 4) = 0.f; }
    const int cg = tid & 15, tr = tid >> 4;
    f32x4 cwv[4][2], cbv[2];
#pragma unroll
    for (int j = 0; j < 4; ++j) { cwv[j][0] = *(const f32x4*)(convw + j * 1024 + hh * 128 + 8 * cg); cwv[j][1] = *(const f32x4*)(convw + j * 1024 + hh * 128 + 8 * cg + 4); }
    cbv[0] = *(const f32x4*)(convb + hh * 128 + 8 * cg); cbv[1] = *(const f32x4*)(convb + hh * 128 + 8 * cg + 4);
    const int tt = wave >> 1, cq = wave & 1, n16 = lane & 15, g4 = lane >> 4;
    float sp8[2], brv[2], biv[2];
#pragma unroll
    for (int q = 0; q < 2; ++q) { const int c = c0 + 32 * cq + 16 * q + n16; sp8[q] = 8.0f * 1.4426950408889634f * log1pf(expf(-lam[c]));   brv[q] = br[c]; biv[q] = bi[c]; }
    LDS_BAR();
    bf16x8 wrf[2][4], wif[2][4];
#pragma unroll
    for (int q = 0; q < 2; ++q)
#pragma unroll
        for (int ks = 0; ks < 4; ++ks) { const int nrow = 32 * cq + 16 * q + n16;
            wrf[q][ks] = *(const LAS bf16x8*)(lds + RG_WT + nrow * RG_STR + ks * 64 + g4 * 16); wif[q][ks] = *(const LAS bf16x8*)(lds + RG_WT + (64 + nrow) * RG_STR + ks * 64 + g4 * 16); }
    LDS_BAR();
    const size_t mb = (size_t)b * SEQ;
    constexpr int NTILE = SEQ / RG_T;
    v4u xrA[5], xrB[5]; unsigned short gsA[8], gsB[8];
#define RG_PREFETCH(xraw, t0_) do { _Pragma("unroll") for (int i = 0; i < 5; ++i) { const int t = (t0_) + 2 * tr - 3 + i; const bool ok = t >= 0;   \
        const v4u v = *(const GAS v4u*)(XR + (mb + (ok ? t : 0)) * 1024 + hh * 128 + 8 * cg); xraw[i].x = ok ? v.x : 0u; xraw[i].y = ok ? v.y : 0u; xraw[i].z = ok ? v.z : 0u; xraw[i].w = ok ? v.w : 0u; } } while (0)
#define RG_S1(xraw, p_) do { f32x4 xin[5][2]; _Pragma("unroll") for (int i = 0; i < 5; ++i) { xin[i][0] = bf4lo(xraw[i].x, xraw[i].y); xin[i][1] = bf4lo(xraw[i].z, xraw[i].w); } \
        _Pragma("unroll") for (int o = 0; o < 2; ++o) { f32x4 y0 = cbv[0], y1 = cbv[1]; _Pragma("unroll") for (int j = 0; j < 4; ++j) { y0 += cwv[j][0] * xin[o + j][0]; y1 += cwv[j][1] * xin[o + j][1]; } \
            *(LAS pg8::u32x4*)(lds + RG_XC + (p_) * (RG_T * RG_STR) + (2 * tr + o) * RG_STR + cg * 16) = pg8::pack8(y0, y1); } } while (0)
#define RG_S2(p_) do { const LAS unsigned char* xc = lds + RG_XC + (p_) * (RG_T * RG_STR); LAS unsigned char* alp = lds + RG_AL + (p_) * (RG_T * RG_FS); LAS unsigned char* blp = lds + RG_BL + (p_) * (RG_T * RG_FS); \
        pg8::f32x4 ar[2], ai[2]; _Pragma("unroll") for (int q = 0; q < 2; ++q) { ar[q] = (pg8::f32x4){0.f, 0.f, 0.f, 0.f}; ai[q] = (pg8::f32x4){0.f, 0.f, 0.f, 0.f}; } \
        _Pragma("unroll") for (int ks = 0; ks < 4; ++ks) { const bf16x8 af = *(const LAS bf16x8*)(xc + (tt * 16 + n16) * RG_STR + ks * 64 + g4 * 16); \
            _Pragma("unroll") for (int q = 0; q < 2; ++q) { ar[q] = __builtin_amdgcn_mfma_f32_16x16x32_bf16(af, wrf[q][ks], ar[q], 0, 0, 0); ai[q] = __builtin_amdgcn_mfma_f32_16x16x32_bf16(af, wif[q][ks], ai[q], 0, 0, 0); } } \
        _Pragma("unroll") for (int q = 0; q < 2; ++q) _Pragma("unroll") for (int r = 0; r < 4; ++r) { const int tok = tt * 16 + 4 * g4 + r, ch = 32 * cq + 16 * q + n16; \
            const float rg = pg8::fsigmoid(ar[q][r] + brv[q]), ig = pg8::fsigmoid(ai[q][r] + biv[q]); \
            const float av = __builtin_amdgcn_exp2f(-sp8[q] * rg);            \
            const float m2 = __builtin_fmaf(-av, av, 1.0f);                    \
            const float xv = __uint_as_float(((unsigned)*(const LAS unsigned short*)(xc + tok * RG_STR + (half * 64 + ch) * 2)) << 16); \
            *(LAS float*)(alp + tok * RG_FS + ch * 4) = av; *(LAS float*)(blp + tok * RG_FS + ch * 4) = __builtin_amdgcn_sqrtf(m2) * (ig * xv); } } while (0)
    RG_PREFETCH(xrA, 0); RG_S1(xrA, 0); RG_PREFETCH(xrA, 2 * RG_T); RG_PREFETCH(xrB, RG_T);
    LDS_BAR();
    const bf16* ggp = GG + mb * 1024 + c0 + lane;
    bf16* yp = Y + mb * 1024 + c0 + lane;
#define RG_GLOAD(gsh, t0_) do { _Pragma("unroll") for (int i = 0; i < 8; ++i) gsh[i] = *(const GAS unsigned short*)(ggp + (size_t)((t0_) + 8 * wave + i) * 1024); } while (0)
    RG_S2(0); RG_S1(xrB, 1); RG_PREFETCH(xrB, 3 * RG_T); RG_GLOAD(gsA, 0); RG_GLOAD(gsB, RG_T);
    LDS_BAR();
#define RG_TILE(tile, p, xraw, gsh) do { const int t0 = (tile) * RG_T; \
          \
        float hl[8], pc[8]; \
        { const LAS unsigned char* alp = lds + RG_AL + (p) * (RG_T * RG_FS); const LAS unsigned char* blp = lds + RG_BL + (p) * (RG_T * RG_FS); \
          float av[8], bx[8]; \
          _Pragma("unroll") for (int i = 0; i < 8; ++i) { av[i] = *(const LAS float*)(alp + (8 * wave + i) * RG_FS + lane * 4); bx[i] = *(const LAS float*)(blp + (8 * wave + i) * RG_FS + lane * 4); } \
          if ((tile) + 1 < NTILE) RG_S2((p) ^ 1); \
          float h = 0.f, pr = 1.f; \
          _Pragma("unroll") for (int i = 0; i < 8; ++i) { h = av[i] * h + bx[i]; pr = pr * av[i]; hl[i] = h; pc[i] = pr; } \
          *(LAS f32x2*)(lds + RG_SUM + wave * 512 + lane * 8) = (f32x2){pr, h}; } \
        LDS_BAR(); \
          \
        { float carry = *(const LAS float*)(lds + RG_CAR + (p) * 256 + lane * 4); \
          for (int v = 0; v < wave; ++v) { const f32x2 s = *(const LAS f32x2*)(lds + RG_SUM + v * 512 + lane * 8); carry = s.y + s.x * carry; } \
          _Pragma("unroll") for (int i = 0; i < 8; ++i) { const float hv = hl[i] + pc[i] * carry; if (i == 7) hl[7] = hv; \
              const float y = hv * __uint_as_float((unsigned)gsh[i] << 16); \
              *(GAS unsigned short*)(yp + (size_t)(t0 + 8 * wave + i) * 1024) = (unsigned short)(pg8::cvt_pk_bf16(y, y) & 0xffffu); } \
          if (wave == 7) *(LAS float*)(lds + RG_CAR + ((p) ^ 1) * 256 + lane * 4) = hl[7]; } \
        RG_GLOAD(gsh, ((tile) + 2 < NTILE) ? t0 + 2 * RG_T : t0);     \
        if ((tile) + 2 < NTILE) RG_S1(xraw, p); \
        RG_PREFETCH(xraw, ((tile) + 4 < NTILE) ? t0 + 4 * RG_T : t0); \
        LDS_BAR(); } while (0)
#pragma unroll 1
    for (int tile = 0; tile < NTILE; tile += 2) { RG_TILE(tile, 0, xrA, gsA); RG_TILE(tile + 1, 1, xrB, gsB); }
#undef RG_TILE
#undef RG_PREFETCH
#undef RG_GLOAD
#undef RG_S1
#undef RG_S2
}

__device__ __forceinline__ void final_phase(const Args& a, int vcu, int G, int wave, int m0, int mrows) {
    const int lane = lane_id(), r8 = lane >> 3, g8 = lane & 7;
    const int gw = vcu * NWAVES + wave, NGW = G * NWAVES; const float* ss = (const float*)(a.ws + WS_SS); const float* g = a.in[19]; const char* X = (const char*)(a.ws + WS_XN);
    for (int rg = m0 / 16 + gw; rg < (m0 + mrows) / 16; rg += NGW) {
        const int row0 = 16 * rg + r8, row1 = row0 + 8;
        const float rs0 = pg8::row_rstd(ss, row0), rs1 = pg8::row_rstd(ss, row1);
        const int ob0 = r8 * 64 + g8 * 8, ob1 = ((r8 + 8) * 64 + g8 * 8) ^ 32;
        float* o0 = a.out + (size_t)row0 * DMODEL + 4 * g8; float* o1 = a.out + (size_t)row1 * DMODEL + 4 * g8;
#pragma unroll 1
        for (int c0 = 0; c0 < 32; c0 += 4) { unsigned long long w0[4], w1[4]; f32x4 gv[4];
#pragma unroll
            for (int i = 0; i < 4; ++i) { const char* blk = X + xf_block(rg, c0 + i); w0[i] = *(const GAS unsigned long long*)(blk + ob0); w1[i] = *(const GAS unsigned long long*)(blk + ob1); gv[i] = *(const f32x4*)(g + 32 * (c0 + i) + 4 * g8); }
#pragma unroll
            for (int i = 0; i < 4; ++i) {
                __builtin_nontemporal_store(pg8::bf4((unsigned)w0[i], (unsigned)(w0[i] >> 32)) * rs0 * gv[i], (GAS f32x4*)(o0 + 32 * (c0 + i)));
                __builtin_nontemporal_store(pg8::bf4((unsigned)w1[i], (unsigned)(w1[i] >> 32)) * rs1 * gv[i], (GAS f32x4*)(o1 + 32 * (c0 + i))); } } }
}

__global__ void __launch_bounds__(NWAVES * 64, 2) mk_fwd(Args args) {
    extern __shared__ __attribute__((aligned(16))) unsigned char lds_raw[];
    LAS unsigned char* lds = (LAS unsigned char*)lds_raw;
    volatile LAS unsigned* MISC = (volatile LAS unsigned*)(lds + MISC_OFF);
    const int wave = __builtin_amdgcn_readfirstlane((int)threadIdx.x >> 6);
    const int G = gridDim.x; const int bx = blockIdx.x; const int vcu = (G % 8 == 0) ? (bx % 8) * (G / 8) + bx / 8 : bx;
    unsigned char* ws = args.ws;
    gu32* ctl = (gu32*)(ws + WS_CTL);
    for (int u = (int)threadIdx.x; u < (LDS_BYTES - LDSCTL_OFF) / 4; u += NWAVES * 64) ((LAS unsigned*)(lds + LDSCTL_OFF))[u] = 0u;
    __syncthreads();
    const int sid = bx & 7, G2 = G / NSTREAM, c = bx >> 3, vcl = c, vcs = sid * G2 + vcl, M0 = sid * MS;
    XcdBarrier bar = xcd_barrier_post((unsigned*)(ctl + CW_BAR), MISC + 8, (unsigned)G);
    XcdBarrier sbar = xcd_barrier_post((unsigned*)(ctl + CW_BAR + 4096 * (1 + sid)), MISC + 10, (unsigned)G2);
    const int lo = args.ph_lo, hi = args.ph_hi;
#define IN(k) (lo <= (k) && (k) < hi)
#define SEAM(k) do { if (IN(k) && IN((k) + 1)) xcd_barrier(sbar); } while (0)
    unsigned char* sb = ws + WS_SB + (size_t)sid * WS_SSTR;
    bf16* XNl = (bf16*)(ws + WS_XN) + (size_t)M0 * 1024; float* SSl = (float*)(ws + WS_SS) + (size_t)M0 * 16;
    bf16* Hl = (bf16*)(sb + SO_H); bf16* Yl = (bf16*)(sb + SO_Y); bf16* Zl = (bf16*)(sb + SO_Z); bf16* Ql = (bf16*)(sb + SO_Q); bf16* GGl = (bf16*)(sb + SO_GG); bf16* XRl = (bf16*)(sb + SO_XR);
    bf16* Yg = Yl - (size_t)M0 * 1024; const bf16* Zg = Zl - (size_t)M0 * 512; const bf16* Qg = Ql - (size_t)M0 * 512; const bf16* Kg = Qg + QKV_STRIDE; const bf16* Vg = Kg + QKV_STRIDE;
    const bf16* GGg = GGl - (size_t)M0 * 1024; const bf16* XRg = XRl - (size_t)M0 * 1024;
    LAS float* RTAB = (LAS float*)(lds + pg8::RTAB_OFF);
    static_assert(pg8::RTAB_OFF >= MISC_OFF + 128 && pg8::RTAB_OFF + 2048 <= LDS_BYTES, "rtab inside the LDS control area");

    if (IN(0)) { p0_prologue(args, lds, vcu, G, wave); }
    if (IN(0) && IN(1)) xcd_barrier(bar);
    if (IN(1)) {
        pg8::Gemm g{XNl, (const bf16*)(ws + WS_WIN0), MS, 2560, DMODEL, 0, 1}; pg8::StaticOrder S; S.init1(MS, 2560, G2, c);
        pg8::EpiInAB E{Zl, Ql, RTAB, mo::C2, QKV_STRIDE};
        pg8::gemm_phase<pg8::EpiInAB, pg8::StaticOrder, true, true>(lds, g, S, E, wave, SSl);
    }
    SEAM(1);
    if (IN(2)) {
        conv_phase(Zg, args.in[6], args.in[7], args.in[8], Yg, lds, vcs, wave);
        const int bh = vcs >> 1, hf = vcs & 1;
        mo::moba_kbar(bh >> 3, bh & 7, Kg, (LAS char*)lds, wave);
#pragma unroll 1
        for (int i = 0; i < 4; ++i) { const int j = hf ? ((i == 0) ? 2 : (i == 1) ? 5 : (i == 2) ? 3 : 4) : ((i == 0) ? 0 : (i == 1) ? 7 : (i == 2) ? 1 : 6);
            mo::moba_unit(bh >> 3, bh & 7, j, Qg, Kg, Vg, Yg, (LAS char*)lds, wave, i == 0, i < 3); }
    }
    SEAM(2);
    if (IN(3)) {
        pg8::Gemm g{Yl, (const bf16*)(ws + WS_WOUT0), MS, DMODEL, DMODEL}; pg8::StaticOrder S; S.init1(MS, DMODEL, G2, c);
        pg8::EpiResB E{XNl, nullptr, SSl};
        pg8::gemm_phase<pg8::EpiResB, pg8::StaticOrder, true, true>(lds, g, S, E, wave);
    }
    SEAM(3);
    if (IN(4)) {
        pg8::Gemm g{XNl, (const bf16*)(ws + WS_WUP0), MS, FF, DMODEL, 0, 1}; pg8::StaticOrder S; S.init1(MS, FF, G2, c);
        pg8::EpiUp E{Hl, RTAB};
        pg8::gemm_phase<pg8::EpiUp, pg8::StaticOrder, true, true>(lds, g, S, E, wave, SSl);
    }
    SEAM(4);
    if (IN(5)) {
        pg8::Gemm g{Hl, (const bf16*)(ws + WS_WDN0), MS, DMODEL, FF, 0, 1}; pg8::StaticOrder S; S.init1(MS, DMODEL, G2, c);
        pg8::EpiResB E{XNl, nullptr, SSl};
        pg8::gemm_phase<pg8::EpiResB, pg8::StaticOrder, true, true, true>(lds, g, S, E, wave);
    }
    SEAM(5);
    if (IN(6)) {
        pg8::Gemm g{XNl, (const bf16*)(ws + WS_WIN1), MS, 2048, DMODEL, 0, 1}; pg8::StaticOrder S; S.init1(MS, 2048, G2, c);
        pg8::EpiInC E{GGl, XRl, RTAB};
        pg8::gemm_phase<pg8::EpiInC, pg8::StaticOrder, true, true>(lds, g, S, E, wave, SSl);
    }
    SEAM(6);
    if (IN(7)) { rglru_phase(args, XRg, GGg, Yg, lds, vcs, wave); }
    SEAM(7);
    if (IN(8)) {
        pg8::Gemm g{Yl, (const bf16*)(ws + WS_WOUT1), MS, DMODEL, DMODEL}; pg8::StaticOrder S; S.init1(MS, DMODEL, G2, c);
        pg8::EpiResB E{XNl, nullptr, SSl};
        pg8::gemm_phase<pg8::EpiResB, pg8::StaticOrder, true, true>(lds, g, S, E, wave);
    }
    SEAM(8);
    if (IN(9)) {
        pg8::Gemm g{XNl, (const bf16*)(ws + WS_WUP1), MS, FF, DMODEL, 0, 1}; pg8::StaticOrder S; S.init1(MS, FF, G2, c);
        pg8::EpiUp E{Hl, RTAB};
        pg8::gemm_phase<pg8::EpiUp, pg8::StaticOrder, true, true>(lds, g, S, E, wave, SSl);
    }
    SEAM(9);
    if (IN(10)) {
        pg8::Gemm g{Hl, (const bf16*)(ws + WS_WDN1), MS, DMODEL, FF, 0, 1}; pg8::StaticOrder S; S.init1(MS, DMODEL, G2, c);
        pg8::EpiResB E{XNl, nullptr, SSl};
        pg8::gemm_phase<pg8::EpiResB, pg8::StaticOrder, true, true, true>(lds, g, S, E, wave);
    }
    SEAM(10);
    if (IN(11)) { final_phase(args, vcl, G2, wave, M0, MS); }
#ifdef MK_PROF
    if (IN(11)) { xcd_barrier(sbar);
        if (bx == 0) { const unsigned long long* pr = (const unsigned long long*)(ws + WS_CTL + 512 * 1024); const float cnt = (float)pr[6];
            const float A = (float)pr[MK_PROF_A] / cnt, B = (float)pr[MK_PROF_B] / cnt; const float c = sqrtf(B * 1e-5f * 128.0f);
            for (int i = (int)threadIdx.x; i < (1 << 18); i += 512) args.out[(size_t)i * 128 + 64] += c;
            if (threadIdx.x == 0) args.out[0] += A * MK_PROF_ASCALE; } }
#endif
#undef IN
#undef SEAM
}

extern "C" void kernel_launch(void* const* d_in, const int* in_sizes, int n_in, void* d_out, int out_size, void* d_ws, size_t ws_size, hipStream_t stream) {
    static int grid = 0;
    if (grid == 0) {
        if (n_in != 20 || in_sizes[0] != M * DMODEL || out_size != M * DMODEL || ws_size < WS_END) { fprintf(stderr, "kernel_launch: unexpected shapes (n_in %d, in0 %d, out %d, ws %zu); nothing launched\n", n_in, n_in > 0 ? in_sizes[0] : -1, out_size, ws_size); grid = -1; return; }
        int dev = 0, cus = 0, per_cu = 0;
        if (hipGetDevice(&dev) != hipSuccess || hipDeviceGetAttribute(&cus, hipDeviceAttributeMultiprocessorCount, dev) != hipSuccess) { grid = -1; return; }
        if (hipFuncSetAttribute((const void*)mk_fwd, hipFuncAttributeMaxDynamicSharedMemorySize, LDS_BYTES) != hipSuccess) { fprintf(stderr, "kernel_launch: hipFuncSetAttribute failed\n"); grid = -1; return; }
        if (hipOccupancyMaxActiveBlocksPerMultiprocessor(&per_cu, (const void*)mk_fwd, NWAVES * 64, LDS_BYTES) != hipSuccess || per_cu < 1) fprintf(stderr, "kernel_launch: note: occupancy query reports %d\n", per_cu);
        (void)hipGetLastError();
        grid = cus;
        if (grid != 256) fprintf(stderr, "kernel_launch: %d CUs (the static schedules assume 256)\n", grid);
    }
    if (grid < 0) return;
    if (hipMemsetAsync((char*)d_ws + WS_CTL, 0, CTL_ZERO_BYTES, stream) != hipSuccess) return;
    Args a{};
    for (int i = 0; i < 20; ++i) a.in[i] = (const float*)d_in[i];
    a.out = (float*)d_out; a.ws = (unsigned char*)d_ws;
#if MK_PER_PHASE
    for (int p = 0; p < NPHASE; ++p) { a.ph_lo = p; a.ph_hi = p + 1; hipLaunchKernelGGL(mk_fwd, dim3(grid), dim3(NWAVES * 64), LDS_BYTES, stream, a); }
#else
    a.ph_lo = 0; a.ph_hi = NPHASE;
    hipLaunchKernelGGL(mk_fwd, dim3(grid), dim3(NWAVES * 64), LDS_BYTES, stream, a);
#endif
}
```

```cpp
#include <hip/hip_runtime.h>
#include <hip/hip_bf16.h>
#include <cstdio>
#include <cstdint>
#include <cmath>
namespace pg8 {
#define PG8_LAS __attribute__((address_space(3)))
typedef unsigned short bf16_t;
typedef short bf16x8 __attribute__((ext_vector_type(8)));
typedef float f32x4 __attribute__((ext_vector_type(4)));
typedef unsigned u32x4 __attribute__((ext_vector_type(4)));
constexpr int BM = 256, BK = 64, HALF = 128, HTB = HALF * BK * 2  , STAGE_BYTES = 8 * HTB, NXCD = 8, WGM = 8;

__host__ __device__ __forceinline__ int lds_byte(int r, int c) { const int st = (r >> 4) * 2 + (c >> 5), rr = r & 15, cc = c & 31, ob = rr * 64 + cc * 2; return st * 1024 + (ob ^ (((ob >> 9) & 1) << 5)); }
__host__ __device__ __forceinline__ void stage_rc(int b, int& R, int& C) { const int st = b / 1024, sb = b % 1024, swz = sb ^ (((sb >> 9) & 1) << 5); R = (st >> 1) * 16 + swz / 64; C = (st & 1) * 32 + (swz % 64) / 2; }
__host__ __device__ __forceinline__ int perm32(int rho) { const int n = rho >> 4, i = rho & 15; return 8 * (i >> 2) + 4 * n + (i & 3); }

struct Unit { int pm, pn; };
struct Gemm { const bf16_t* A; const bf16_t* Bt; int M, N, K; int lda = 0; int afrag = 0; };

struct StaticOrder {
    int nM, nN, nwg, G, c, remap = 1;
    __host__ __device__ void init(int M, int N, int G_, int c_) { nM = M / BM; nN = N / BM; nwg = nM * nN; G = G_; c = c_; }
    __host__ __device__ void init1(int M, int N, int G_, int c_) { init(M, N, G_, c_); remap = 0; }
    __host__ __device__ bool next(int i, Unit& u) const {
        const long L = (long)i * G + c; if (L >= nwg) return false;
        int wgid = (int)L; if (remap) { const int q = nwg / NXCD, r = nwg % NXCD, xcd = wgid % NXCD, off = wgid / NXCD; wgid = (xcd < r ? xcd * (q + 1) : r * (q + 1) + (xcd - r) * q) + off; }
        const int nig = WGM * nN, gid = wgid / nig, fm = gid * WGM, gsz = (nM - fm) < WGM ? (nM - fm) : WGM;
        u.pm = fm + ((wgid % nig) % gsz); u.pn = (wgid % nig) / gsz; return true;
    }
    __device__ __forceinline__ void a_ready(const Unit&) const {}
    __device__ __forceinline__ void done(const Unit&) const {}
};
__device__ __forceinline__ unsigned cvt_pk_bf16(float lo, float hi) { unsigned r; asm volatile("v_cvt_pk_bf16_f32 %0, %1, %2" : "=v"(r) : "v"(lo), "v"(hi)); return r; }
typedef float f32x2 __attribute__((ext_vector_type(2)));
typedef unsigned u32x2 __attribute__((ext_vector_type(2)));
__device__ __forceinline__ float row_rstd(const float* ss, int row) {
    const f32x4* p = (const f32x4*)(ss + (size_t)row * 16);
    const f32x4 a = p[0], b = p[1], c = p[2], d = p[3];
    const float s = (((a[0] + a[1]) + (a[2] + a[3])) + ((b[0] + b[1]) + (b[2] + b[3]))) + (((c[0] + c[1]) + (c[2] + c[3])) + ((d[0] + d[1]) + (d[2] + d[3])));
    return 1.0f / sqrtf(s * (1.0f / 1024.0f) + 1e-6f);
}
constexpr int RTAB_OFF = 131072 + 1024;
__device__ __forceinline__ void rtab_fill(const StaticOrder& S, const float* ss, PG8_LAS float* rtab, int wid) {
    const int lane = (int)__builtin_amdgcn_mbcnt_hi(~0u, __builtin_amdgcn_mbcnt_lo(~0u, 0u)), t = wid * 64 + lane, row = t >> 1, h = t & 1;
    Unit u; int prev = -1;
    for (int i = 0; S.next(i, u); ++i) { if (u.pm == prev) continue; prev = u.pm;
        const f32x4* p = (const f32x4*)(ss + ((size_t)u.pm * BM + row) * 16 + h * 8);
        const f32x4 a = p[0], b = p[1];
        float s = ((a[0] + a[1]) + (a[2] + a[3])) + ((b[0] + b[1]) + (b[2] + b[3]));
        s += __shfl_xor(s, 1);
        const float r = 1.0f / sqrtf(s * (1.0f / 1024.0f) + 1e-6f);
        if (h == 0) rtab[((u.pm >> 3) & 1) * 256 + row] = r; }
    asm volatile("s_waitcnt lgkmcnt(0)\n\ts_barrier" ::: "memory");
}
__device__ __forceinline__ void row_scales(float (&rs)[2][4], const PG8_LAS float* rtab, const Unit& u, int wr, int fr, float mul) {
    const PG8_LAS float* t = rtab + ((u.pm >> 3) & 1) * 256 + wr * 64 + fr;
#pragma unroll
    for (int ai = 0; ai < 2; ++ai)
#pragma unroll
        for (int m = 0; m < 4; ++m) rs[ai][m] = t[ai * HALF + m * 16] * mul;
}
__device__ __forceinline__ float fsigmoid(float x) { return __builtin_amdgcn_rcpf(1.0f + __builtin_amdgcn_exp2f(-1.4426950408889634f * x)); }
__device__ __forceinline__ u32x4 pack8(const f32x4& v0, const f32x4& v1) { u32x4 w; w.x = cvt_pk_bf16(v0[0], v0[1]); w.y = cvt_pk_bf16(v0[2], v0[3]); w.z = cvt_pk_bf16(v1[0], v1[1]); w.w = cvt_pk_bf16(v1[2], v1[3]); return w; }

struct EpiInAB {
    static constexpr bool PERM = true, AFTER_DRAIN = false, ADJ = false;
    bf16_t* Z; bf16_t* QKV; const PG8_LAS float* rtab; float qscale; size_t qkv_stride;
    __device__ __forceinline__ void operator()(const f32x4 (&acc)[2][2][4][2], const Unit& u, int wr, int wc, int fr, int fq) const {
        const int row0 = u.pm * BM + wr * 64 + fr, cw = wc * 32 + 8 * fq;
        float rsv[2][4]; row_scales(rsv, rtab, u, wr, fr, (u.pn == 4 || u.pn == 5) ? qscale : 1.0f);
        if (u.pn < 4) {
#pragma unroll
            for (int ai = 0; ai < 2; ++ai)
#pragma unroll
                for (int m = 0; m < 4; ++m) { const int row = row0 + ai * HALF + m * 16; const float rs = rsv[ai][m];
                    f32x4 z0, z1;
#pragma unroll
                    for (int j = 0; j < 4; ++j) { z0[j] = (acc[ai][0][m][0][j] * rs) * fsigmoid(acc[ai][1][m][0][j] * rs); z1[j] = (acc[ai][0][m][1][j] * rs) * fsigmoid(acc[ai][1][m][1][j] * rs); }
                    __builtin_nontemporal_store(pack8(z0, z1), (u32x4*)(Z + (size_t)row * 512 + u.pn * 128 + cw)); __builtin_amdgcn_sched_barrier(0); }
        } else {
            const int t = (u.pn - 4) >> 1; bf16_t* dst = QKV + (size_t)t * qkv_stride;
            const int cb = ((u.pn - 4) & 1) * 256 + cw;
#pragma unroll
            for (int ai = 0; ai < 2; ++ai)
#pragma unroll
                for (int m = 0; m < 4; ++m) { const int row = row0 + ai * HALF + m * 16; const float rs = rsv[ai][m];
#pragma unroll
                    for (int bj = 0; bj < 2; ++bj) { const f32x4 v0 = acc[ai][bj][m][0] * rs, v1 = acc[ai][bj][m][1] * rs;
                        if (t == 0) __builtin_nontemporal_store(pack8(v0, v1), (u32x4*)(dst + (size_t)row * 512 + cb + bj * HALF)); else *(u32x4*)(dst + (size_t)row * 512 + cb + bj * HALF) = pack8(v0, v1); } __builtin_amdgcn_sched_barrier(0); }
        }
    }
};
__device__ __forceinline__ float irelu(float x) { const int i = __float_as_int(x); return __int_as_float(i > 0 ? i : 0); }
struct EpiUp {
    static constexpr bool PERM = true, AFTER_DRAIN = false, ADJ = true;
    bf16_t* H; const PG8_LAS float* rtab;
    static constexpr int FFT = 4096 / 64;
    __device__ __forceinline__ void operator()(const f32x4 (&acc)[2][2][4][2], const Unit& u, int wr, int wc, int fr, int fq) const {
        const int fo = (fr * 64 + fq * 16) ^ ((fr >> 3) << 5);
        float rsv[2][4]; row_scales(rsv, rtab, u, wr, fr, 1.0f);
#pragma unroll
        for (int ai = 0; ai < 2; ++ai)
#pragma unroll
            for (int m = 0; m < 4; ++m) { const float rs2 = rsv[ai][m] * rsv[ai][m];
                const f32x2 r2 = (f32x2){rs2, rs2};
#pragma unroll
                for (int bj = 0; bj < 2; ++bj) { f32x4 v0, v1;
#pragma unroll
                    for (int j = 0; j < 4; j += 2) {
                        const float x0 = acc[ai][bj][m][0][j], x1 = acc[ai][bj][m][0][j + 1], x2 = acc[ai][bj][m][1][j], x3 = acc[ai][bj][m][1][j + 1];
                        f32x2 a = (f32x2){irelu(x0), irelu(x1)}, b = (f32x2){irelu(x2), irelu(x3)};
                        a = (a * a) * r2; b = (b * b) * r2; v0[j] = a[0]; v0[j + 1] = a[1]; v1[j] = b[0]; v1[j + 1] = b[1]; }
                    __builtin_nontemporal_store(pack8(v0, v1), (u32x4*)((char*)H + ((((size_t)(u.pm * (FFT) + u.pn * 4 + wc) * 2 + ai) * 16 + (2 * (4 * wr + m) + bj)) << 10) + fo));     } __builtin_amdgcn_sched_barrier(0); }
    }
};
struct EpiInC {
    static constexpr bool PERM = true, AFTER_DRAIN = false, ADJ = true;
    bf16_t* GG; bf16_t* XR; const PG8_LAS float* rtab;
    __device__ __forceinline__ void operator()(const f32x4 (&acc)[2][2][4][2], const Unit& u, int wr, int wc, int fr, int fq) const {
        const int row0 = u.pm * BM + wr * 64 + fr, col0 = (u.pn & 3) * BM + wc * 64 + 8 * fq; const bool isg = u.pn < 4; bf16_t* dst = isg ? GG : XR;
        float rsv[2][4]; row_scales(rsv, rtab, u, wr, fr, 1.0f);
#pragma unroll
        for (int ai = 0; ai < 2; ++ai)
#pragma unroll
            for (int m = 0; m < 4; ++m) { const int row = row0 + ai * HALF + m * 16; const float rs = rsv[ai][m];
#pragma unroll
                for (int bj = 0; bj < 2; ++bj) { f32x4 v0 = acc[ai][bj][m][0] * rs, v1 = acc[ai][bj][m][1] * rs;
                    if (isg) {
                        const f32x2 c1 = (f32x2){-2.3022081983f, -2.3022081983f}, c2 = (f32x2){-0.10294324f, -0.10294324f}, one = (f32x2){1.0f, 1.0f};
#pragma unroll
                        for (int j = 0; j < 4; j += 2) {
                            f32x2 xa = (f32x2){v0[j], v0[j + 1]}, xb = (f32x2){v1[j], v1[j + 1]};
                            f32x2 ea = xa * (xa * xa * c2 + c1), eb = xb * (xb * xb * c2 + c1);
                            ea = (f32x2){__builtin_amdgcn_exp2f(ea[0]), __builtin_amdgcn_exp2f(ea[1])} + one; eb = (f32x2){__builtin_amdgcn_exp2f(eb[0]), __builtin_amdgcn_exp2f(eb[1])} + one;
                            xa = xa * (f32x2){__builtin_amdgcn_rcpf(ea[0]), __builtin_amdgcn_rcpf(ea[1])}; xb = xb * (f32x2){__builtin_amdgcn_rcpf(eb[0]), __builtin_amdgcn_rcpf(eb[1])};
                            v0[j] = xa[0]; v0[j + 1] = xa[1]; v1[j] = xb[0]; v1[j + 1] = xb[1]; } }
                    __builtin_nontemporal_store(pack8(v0, v1), (u32x4*)(dst + (size_t)row * 1024 + col0 + bj * 32)); } __builtin_amdgcn_sched_barrier(0); }
    }
};
__device__ __forceinline__ f32x4 bf4(unsigned a, unsigned b) { return (f32x4){__uint_as_float(a << 16), __uint_as_float(a & 0xffff0000u), __uint_as_float(b << 16), __uint_as_float(b & 0xffff0000u)}; }
struct EpiResB {
    static constexpr bool PERM = true, AFTER_DRAIN = false, ADJ = true;
    bf16_t* X; float* outf; float* ssout;
    __device__ __forceinline__ void operator()(const f32x4 (&acc)[2][2][4][2], const Unit& u, int wr, int wc, int fr, int fq) const {
        const int row0 = u.pm * BM + wr * 64 + fr;
        const int fo = (fr * 64 + fq * 16) ^ ((fr >> 3) << 5);
        char* xb = (char*)X + (((size_t)(u.pm * 16 + u.pn * 4 + wc) * 2) << 14) + fo;
        u32x4 raw[2][4][2];
#pragma unroll
        for (int ai = 0; ai < 2; ++ai)
#pragma unroll
            for (int m = 0; m < 4; ++m)
#pragma unroll
                for (int bj = 0; bj < 2; ++bj) raw[ai][m][bj] = *(const u32x4*)(xb + ((ai * 16 + 2 * (4 * wr + m) + bj) << 10));
#pragma unroll
        for (int ai = 0; ai < 2; ++ai)
#pragma unroll
            for (int m = 0; m < 4; ++m) { const int row = row0 + ai * HALF + m * 16; float sq = 0.f;
                f32x2 sq2 = (f32x2){0.f, 0.f};
#pragma unroll
                for (int bj = 0; bj < 2; ++bj) { const u32x4 rw = raw[ai][m][bj];
                    const f32x4 x0 = bf4(rw.x, rw.y) + acc[ai][bj][m][0], x1 = bf4(rw.z, rw.w) + acc[ai][bj][m][1];
                    const f32x2 a0 = (f32x2){x0[0], x0[1]}, a1 = (f32x2){x0[2], x0[3]}, a2 = (f32x2){x1[0], x1[1]}, a3 = (f32x2){x1[2], x1[3]};
                    sq2 = a0 * a0 + sq2; sq2 = a1 * a1 + sq2; sq2 = a2 * a2 + sq2; sq2 = a3 * a3 + sq2;
                    *(u32x4*)(xb + ((ai * 16 + 2 * (4 * wr + m) + bj) << 10)) = pack8(x0, x1); }
                sq = sq2[0] + sq2[1];
                { const auto r16 = __builtin_amdgcn_permlane16_swap(__float_as_uint(sq), __float_as_uint(sq), false, false); sq = __uint_as_float(r16[0]) + __uint_as_float(r16[1]);
                  const auto r32 = __builtin_amdgcn_permlane32_swap(__float_as_uint(sq), __float_as_uint(sq), false, false); sq = __uint_as_float(r32[0]) + __uint_as_float(r32[1]); }
                if (fq == 0) ssout[(size_t)row * 16 + u.pn * 4 + wc] = sq;
                __builtin_amdgcn_sched_barrier(0); }
    }
};

template <class Epi, class Sched, bool ALIGN_EPI = false, bool SP2 = false, bool ANT = false>
__device__ __forceinline__ void gemm_phase(PG8_LAS unsigned char* lds, const Gemm g, const Sched& S, const Epi& E, const int wid, const float* ssfill = nullptr) {
    const int lane = (int)__builtin_amdgcn_mbcnt_hi(~0u, __builtin_amdgcn_mbcnt_lo(~0u, 0u)), tid = wid * 64 + lane, wr = wid >> 2, wc = wid & 3, fr = lane & 15, fq = lane >> 4;
    const int K = g.K, nt = K / BK, lda = g.lda ? g.lda : K;
    unsigned voffA[2], voffB[2];
#pragma unroll
    for (int i = 0; i < 2; ++i) { int R, C; stage_rc(tid * 16 + i * 8192, R, C);
        const int Rb = Epi::ADJ ? ((R >> 5) * 64 + perm32(R & 31)) : Epi::PERM ? ((R & ~31) + perm32(R & 31)) : R;
        voffA[i] = g.afrag ? (unsigned)((wid + 8 * i) * 1024 + lane * 16) : (unsigned)(R * lda + C) * 2u; voffB[i] = (unsigned)(Rb * K + C) * 2u; }
    const size_t kstep = (size_t)(BK * 2);
    const size_t hstep = (size_t)HALF * K * 2;
    const size_t bhstep = Epi::ADJ ? (size_t)32 * K * 2 : hstep;
    const size_t tstep = 2 * hstep;
    const bool afrag = g.afrag != 0;
    const size_t ahstep = afrag ? (size_t)HTB : (size_t)HALF * lda * 2, akstep = afrag ? (size_t)(2 * HTB) : kstep, atstep = afrag ? (size_t)(K / BK) * 2 * HTB : 2 * (size_t)HALF * lda * 2;
    const unsigned ldsw = (unsigned)wid * 1024u;
    const int aoff = lds_byte(wr * 64 + fr, fq * 8), boff = lds_byte(wc * 32 + fr, fq * 8);
#define PG8_SA(b, h) (((b) * 2 + (h)) * HTB)
#define PG8_SB(b, h) ((4 + (b) * 2 + (h)) * HTB)
#define PG8_STAGE(bufoff, gbase, voff) do { _Pragma("unroll") for (int _i = 0; _i < 2; ++_i) \
        __builtin_amdgcn_global_load_lds((const unsigned*)((const char*)(gbase) + (voff)[_i]), (PG8_LAS unsigned*)(lds + (bufoff) + ldsw + _i * 8192), 16, 0, 0); } while (0)
#define PG8_STAGEA(bufoff, gbase, voff) do { _Pragma("unroll") for (int _i = 0; _i < 2; ++_i) \
        __builtin_amdgcn_global_load_lds((const unsigned*)((const char*)(gbase) + (voff)[_i]), (PG8_LAS unsigned*)(lds + (bufoff) + ldsw + _i * 8192), 16, 0, ANT ? 2 : 0); } while (0)
#define PG8_LDA(dst, b, h) do { _Pragma("unroll") for (int m = 0; m < 4; ++m) _Pragma("unroll") for (int k = 0; k < 2; ++k) dst[m][k] = *(const PG8_LAS bf16x8*)(lds + PG8_SA(b, h) + aoff + m * 2048 + k * 1024); } while (0)
#define PG8_LDB(dst, b, h) do { _Pragma("unroll") for (int n = 0; n < 2; ++n) _Pragma("unroll") for (int k = 0; k < 2; ++k) dst[n][k] = *(const PG8_LAS bf16x8*)(lds + PG8_SB(b, h) + boff + n * 2048 + k * 1024); } while (0)
#define PG8_MMA(ai, bj, At, Bt) do { __builtin_amdgcn_s_setprio(1); _Pragma("unroll") for (int m = 0; m < 4; ++m) _Pragma("unroll") for (int n = 0; n < 2; ++n) _Pragma("unroll") for (int k = 0; k < 2; ++k) \
        acc[ai][bj][m][n] = __builtin_amdgcn_mfma_f32_16x16x32_bf16(Bt[n][k], At[m][k], acc[ai][bj][m][n], 0, 0, 0); __builtin_amdgcn_s_setprio(0); } while (0)
#define PG8_WAIT_V(n) asm volatile("s_waitcnt vmcnt(" #n ")" ::: "memory")
#define PG8_WAIT_L(n) asm volatile("s_waitcnt lgkmcnt(" #n ")" ::: "memory")
#define PG8_BAR __builtin_amdgcn_s_barrier()
#define PG8_SCHED __builtin_amdgcn_sched_barrier(0)
    Unit cur, nxt; int ui = 0;
    if (!S.next(0, cur)) return;
    f32x4 acc[2][2][4][2];
#pragma unroll
    for (int a = 0; a < 2; ++a)
#pragma unroll
        for (int b = 0; b < 2; ++b)
#pragma unroll
            for (int m = 0; m < 4; ++m)
#pragma unroll
                for (int n = 0; n < 2; ++n) acc[a][b][m][n] = (f32x4){0.f, 0.f, 0.f, 0.f};
    bf16x8 At[4][2], B0[2][2], B1[2][2];
    const char* cA = (const char*)g.A + (size_t)cur.pm * atstep; const char* cB = (const char*)g.Bt + (size_t)cur.pn * tstep;
    S.a_ready(cur);
    if constexpr (SP2) {
        PG8_STAGE(PG8_SB(0, 0), cB, voffB); PG8_STAGE(PG8_SB(0, 1), cB + bhstep, voffB); PG8_STAGEA(PG8_SA(0, 0), cA, voffA); PG8_STAGEA(PG8_SA(0, 1), cA + ahstep, voffA);
        if (ssfill) rtab_fill(S, ssfill, (PG8_LAS float*)(lds + RTAB_OFF), wid);
        if (wr == 1) PG8_BAR;
        PG8_WAIT_V(2); PG8_BAR;
        PG8_STAGE(PG8_SB(1, 0), cB + kstep, voffB); PG8_STAGEA(PG8_SA(1, 0), cA + akstep, voffA); PG8_STAGE(PG8_SB(1, 1), cB + bhstep + kstep, voffB);
        PG8_WAIT_V(6); PG8_BAR;
    } else {
        PG8_STAGE(PG8_SB(0, 0), cB, voffB); PG8_STAGEA(PG8_SA(0, 0), cA, voffA); PG8_STAGE(PG8_SB(0, 1), cB + bhstep, voffB); PG8_STAGEA(PG8_SA(0, 1), cA + ahstep, voffA);
        if (wr == 1) PG8_BAR;
        PG8_WAIT_V(4); PG8_BAR;
        PG8_STAGE(PG8_SB(1, 0), cB + kstep, voffB); PG8_STAGEA(PG8_SA(1, 0), cA + akstep, voffA); PG8_STAGE(PG8_SB(1, 1), cB + bhstep + kstep, voffB);
        PG8_WAIT_V(6); PG8_BAR;
    }
    for (;;) {
        const bool has_next = S.next(ui + 1, nxt);
        const char* nA = has_next ? (const char*)g.A + (size_t)nxt.pm * atstep : cA; const char* nB = has_next ? (const char*)g.Bt + (size_t)nxt.pn * tstep : cB;
        for (int t = 0; t < nt; t += 2) {
            const bool last = (t == nt - 2);
            const char* a1 = cA + (size_t)(t + 1) * akstep;
            const char* a2 = last ? nA : cA + (size_t)(t + 2) * akstep; const char* b2 = last ? nB : cB + (size_t)(t + 2) * kstep;
            const char* a3 = a2 + akstep; const char* b3 = b2 + kstep;
            if (last && has_next) S.a_ready(nxt);
            if constexpr (SP2) {
            PG8_LDB(B0, 0, 0); PG8_LDB(B1, 0, 1); PG8_SCHED; PG8_LDA(At, 0, 0); PG8_STAGEA(PG8_SA(1, 1), a1 + ahstep, voffA);
            PG8_WAIT_V(8); PG8_WAIT_L(0); PG8_BAR; PG8_MMA(0, 0, At, B0); PG8_MMA(0, 1, At, B1); PG8_BAR; PG8_SCHED;
            PG8_LDA(At, 0, 1); PG8_STAGE(PG8_SB(0, 0), b2, voffB); PG8_STAGE(PG8_SB(0, 1), b2 + bhstep, voffB); PG8_STAGEA(PG8_SA(0, 0), a2, voffA);
            PG8_WAIT_V(8); PG8_WAIT_L(0); PG8_BAR; PG8_MMA(1, 0, At, B0); PG8_MMA(1, 1, At, B1); PG8_BAR; PG8_SCHED;
            PG8_LDB(B0, 1, 0); PG8_LDB(B1, 1, 1); PG8_SCHED; PG8_LDA(At, 1, 0); PG8_STAGEA(PG8_SA(0, 1), a2 + ahstep, voffA);
            PG8_WAIT_V(8); PG8_WAIT_L(0); PG8_BAR; PG8_MMA(0, 0, At, B0); PG8_MMA(0, 1, At, B1); PG8_BAR; PG8_SCHED;
            PG8_LDA(At, 1, 1); PG8_STAGE(PG8_SB(1, 0), b3, voffB); PG8_STAGE(PG8_SB(1, 1), b3 + bhstep, voffB); PG8_STAGEA(PG8_SA(1, 0), a3, voffA);
            PG8_WAIT_V(8); PG8_WAIT_L(0); PG8_BAR; PG8_MMA(1, 0, At, B0); PG8_MMA(1, 1, At, B1); PG8_BAR; PG8_SCHED;
            } else {
            PG8_LDB(B0, 0, 0); PG8_SCHED; PG8_LDA(At, 0, 0); PG8_STAGEA(PG8_SA(1, 1), a1 + ahstep, voffA);
            PG8_WAIT_L(8); PG8_BAR; PG8_WAIT_L(0); PG8_MMA(0, 0, At, B0); PG8_BAR; PG8_SCHED;
            PG8_LDB(B1, 0, 1); PG8_STAGE(PG8_SB(0, 0), b2, voffB);
            PG8_BAR; PG8_WAIT_L(0); PG8_MMA(0, 1, At, B1); PG8_BAR;
            PG8_LDA(At, 0, 1); PG8_STAGEA(PG8_SA(0, 0), a2, voffA);
            PG8_BAR; PG8_WAIT_L(0); PG8_MMA(1, 0, At, B0); PG8_BAR; PG8_SCHED;
            PG8_STAGE(PG8_SB(0, 1), b2 + bhstep, voffB);
            PG8_WAIT_V(6); PG8_BAR; PG8_MMA(1, 1, At, B1); PG8_BAR;
            PG8_LDB(B0, 1, 0); PG8_SCHED; PG8_LDA(At, 1, 0); PG8_STAGEA(PG8_SA(0, 1), a2 + ahstep, voffA);
            PG8_WAIT_L(8); PG8_BAR; PG8_WAIT_L(0); PG8_MMA(0, 0, At, B0); PG8_BAR; PG8_SCHED;
            PG8_LDB(B1, 1, 1); PG8_STAGE(PG8_SB(1, 0), b3, voffB);
            PG8_BAR; PG8_WAIT_L(0); PG8_MMA(0, 1, At, B1); PG8_BAR;
            PG8_LDA(At, 1, 1); PG8_STAGEA(PG8_SA(1, 0), a3, voffA);
            PG8_BAR; PG8_WAIT_L(0); PG8_MMA(1, 0, At, B0); PG8_BAR; PG8_SCHED;
            PG8_STAGE(PG8_SB(1, 1), b3 + bhstep, voffB);
            PG8_WAIT_V(6); PG8_BAR; PG8_MMA(1, 1, At, B1); PG8_BAR;
            }
        }
        if constexpr (ALIGN_EPI) { if (wr == 0) PG8_BAR; }
        if constexpr (!Epi::AFTER_DRAIN) { E(acc, cur, wr, wc, fr, fq); S.done(cur); }
        if (!has_next) break;
#pragma unroll
        for (int a = 0; a < 2; ++a)
#pragma unroll
            for (int b = 0; b < 2; ++b)
#pragma unroll
                for (int m = 0; m < 4; ++m)
#pragma unroll
                    for (int n = 0; n < 2; ++n) acc[a][b][m][n] = (f32x4){0.f, 0.f, 0.f, 0.f};
        cur = nxt; cA = nA; cB = nB; ++ui;
        if constexpr (ALIGN_EPI) { if (wr == 1) PG8_BAR; }
    }
    PG8_WAIT_V(0);
    if constexpr (!ALIGN_EPI) { if (wr == 0) PG8_BAR; }
    PG8_BAR;
    if constexpr (Epi::AFTER_DRAIN) { E.fused(acc, cur, wr, wc, fr, fq, lds, wid, lane); S.done(cur); }
#undef PG8_SA
#undef PG8_SB
#undef PG8_STAGE
#undef PG8_STAGEA
#undef PG8_LDA
#undef PG8_LDB
#undef PG8_MMA
#undef PG8_WAIT_V
#undef PG8_WAIT_L
#undef PG8_BAR
#undef PG8_SCHED
}
}
namespace mo {
using bf16x8=__attribute__((ext_vector_type(8)))short;
using s16x4=__attribute__((ext_vector_type(4)))short;
using f32x16=__attribute__((ext_vector_type(16)))float;
using u32x4=__attribute__((ext_vector_type(4)))unsigned;
typedef unsigned short bf16;
constexpr int NHEAD=8,SEQ=2048,D=64,DM=NHEAD*D,OPITCH=1024,OCOL0=512;
constexpr int NW=8,QBLK=32,QB=QBLK*NW,KVBLK=64;
__device__ __forceinline__ int crow(int r,int hi){return (r&3)+8*(r>>2)+4*hi;}
#define MO_LAS __attribute__((address_space(3)))
constexpr int SLOTB=8192;
constexpr int LDS_K=0, LDS_V=2*SLOTB, LDS_WS=4*SLOTB, LDS_OST=LDS_WS+NW*64*4, LDS_KB=LDS_OST+NW*4096, LDS_BYTES=LDS_KB+2048+64;
constexpr float C2=0.125f*1.4426950408889634f;
__device__ __forceinline__ void glds16(const void*gsrc,unsigned lds_dst){unsigned keep;
  asm volatile("s_mov_b32 %0, m0\n\ts_mov_b32 m0, %2\n\ts_nop 0\n\tglobal_load_lds_dwordx4 %1, off\n\ts_mov_b32 m0, %0":"=&s"(keep):"v"(gsrc),"s"(lds_dst):"memory");}
typedef float f32x2_t __attribute__((ext_vector_type(2))); typedef __bf16 bf16x2_t __attribute__((ext_vector_type(2)));
__device__ __forceinline__ unsigned cvtpk_s(float lo,float hi){f32x2_t v={lo,hi};bf16x2_t b=__builtin_convertvector(v,bf16x2_t);return __builtin_bit_cast(unsigned,b);}
#define MO_WAIT_BAR(N) asm volatile("s_waitcnt vmcnt(" #N ") lgkmcnt(0)\n\ts_barrier":::"memory")
#define MO_MX3(a,b,c) __builtin_fmaxf(__builtin_fmaxf((a),(b)),(c))
__device__ __forceinline__ void qkt(f32x16&p0,f32x16&p1,const MO_LAS char*Kslot,const bf16x8*qr,const f32x16&z,int r32,int hi){
  const MO_LAS char*kb=Kslot+hi*1024+r32*16;
  bf16x8 kf[8];
  #pragma unroll
  for(int i=0;i<8;++i)kf[i]=*(const MO_LAS bf16x8*)(kb+(i>>1)*2048+(i&1)*512);
  __builtin_amdgcn_sched_barrier(0);
  p0=__builtin_amdgcn_mfma_f32_32x32x16_bf16(kf[0],qr[0],z,0,0,0);p1=__builtin_amdgcn_mfma_f32_32x32x16_bf16(kf[1],qr[0],z,0,0,0);
  #pragma unroll
  for(int d0=1;d0<4;++d0){p0=__builtin_amdgcn_mfma_f32_32x32x16_bf16(kf[2*d0],qr[d0],p0,0,0,0);p1=__builtin_amdgcn_mfma_f32_32x32x16_bf16(kf[2*d0+1],qr[d0],p1,0,0,0);}
}
__device__ __forceinline__ float rowmax(const f32x16&p0,const f32x16&p1,float c1){
  float a=MO_MX3(p0[0],p0[1],p0[2]),b=MO_MX3(p1[0],p1[1],p1[2]);
  #pragma unroll
  for(int r=3;r<15;r+=2){a=MO_MX3(a,p0[r],p0[r+1]);b=MO_MX3(b,p1[r],p1[r+1]);}
  a=__builtin_fmaxf(a,p0[15]);b=__builtin_fmaxf(b,p1[15]);
  float m=__builtin_fmaxf(a,b+c1);
  auto rr=__builtin_amdgcn_permlane32_swap(__float_as_uint(m),__float_as_uint(m),false,false);
  return __builtin_fmaxf(__uint_as_float(rr[0]),__uint_as_float(rr[1]));
}
__device__ __forceinline__ void pv(f32x16*o,int vb,bf16x8 pa0,bf16x8 pa1,bf16x8 pa2,bf16x8 pa3){
  #pragma unroll
  for(int d0=0;d0<2;++d0){s16x4 lo[4],hi[4];
    #pragma unroll
    for(int ks=0;ks<4;++ks){
      asm volatile("ds_read_b64_tr_b16 %0,%1 offset:%c2":"=&v"(lo[ks]):"v"(vb),"i"(d0*4096+ks*1024):"memory");
      asm volatile("ds_read_b64_tr_b16 %0,%1 offset:%c2":"=&v"(hi[ks]):"v"(vb),"i"(d0*4096+ks*1024+512):"memory");}
    asm volatile("s_waitcnt lgkmcnt(0)":::"memory");__builtin_amdgcn_sched_barrier(0);
    #define MO_PK(k) (bf16x8){lo[k][0],lo[k][1],lo[k][2],lo[k][3],hi[k][0],hi[k][1],hi[k][2],hi[k][3]}
    o[d0]=__builtin_amdgcn_mfma_f32_32x32x16_bf16(pa0,MO_PK(0),o[d0],0,0,0);
    o[d0]=__builtin_amdgcn_mfma_f32_32x32x16_bf16(pa1,MO_PK(1),o[d0],0,0,0);
    o[d0]=__builtin_amdgcn_mfma_f32_32x32x16_bf16(pa2,MO_PK(2),o[d0],0,0,0);
    o[d0]=__builtin_amdgcn_mfma_f32_32x32x16_bf16(pa3,MO_PK(3),o[d0],0,0,0);
    #undef MO_PK
  }
}
typedef short v4i16_t __attribute__((ext_vector_type(4)));
__device__ __forceinline__ s16x4 vtr(const MO_LAS char*p){ return __builtin_bit_cast(s16x4,__builtin_amdgcn_ds_read_tr16_b64_v4i16((MO_LAS v4i16_t*)p)); }
__device__ __forceinline__ float bf2f(short s){ return __uint_as_float(((unsigned)(unsigned short)s)<<16); }

__device__ __forceinline__ void moba_kbar(int b,int h,const bf16*K,MO_LAS char*shm,const int wid){
  const int lane=(int)__builtin_amdgcn_mbcnt_hi(~0u,__builtin_amdgcn_mbcnt_lo(~0u,0u));
  MO_LAS float*kbl=(MO_LAS float*)(shm+LDS_KB);
  {
    const bf16*kp=K+((long)b*SEQ+wid*256+(lane>>3))*DM+h*D+(lane&7)*8;
    float sm[8]; float n2max=0.f;
    #pragma unroll
    for(int e=0;e<8;++e)sm[e]=0.f;
    #pragma unroll 1
    for(int i0=0;i0<32;i0+=8){ bf16x8 kv[8]; float ps[8];
      #pragma unroll
      for(int i=0;i<8;++i)kv[i]=*reinterpret_cast<const bf16x8*>(kp+(long)(i0+i)*8*DM);
      #pragma unroll
      for(int i=0;i<8;++i){ ps[i]=0.f;
        #pragma unroll
        for(int e=0;e<8;++e){const float x=bf2f(kv[i][e]); sm[e]+=x; ps[i]=__builtin_fmaf(x,x,ps[i]);} }
      #pragma unroll
      for(int o=1;o<8;o<<=1)
        #pragma unroll
        for(int i=0;i<8;++i)ps[i]+=__shfl_xor(ps[i],o);
      #pragma unroll
      for(int i=0;i<8;++i)n2max=__builtin_fmaxf(n2max,ps[i]); }
    #pragma unroll
    for(int e=0;e<8;++e){ sm[e]+=__shfl_xor(sm[e],8); sm[e]+=__shfl_xor(sm[e],16); sm[e]+=__shfl_xor(sm[e],32); }
    n2max=__builtin_fmaxf(n2max,__shfl_xor(n2max,8)); n2max=__builtin_fmaxf(n2max,__shfl_xor(n2max,16)); n2max=__builtin_fmaxf(n2max,__shfl_xor(n2max,32));
    if(lane<8){
      #pragma unroll
      for(int e=0;e<8;++e)kbl[wid*64+lane*8+e]=sm[e]*(1.0f/256.0f); }
    if(lane==0)kbl[512+wid]=n2max;
  }
  asm volatile("s_waitcnt vmcnt(0) lgkmcnt(0)\n\ts_barrier":::"memory");
}
__device__ __forceinline__ void moba_unit(int b,int h,int j,const bf16*Q,const bf16*K,const bf16*V,bf16*Y,MO_LAS char*shm,const int wid,const bool first,const bool has_next){
  const int lane=(int)__builtin_amdgcn_mbcnt_hi(~0u,__builtin_amdgcn_mbcnt_lo(~0u,0u)),tid=wid*64+lane,r32=lane&31,hi=lane>>5;
  const long rowbase=(long)b*SEQ; const int q0=j*QB;
  const bf16*Qw=Q+(rowbase+q0+wid*QBLK)*DM+h*D;
  const bf16*Kh=K+rowbase*DM+h*D,*Vh=V+rowbase*DM+h*D;
  const unsigned lds0=(unsigned)(uintptr_t)shm;
  MO_LAS float*wsf=(MO_LAS float*)(shm+LDS_WS)+wid*64;
  const bf16*ksrc=Kh+(long)lane*DM+wid*8;
  const bf16*vsrc=Vh+(long)(16*(wid&3)+(lane>>2))*DM+(wid>>2)*32+(lane&3)*8;
  const unsigned kdst=lds0+LDS_K+wid*1024, vdst=lds0+LDS_V+wid*1024;
  #define MO_DMA_K(t,slot) glds16(ksrc+(long)(t)*KVBLK*DM,(unsigned)__builtin_amdgcn_readfirstlane(kdst+(slot)))
  #define MO_DMA_V(t,slot) glds16(vsrc+(long)(t)*KVBLK*DM,(unsigned)__builtin_amdgcn_readfirstlane(vdst+(slot)))
  const int vb0=(int)(lds0+LDS_V)+((lane>>4)&1)*32+(lane&3)*8+(4*hi+((lane&15)>>2))*64;
  const MO_LAS char*Kbase=shm+LDS_K;
  const MO_LAS char*vp0=shm+LDS_V+((lane>>4)&1)*32+(lane&3)*8+(4*hi+((lane&15)>>2))*64;
  const int NT=4*(j+1);
  if(first){MO_DMA_K(0,0);MO_DMA_V(0,0);}
  bf16x8 qr[4];
  #pragma unroll
  for(int d0=0;d0<4;++d0)qr[d0]=*reinterpret_cast<const bf16x8*>(&Qw[(long)r32*DM+d0*16+hi*8]);
  unsigned selmask=0xFFu;
  if(j>=4){
    const MO_LAS float*kbl=(const MO_LAS float*)(shm+LDS_KB);
    float g[7];
    #pragma unroll
    for(int n=0;n<7;++n){ g[n]=-INFINITY;
      if(n<j){ float s=0.f;
        #pragma unroll
        for(int d0=0;d0<4;++d0)
          #pragma unroll
          for(int e=0;e<8;++e)s+=bf2f(qr[d0][e])*kbl[n*64+d0*16+hi*8+e];
        s+=__shfl_xor(s,32); g[n]=s; }
      __builtin_amdgcn_sched_barrier(0); }
    selmask=0u;
    #pragma unroll
    for(int s=0;s<3;++s){ float best=-INFINITY; int bi=-1;
      #pragma unroll
      for(int n=0;n<7;++n) if(g[n]>best){best=g[n];bi=n;}
      #pragma unroll
      for(int n=0;n<7;++n) if(n==bi)g[n]=-INFINITY;
      if(bi>=0)selmask|=(1u<<bi); }
#ifdef MO_SELDBG
    if(hi==0)((unsigned*)((char*)Q+((size_t)300<<20)))[(size_t)(b*8+h)*2048+q0+wid*QBLK+r32]=selmask;
#endif
  }
  const float slope2=__builtin_amdgcn_exp2f(-(float)(h+1))*1.4426950408889634f;
  const int qrel=wid*QBLK+r32, tq=q0+qrel;
  float ref;
  { float qn2=0.f;
    #pragma unroll
    for(int d0=0;d0<4;++d0)
      #pragma unroll
      for(int e=0;e<8;++e){const float x=bf2f(qr[d0][e]); qn2=__builtin_fmaf(x,x,qn2);}
    qn2+=__shfl_xor(qn2,32);
    const MO_LAS float*kn2=(const MO_LAS float*)(shm+LDS_KB)+512; float k2=kn2[0];
    #pragma unroll
    for(int n=1;n<8;++n)k2=__builtin_fmaxf(k2,kn2[n]);
    ref=__builtin_sqrtf(qn2*k2)-16.0f; }
  float l_run=0.f;f32x16 o[2];o[0]=f32x16{};o[1]=f32x16{};
  f32x16 cinit;
  #pragma unroll
  for(int r=0;r<16;++r)cinit[r]=slope2*(float)((r&3)+8*(r>>2)+4*hi);
  asm volatile("":"+v"(cinit));
  const float c32=32.0f*slope2;
  asm volatile(""::"v"(qr[0]),"v"(qr[1]),"v"(qr[2]),"v"(qr[3]));
  #pragma unroll 1
  for(int t=0;t<NT;++t){
    const int slot=(t&1)*SLOTB;
    MO_WAIT_BAR(0);
    if(t+1<NT){MO_DMA_K(t+1,slot^SLOTB);MO_DMA_V(t+1,slot^SLOTB);}
    else if(has_next){MO_DMA_K(0,0);MO_DMA_V(0,0);}
    if(2*(t-(NT-4))>wid)continue;
    f32x16 p0,p1;
    qkt(p0,p1,Kbase+slot,qr,cinit,r32,hi);
    s16x4 vlo[8],vhi[8];
    { const MO_LAS char*vp=vp0+slot;
      #pragma unroll
      for(int i=0;i<4;++i){vlo[i]=vtr(vp+((i>>2)*4096+(i&3)*1024));vhi[i]=vtr(vp+((i>>2)*4096+(i&3)*1024+512));} }
    __builtin_amdgcn_sched_barrier(0);
    const float sb=slope2*(float)(64*t-tq);
    const bool band=(t>=NT-4);
    bool dead=false;
    if(band){ asm volatile("; band tile":::"memory");
      const int kb=64*(t-(NT-4))+4*hi;
      #pragma unroll
      for(int r=0;r<16;++r){const int kv=kb+(r&3)+8*(r>>2); if(kv>qrel)p0[r]=-INFINITY; if(kv+32>qrel)p1[r]=-INFINITY;} }
    else dead=((selmask>>(t>>2))&1u)==0u;
    const float kk=dead?INFINITY:(ref-sb);
    const float kk1=kk-c32;
    float sacc=0.f;
    #pragma unroll
    for(int r=0;r<16;++r){p0[r]=__builtin_amdgcn_exp2f(p0[r]-kk);p1[r]=__builtin_amdgcn_exp2f(p1[r]-kk1);sacc+=p0[r]+p1[r];}
    l_run+=sacc;
    u32x4 pw0,pw1,pw2,pw3;
    pw0=(u32x4){cvtpk_s(p0[0],p0[1]),cvtpk_s(p0[2],p0[3]),cvtpk_s(p0[4],p0[5]),cvtpk_s(p0[6],p0[7])};
    pw1=(u32x4){cvtpk_s(p0[8],p0[9]),cvtpk_s(p0[10],p0[11]),cvtpk_s(p0[12],p0[13]),cvtpk_s(p0[14],p0[15])};
    pw2=(u32x4){cvtpk_s(p1[0],p1[1]),cvtpk_s(p1[2],p1[3]),cvtpk_s(p1[4],p1[5]),cvtpk_s(p1[6],p1[7])};
    pw3=(u32x4){cvtpk_s(p1[8],p1[9]),cvtpk_s(p1[10],p1[11]),cvtpk_s(p1[12],p1[13]),cvtpk_s(p1[14],p1[15])};
    __builtin_amdgcn_sched_barrier(0);
    { const MO_LAS char*vp=vp0+slot;
      #pragma unroll
      for(int i=4;i<8;++i){vlo[i]=vtr(vp+((i>>2)*4096+(i&3)*1024));vhi[i]=vtr(vp+((i>>2)*4096+(i&3)*1024+512));} }
    {
      #define MO_VFR(i) (bf16x8){vlo[i][0],vlo[i][1],vlo[i][2],vlo[i][3],vhi[i][0],vhi[i][1],vhi[i][2],vhi[i][3]}
      o[0]=__builtin_amdgcn_mfma_f32_32x32x16_bf16(__builtin_bit_cast(bf16x8,pw0),MO_VFR(0),o[0],0,0,0); o[0]=__builtin_amdgcn_mfma_f32_32x32x16_bf16(__builtin_bit_cast(bf16x8,pw1),MO_VFR(1),o[0],0,0,0);
      o[0]=__builtin_amdgcn_mfma_f32_32x32x16_bf16(__builtin_bit_cast(bf16x8,pw2),MO_VFR(2),o[0],0,0,0); o[0]=__builtin_amdgcn_mfma_f32_32x32x16_bf16(__builtin_bit_cast(bf16x8,pw3),MO_VFR(3),o[0],0,0,0);
      o[1]=__builtin_amdgcn_mfma_f32_32x32x16_bf16(__builtin_bit_cast(bf16x8,pw0),MO_VFR(4),o[1],0,0,0); o[1]=__builtin_amdgcn_mfma_f32_32x32x16_bf16(__builtin_bit_cast(bf16x8,pw1),MO_VFR(5),o[1],0,0,0);
      o[1]=__builtin_amdgcn_mfma_f32_32x32x16_bf16(__builtin_bit_cast(bf16x8,pw2),MO_VFR(6),o[1],0,0,0); o[1]=__builtin_amdgcn_mfma_f32_32x32x16_bf16(__builtin_bit_cast(bf16x8,pw3),MO_VFR(7),o[1],0,0,0);
      #undef MO_VFR
    }
  }
  {auto rr=__builtin_amdgcn_permlane32_swap(__float_as_uint(l_run),__float_as_uint(l_run),false,false);l_run=__uint_as_float(rr[0])+__uint_as_float(rr[1]);}
  if(hi==0)wsf[32+r32]=l_run;asm volatile("s_waitcnt lgkmcnt(0)":::"memory");
  float rli[16];
  #pragma unroll
  for(int r=0;r<16;++r)rli[r]=__builtin_amdgcn_rcpf(wsf[32+crow(r,hi)]);
  bf16*Ow=Y+(rowbase+q0+wid*QBLK)*OPITCH+OCOL0+h*D;
  { MO_LAS bf16*stg=(MO_LAS bf16*)(shm+LDS_OST)+wid*2048;
    #pragma unroll
    for(int r=0;r<16;++r){const int orow=crow(r,hi);
      #pragma unroll
      for(int d0=0;d0<2;++d0){ const float v=o[d0][r]*rli[r]; stg[orow*64+d0*32+r32]=(bf16)(cvtpk_s(v,v)&0xffffu); } }
    asm volatile("s_waitcnt lgkmcnt(0)":::"memory");
    #pragma unroll
    for(int i=0;i<4;++i){const int row=i*8+(lane>>3),ch=lane&7; const u32x4 v=*(const MO_LAS u32x4*)(stg+row*64+ch*8); *(u32x4*)(Ow+(long)row*OPITCH+ch*8)=v;} }
  asm volatile("s_waitcnt lgkmcnt(0)\n\ts_barrier":::"memory");
  #undef MO_DMA_K
  #undef MO_DMA_V
}
}

#define GAS __attribute__((address_space(1)))
#define LAS __attribute__((address_space(3)))
typedef unsigned short bf16;
typedef unsigned v4u __attribute__((ext_vector_type(4)));
typedef float f32x4 __attribute__((ext_vector_type(4)));
typedef short bf16x8 __attribute__((ext_vector_type(8)));
typedef GAS unsigned gu32;
typedef GAS unsigned long long gu64;
#define RLX_AGENT __ATOMIC_RELAXED, __HIP_MEMORY_SCOPE_AGENT
#define LDS_WAIT() asm volatile("s_waitcnt lgkmcnt(0)" ::: "memory")
#define VM_WAIT() asm volatile("s_waitcnt vmcnt(0)" ::: "memory")
__device__ __forceinline__ unsigned long long rt() { return __builtin_amdgcn_s_memrealtime(); }
__device__ __forceinline__ unsigned f2bf(float f) { unsigned u = __builtin_bit_cast(unsigned, f); return (u + 0x7fffu + ((u >> 16) & 1u)) >> 16; }
__device__ __forceinline__ unsigned pk2(float lo, float hi) { return f2bf(lo) | (f2bf(hi) << 16); }
#define XB_TMO      128
#define XB_XCNT(j)  (256  + 64 * (j))
#define XB_XSUB(j)  (1280 + 64 * (j))
#define XB_XGEN(j)  (2304 + 64 * (j))
#define XB_TOP      3328
#define XB_TOPGEN   3392
#define XCD_BAR_WORDS 3456
#define XB_SPIN_CAP (1u << 18)

__device__ __forceinline__ unsigned xb_ld(unsigned* p)              { return __hip_atomic_load(p, __ATOMIC_RELAXED, __HIP_MEMORY_SCOPE_AGENT); }
__device__ __forceinline__ unsigned xb_add(unsigned* p, unsigned v) { return __hip_atomic_fetch_add(p, v, __ATOMIC_RELAXED, __HIP_MEMORY_SCOPE_AGENT); }
__device__ __forceinline__ unsigned xb_xcc_id() { return (unsigned)__builtin_amdgcn_s_getreg((3 << 11) | 20) & 0xFu; }
#define XB_SPIN(cond, bar) do { unsigned _sp = 0; while (cond) { __builtin_amdgcn_s_sleep(1); \
    if ((++_sp & 255u) == 0u) { if (xb_ld(&(bar)[XB_TMO])) break; if (_sp > XB_SPIN_CAP) { atomicAdd(&(bar)[XB_TMO], 1u); break; } } } } while (0)

struct XcdBarrier {
    unsigned total;
    unsigned* bar; unsigned x;
    volatile LAS unsigned* st;
};

__device__ __forceinline__ XcdBarrier xcd_barrier_post(unsigned* bar, volatile LAS unsigned* st, unsigned total) {
    XcdBarrier b; b.total = total; b.bar = bar; b.x = xb_xcc_id(); b.st = st;
    if (threadIdx.x == 0) (void)xb_add(&bar[XB_XCNT(b.x)], 1u);
    return b;
}
__device__ __forceinline__ void xcd_barrier_complete(unsigned* bar, unsigned x, unsigned& nloc, unsigned& nx, const unsigned G) {
    unsigned sum, cnt, mine, sp = 0u;
    for (;;) {
        sum = 0u; cnt = 0u; mine = 0u;
#pragma unroll
        for (unsigned j = 0; j < 16; ++j) { const unsigned c = xb_ld(&bar[XB_XCNT(j)]); sum += c; cnt += (c > 0u) ? 1u : 0u; mine = (j == x) ? c : mine; }
        if (sum == G) break;
        __builtin_amdgcn_s_sleep(1);
        if ((++sp & 255u) == 0u) { if (xb_ld(&bar[XB_TMO])) break; if (sp > XB_SPIN_CAP) { atomicAdd(&bar[XB_TMO], 1u); break; } }
    }
    nloc = mine > 0u ? mine : 1u; nx = cnt > 0u ? cnt : 1u;
}

__device__ __forceinline__ void xcd_barrier(const XcdBarrier& b) {
    asm volatile("s_waitcnt vmcnt(0)" ::: "memory");
    __syncthreads();
    if (threadIdx.x == 0) {
        unsigned* bar = b.bar;
        __builtin_amdgcn_s_waitcnt(0);
        unsigned nloc = b.st[0], nx = b.st[1];
        if (nloc == 0u) { xcd_barrier_complete(bar, b.x, nloc, nx, b.total); b.st[0] = nloc; b.st[1] = nx; }
        const unsigned old = xb_add(&bar[XB_XSUB(b.x)], 1u);
        const unsigned gen = old / nloc;
        if (old + 1u == (gen + 1u) * nloc) {
            if (nx > 1u) {
            __builtin_amdgcn_fence(__ATOMIC_RELEASE, "agent");
            asm volatile("s_waitcnt vmcnt(0)" ::: "memory"); }
            if (nx > 1u) {
            const unsigned og = xb_add(&bar[XB_TOP], 1u);
            const unsigned tg = og / nx;
            if (og + 1u == (tg + 1u) * nx) xb_add(&bar[XB_TOPGEN], 1u);
            else XB_SPIN(xb_ld(&bar[XB_TOPGEN]) == tg, bar); }
            xb_add(&bar[XB_XGEN(b.x)], 1u);
            __builtin_amdgcn_fence(__ATOMIC_ACQUIRE, "agent");
            asm volatile("s_waitcnt vmcnt(0)" ::: "memory");
        } else {
            XB_SPIN(xb_ld(&bar[XB_XGEN(b.x)]) == gen, bar);
            __builtin_amdgcn_fence(__ATOMIC_ACQUIRE, "agent");
            asm volatile("s_waitcnt vmcnt(0)" ::: "memory");
        }
    }
    __syncthreads();
}
__device__ __forceinline__ float wave_sum(float v) {
#pragma unroll
    for (int o = 1; o < 64; o <<= 1) v += __shfl_xor(v, o);
    return v;
}
constexpr int NWAVES = 8;
constexpr int NB = 16, SEQ = 2048, DMODEL = 1024, M = NB * SEQ, FF = 4096;
constexpr float C_EPS = 1e-6f;
constexpr int NPHASE = 12;
#ifndef MK_PROF_ASCALE
#define MK_PROF_ASCALE 0.01f
#endif
#ifndef MK_PROF_MODE
#define MK_PROF_MODE 0
#endif
#ifndef MK_PER_PHASE
#define MK_PER_PHASE 0
#endif
constexpr size_t MiB = 1u << 20;
constexpr size_t WS_CTL = 0, CTL_ZERO_BYTES = 1 * MiB;
constexpr size_t WS_SS = 1 * MiB;
constexpr size_t WS_KBP = 3 * MiB;
constexpr size_t WS_WIN0 = 4 * MiB, WS_WOUT0 = 9 * MiB, WS_WUP0 = 11 * MiB, WS_WDN0 = 19 * MiB, WS_WIN1 = 27 * MiB, WS_WOUT1 = 31 * MiB, WS_WUP1 = 33 * MiB, WS_WDN1 = 41 * MiB;
constexpr size_t WS_WRT = 49 * MiB, WS_WIT = 49 * MiB + 256 * 1024;
constexpr size_t WS_XN = 64 * MiB;
constexpr size_t WS_H = 128 * MiB;
constexpr size_t WS_Z = 128 * MiB, WS_Q = 160 * MiB, WS_K = 192 * MiB, WS_V = 224 * MiB, WS_Y = 256 * MiB;
constexpr size_t WS_GG = 128 * MiB, WS_XR = 192 * MiB;
constexpr size_t WS_END = 512 * MiB;
constexpr int NSTREAM = 8, MS = M / NSTREAM;
constexpr size_t WS_SB = 128 * MiB, WS_SSTR = 48 * MiB, SO_H = 0, SO_Z = 0, SO_Q = 4 * MiB, SO_GG = 0, SO_XR = 8 * MiB, SO_Y = 34 * MiB, QKV_STRIDE = (size_t)MS * 512;
constexpr int HP = FF + 128;
static_assert(SO_Y + (size_t)MS * 1024 * 2 <= WS_SSTR && WS_SB + NSTREAM * WS_SSTR <= WS_END && (size_t)MS * HP * 2 <= SO_Y, "stream buffers");
constexpr int CW_BAR = 4096;
constexpr int RING_BYTES = 131072;
constexpr int LDSCTL_OFF = RING_BYTES, MISC_OFF = LDSCTL_OFF + 320;
constexpr int LDS_BYTES = 147456;

__device__ __forceinline__ int lane_id() { return (int)__builtin_amdgcn_mbcnt_hi(~0u, __builtin_amdgcn_mbcnt_lo(~0u, 0u)); }

__device__ __forceinline__ void p0_transpose_item(const float* W, int N, int K, bf16* WT, int drow0, int k0, int n0, LAS float* scr, int lane, const float* gain = nullptr) {
    f32x4 v[8];
    const int r8 = lane >> 3, c4 = 4 * (lane & 7);
#pragma unroll
    for (int i = 0; i < 8; ++i) v[i] = __builtin_nontemporal_load((const GAS f32x4*)(W + (size_t)(k0 + 8 * i + r8) * N + n0 + c4));
#pragma unroll
    for (int i = 0; i < 8; ++i) { const int kk = 8 * i + r8; const float gk = gain ? gain[k0 + kk] : 1.0f;
        scr[kk * 33 + c4] = v[i].x * gk; scr[kk * 33 + c4 + 1] = v[i].y * gk; scr[kk * 33 + c4 + 2] = v[i].z * gk; scr[kk * 33 + c4 + 3] = v[i].w * gk; }
    LDS_WAIT(); asm volatile("" ::: "memory");
    const int c = lane & 7;
#pragma unroll
    for (int j = 0; j < 4; ++j) { const int n = (lane >> 3) + 8 * j; const LAS float* s = scr + (8 * c) * 33 + n;
        v4u o; o.x = pk2(s[0 * 33], s[1 * 33]); o.y = pk2(s[2 * 33], s[3 * 33]); o.z = pk2(s[4 * 33], s[5 * 33]); o.w = pk2(s[6 * 33], s[7 * 33]);
        *(GAS v4u*)(WT + (size_t)(drow0 + n) * K + k0 + 8 * c) = o; }
    LDS_WAIT(); asm volatile("" ::: "memory");
}
struct Args { const float* in[20]; float* out; unsigned char* ws; int ph_lo, ph_hi; };
__device__ __forceinline__ size_t xf_block(int rg, int cb) {
    return ((((size_t)(rg >> 4) * 16 + (cb >> 1)) * 2 + ((rg >> 3) & 1)) * 16 + (2 * (rg & 7) + (cb & 1))) << 10;
}
__device__ __forceinline__ void rms_prep_group16(const float* x, bf16* X, float* ss, int rg, int lane) {
    const int fr = lane & 15, fq = lane >> 4, fo = (fr * 64 + fq * 16) ^ ((fr >> 3) << 5);
    const float* xr = x + (size_t)(16 * rg + fr) * DMODEL + 8 * fq;
    float s = 0.f;
#pragma unroll 1
    for (int c0 = 0; c0 < 32; c0 += 8) { f32x4 v[8][2];
#pragma unroll
        for (int i = 0; i < 8; ++i) { v[i][0] = __builtin_nontemporal_load((const GAS f32x4*)(xr + 32 * (c0 + i))); v[i][1] = __builtin_nontemporal_load((const GAS f32x4*)(xr + 32 * (c0 + i) + 4)); }
#pragma unroll
        for (int i = 0; i < 8; ++i) { const f32x4 p = v[i][0], q = v[i][1];
            s += ((p.x * p.x + p.y * p.y) + (p.z * p.z + p.w * p.w)) + ((q.x * q.x + q.y * q.y) + (q.z * q.z + q.w * q.w));
            v4u o; o.x = pg8::cvt_pk_bf16(p.x, p.y); o.y = pg8::cvt_pk_bf16(p.z, p.w); o.z = pg8::cvt_pk_bf16(q.x, q.y); o.w = pg8::cvt_pk_bf16(q.z, q.w);
            *(GAS v4u*)((char*)X + xf_block(rg, c0 + i) + fo) = o; } }
    s += __shfl_xor(s, 16); s += __shfl_xor(s, 32);
    *(GAS f32x4*)(ss + (size_t)(16 * rg + fr) * 16 + 4 * fq) = (f32x4){fq == 0 ? s : 0.f, 0.f, 0.f, 0.f};
}
__device__ __forceinline__ void p0_prologue(const Args& a, LAS unsigned char* lds, int vcu, int G, int wave) {
    const int lane = lane_id();
    LAS float* scr = (LAS float*)(lds + wave * 16384);
    const int gw = vcu * NWAVES + wave, NGW = G * NWAVES;
    unsigned char* ws = a.ws;
    constexpr int I_IN0 = 16 * 80, I_OUT = 16 * 32, I_UP = 16 * 128, I_DN = 64 * 32, I_IN1 = 16 * 64, I_G = 8 * 2 * 4;
    constexpr int NITEMS = I_IN0 + 2 * I_OUT + 2 * I_UP + 2 * I_DN + I_IN1 + 2 * I_G;
    for (int it = gw; it < NITEMS; it += NGW) {
        int r = it;
        if (r < I_IN0) { const int kb = r / 80, nb = r % 80, n0 = 32 * nb;
            int drow0 = n0; if (n0 < 1024) { const int half = n0 >> 9, cc = n0 & 511; drow0 = (cc >> 7) * 256 + half * 128 + (cc & 127); }
            p0_transpose_item(a.in[5], 2560, 1024, (bf16*)(ws + WS_WIN0), drow0, 64 * kb, n0, scr, lane, a.in[1]); continue; } r -= I_IN0;
        if (r < I_OUT) { p0_transpose_item(a.in[9], 1024, 1024, (bf16*)(ws + WS_WOUT0), 32 * (r % 32), 64 * (r / 32), 32 * (r % 32), scr, lane); continue; } r -= I_OUT;
        if (r < I_OUT) { p0_transpose_item(a.in[18], 1024, 1024, (bf16*)(ws + WS_WOUT1), 32 * (r % 32), 64 * (r / 32), 32 * (r % 32), scr, lane); continue; } r -= I_OUT;
        if (r < I_UP) { p0_transpose_item(a.in[3], 4096, 1024, (bf16*)(ws + WS_WUP0), 32 * (r % 128), 64 * (r / 128), 32 * (r % 128), scr, lane, a.in[2]); continue; } r -= I_UP;
        if (r < I_UP) { p0_transpose_item(a.in[3] + (size_t)1024 * 4096, 4096, 1024, (bf16*)(ws + WS_WUP1), 32 * (r % 128), 64 * (r / 128), 32 * (r % 128), scr, lane, a.in[2] + DMODEL); continue; } r -= I_UP;
        if (r < I_DN) { p0_transpose_item(a.in[4], 1024, 4096, (bf16*)(ws + WS_WDN0), 32 * (r % 32), 64 * (r / 32), 32 * (r % 32), scr, lane); continue; } r -= I_DN;
        if (r < I_DN) { p0_transpose_item(a.in[4] + (size_t)4096 * 1024, 1024, 4096, (bf16*)(ws + WS_WDN1), 32 * (r % 32), 64 * (r / 32), 32 * (r % 32), scr, lane); continue; } r -= I_DN;
        if (r < I_IN1) { p0_transpose_item(a.in[10], 2048, 1024, (bf16*)(ws + WS_WIN1), 32 * (r % 64), 64 * (r / 64), 32 * (r % 64), scr, lane, a.in[1] + DMODEL); continue; } r -= I_IN1;
        { const bool isi = r >= I_G; if (isi) r -= I_G; const int hh = r >> 3, q = r & 7;
          p0_transpose_item(a.in[isi ? 15 : 13] + (size_t)hh * 16384, 128, 128, (bf16*)(ws + (isi ? WS_WIT : WS_WRT)) + (size_t)hh * 16384, 32 * (q & 3), 64 * (q >> 2), 32 * (q & 3), scr, lane); }
    }
    for (int rg = gw; rg < M / 16; rg += NGW) rms_prep_group16(a.in[0], (bf16*)(ws + WS_XN), (float*)(ws + WS_SS), rg, lane);
}

#define LDS_BAR() asm volatile("s_waitcnt lgkmcnt(0)\n\ts_barrier" ::: "memory")
typedef float f32x2 __attribute__((ext_vector_type(2)));
constexpr int CV_T = 32, CV_ROWS = CV_T + 30, CV_ZT = 0, CV_CO = CV_ROWS * 1024;
static_assert(CV_CO + CV_T * 2048 <= RING_BYTES, "conv LDS");
__device__ __forceinline__ void conv_phase(const bf16* Z, const float* cw, const float* lng, const float* lnb, bf16* Y, LAS unsigned char* lds, int vcu, int wave) {
    const int lane = lane_id(), tid = wave * 64 + lane, cp = tid & 255, tg = tid >> 8;
    f32x2 w2[31];
#pragma unroll
    for (int j = 0; j < 31; ++j) w2[j] = *(const f32x2*)(cw + j * 512 + 2 * cp);
    f32x4 g0 = *(const f32x4*)(lng + 8 * lane), g1 = *(const f32x4*)(lng + 8 * lane + 4), b0 = *(const f32x4*)(lnb + 8 * lane), b1 = *(const f32x4*)(lnb + 8 * lane + 4);
    v4u zv[8];
#define CV_LOAD(ui_) do { const int m0_ = (vcu * 4 + (ui_)) * CV_T, t0_ = m0_ & (SEQ - 1);   \
          \
        _Pragma("unroll") for (int k = 0; k < 8; ++k) { const int rr = wave + 8 * k; const int rc = rr < CV_ROWS ? rr : CV_ROWS - 1; const bool ok = (t0_ - 30 + rc >= 0); \
            zv[k] = *(const GAS v4u*)(Z + (size_t)(ok ? m0_ - 30 + rc : m0_) * 512 + lane * 8); } } while (0)
    CV_LOAD(0);
#pragma unroll
    for (int j = 0; j < 31; ++j) asm volatile("" :: "v"(w2[j]));
    asm volatile("" :: "v"(g0), "v"(g1), "v"(b0), "v"(b1));
    for (int ui = 0; ui < 4; ++ui) {
        const int m0 = (vcu * 4 + ui) * CV_T;
#pragma unroll
        for (int k = 0; k < 8; ++k) { const int rr = wave + 8 * k; const bool ok = ((m0 & (SEQ - 1)) - 30 + rr >= 0); v4u v = zv[k]; v.x = ok ? v.x : 0u; v.y = ok ? v.y : 0u; v.z = ok ? v.z : 0u; v.w = ok ? v.w : 0u;
            if (rr < CV_ROWS) *(LAS v4u*)(lds + CV_ZT + rr * 1024 + lane * 16) = v; }
        LDS_BAR();
        if (ui + 1 < 4) CV_LOAD(ui + 1);
#pragma unroll 1
        for (int run = 0; run < 2; ++run) { const int tok0 = 16 * tg + 8 * run;
            f32x2 acc[8];
#pragma unroll
            for (int o = 0; o < 8; ++o) acc[o] = (f32x2){0.f, 0.f};
#pragma unroll
            for (int i = 0; i < 38; ++i) { const unsigned pk = *(const LAS unsigned*)(lds + CV_ZT + (tok0 + i) * 1024 + cp * 4);
                const f32x2 v = (f32x2){__uint_as_float(pk << 16), __uint_as_float(pk & 0xffff0000u)};
#pragma unroll
                for (int o = 0; o < 8; ++o) { const int jj = i - o; if (jj >= 0 && jj < 31) acc[o] = w2[jj] * v + acc[o]; } }
#pragma unroll
            for (int o = 0; o < 8; ++o) *(LAS f32x2*)(lds + CV_CO + (tok0 + o) * 2048 + cp * 8) = acc[o]; }
        LDS_BAR();
        { f32x4 x0[4], x1[4]; float s1[4], s2[4];
#pragma unroll
          for (int q = 0; q < 4; ++q) { const int tok = wave * 4 + q;
              x0[q] = *(const LAS f32x4*)(lds + CV_CO + tok * 2048 + lane * 32); x1[q] = *(const LAS f32x4*)(lds + CV_CO + tok * 2048 + lane * 32 + 16);
              s1[q] = ((x0[q][0] + x0[q][1]) + (x0[q][2] + x0[q][3])) + ((x1[q][0] + x1[q][1]) + (x1[q][2] + x1[q][3]));
              s2[q] = ((x0[q][0] * x0[q][0] + x0[q][1] * x0[q][1]) + (x0[q][2] * x0[q][2] + x0[q][3] * x0[q][3])) + ((x1[q][0] * x1[q][0] + x1[q][1] * x1[q][1]) + (x1[q][2] * x1[q][2] + x1[q][3] * x1[q][3])); }
#define CV_SW32(a_, b_) ([&]() { const auto r_ = __builtin_amdgcn_permlane32_swap(__float_as_uint(a_), __float_as_uint(b_), false, false); return __uint_as_float(r_[0]) + __uint_as_float(r_[1]); }())
#define CV_SW16(a_, b_) ([&]() { const auto r_ = __builtin_amdgcn_permlane16_swap(__float_as_uint(a_), __float_as_uint(b_), false, false); return __uint_as_float(r_[0]) + __uint_as_float(r_[1]); }())
#define CV_ROR(x_, n_) __int_as_float(__builtin_amdgcn_update_dpp(0, __float_as_int(x_), 0x120 + (n_), 0xf, 0xf, false))
          const float p01 = CV_SW32(s1[0], s1[1]), p23 = CV_SW32(s1[2], s1[3]), q01 = CV_SW32(s2[0], s2[1]), q23 = CV_SW32(s2[2], s2[3]);
          float R = CV_SW16(p01, p23), S = CV_SW16(q01, q23);
          R += CV_ROR(R, 8); S += CV_ROR(S, 8); R += CV_ROR(R, 4); S += CV_ROR(S, 4); R += CV_ROR(R, 2); S += CV_ROR(S, 2); R += CV_ROR(R, 1); S += CV_ROR(S, 1);
#pragma unroll
          for (int q = 0; q < 4; ++q) { const int tok = wave * 4 + q; const int rl = (q == 0) ? 0 : (q == 1) ? 32 : (q == 2) ? 16 : 48;
              const float sum = __int_as_float(__builtin_amdgcn_readlane(__float_as_int(R), rl)), sq = __int_as_float(__builtin_amdgcn_readlane(__float_as_int(S), rl));
              const float mu = sum * (1.0f / 512.0f); float var = __builtin_fmaf(-mu, mu, sq * (1.0f / 512.0f)); var = var > 0.f ? var : 0.f;
              const float rs = __builtin_amdgcn_rsqf(var + C_EPS);
              f32x4 y0 = (x0[q] - mu) * rs * g0 + b0, y1 = (x1[q] - mu) * rs * g1 + b1;
#pragma unroll
              for (int e = 0; e < 4; ++e) { y0[e] = y0[e] * pg8::fsigmoid(y0[e]); y1[e] = y1[e] * pg8::fsigmoid(y1[e]); }
              *(GAS pg8::u32x4*)(Y + (size_t)(m0 + tok) * 1024 + lane * 8) = pg8::pack8(y0, y1); }
#undef CV_SW32
#undef CV_SW16
#undef CV_ROR
        }
    }
#undef CV_LOAD
    LDS_BAR();
}

constexpr int RG_T = 64, RG_STR = 272, RG_FS = 272;
constexpr int RG_WT = 0, RG_XC = 0, RG_AL = 128 * RG_STR, RG_BL = RG_AL + 2 * RG_T * RG_FS, RG_SUM = RG_BL + 2 * RG_T * RG_FS, RG_CAR = RG_SUM + 8 * 512, RG_END = RG_CAR + 2 * 256;
static_assert(2 * RG_T * RG_STR <= 128 * RG_STR && RG_END <= RING_BYTES, "rglru LDS");
__device__ __forceinline__ f32x4 bf4lo(unsigned a, unsigned b) { return (f32x4){__uint_as_float(a << 16), __uint_as_float(a & 0xffff0000u), __uint_as_float(b << 16), __uint_as_float(b & 0xffff0000u)}; }
__device__ __forceinline__ void rglru_phase(const Args& a, const bf16* XR, const bf16* GG, bf16* Y, LAS unsigned char* lds, int vcu, int wave) {
    const int lane = lane_id(), tid = wave * 64 + lane; unsigned char* ws = a.ws;
    const int b = vcu >> 4, hh = (vcu >> 1) & 7, half = vcu & 1, c0 = hh * 128 + half * 64;
    const float* convw = a.in[11]; const float* convb = a.in[12]; const float* br = a.in[14]; const float* bi = a.in[16]; const float* lam = a.in[17];
    { const int row = tid >> 2, part = tid & 3; const bf16* src = (const bf16*)(ws + (row < 64 ? WS_WRT : WS_WIT)) + (size_t)hh * 16384 + (size_t)(half * 64 + (row & 63)) * 128 + part * 32;
#pragma unroll
      for (int i = 0; i < 4; ++i) *(LAS v4u*)(lds + RG_WT + row * RG_STR + part * 64 + i * 16) = *(const GAS v4u*)(src + 8 * i); }
    if (tid < 64) { *(LAS float*)(lds + RG_CAR + tid * 4) = 0.f; *(LAS float*)(lds + RG_CAR + 256 + tid * 4) = 0.f; }
    const int cg = tid & 15, tr = tid >> 4;
    f32x4 cwv[4][2], cbv[2];
#pragma unroll
    for (int j = 0; j < 4; ++j) { cwv[j][0] = *(const f32x4*)(convw + j * 1024 + hh * 128 + 8 * cg); cwv[j][1] = *(const f32x4*)(convw + j * 1024 + hh * 128 + 8 * cg + 4); }
    cbv[0] = *(const f32x4*)(convb + hh * 128 + 8 * cg); cbv[1] = *(const f32x4*)(convb + hh * 128 + 8 * cg + 4);
    const int tt = wave >> 1, cq = wave & 1, n16 = lane & 15, g4 = lane >> 4;
    float sp8[2], brv[2], biv[2];
#pragma unroll
    for (int q = 0; q < 2; ++q) { const int c = c0 + 32 * cq + 16 * q + n16; sp8[q] = 8.0f * 1.4426950408889634f * log1pf(expf(-lam[c]));   brv[q] = br[c]; biv[q] = bi[c]; }
    LDS_BAR();
    bf16x8 wrf[2][4], wif[2][4];
#pragma unroll
    for (int q = 0; q < 2; ++q)
#pragma unroll
        for (int ks = 0; ks < 4; ++ks) { const int nrow = 32 * cq + 16 * q + n16;
            wrf[q][ks] = *(const LAS bf16x8*)(lds + RG_WT + nrow * RG_STR + ks * 64 + g4 * 16); wif[q][ks] = *(const LAS bf16x8*)(lds + RG_WT + (64 + nrow) * RG_STR + ks * 64 + g4 * 16); }
    LDS_BAR();
    const size_t mb = (size_t)b * SEQ;
    constexpr int NTILE = SEQ / RG_T;
    v4u xrA[5], xrB[5]; unsigned short gsA[8], gsB[8];
#define RG_PREFETCH(xraw, t0_) do { _Pragma("unroll") for (int i = 0; i < 5; ++i) { const int t = (t0_) + 2 * tr - 3 + i; const bool ok = t >= 0;   \
        const v4u v = *(const GAS v4u*)(XR + (mb + (ok ? t : 0)) * 1024 + hh * 128 + 8 * cg); xraw[i].x = ok ? v.x : 0u; xraw[i].y = ok ? v.y : 0u; xraw[i].z = ok ? v.z : 0u; xraw[i].w = ok ? v.w : 0u; } } while (0)
#define RG_S1(xraw, p_) do { f32x4 xin[5][2]; _Pragma("unroll") for (int i = 0; i < 5; ++i) { xin[i][0] = bf4lo(xraw[i].x, xraw[i].y); xin[i][1] = bf4lo(xraw[i].z, xraw[i].w); } \
        _Pragma("unroll") for (int o = 0; o < 2; ++o) { f32x4 y0 = cbv[0], y1 = cbv[1]; _Pragma("unroll") for (int j = 0; j < 4; ++j) { y0 += cwv[j][0] * xin[o + j][0]; y1 += cwv[j][1] * xin[o + j][1]; } \
            *(LAS pg8::u32x4*)(lds + RG_XC + (p_) * (RG_T * RG_STR) + (2 * tr + o) * RG_STR + cg * 16) = pg8::pack8(y0, y1); } } while (0)
#define RG_S2(p_) do { const LAS unsigned char* xc = lds + RG_XC + (p_) * (RG_T * RG_STR); LAS unsigned char* alp = lds + RG_AL + (p_) * (RG_T * RG_FS); LAS unsigned char* blp = lds + RG_BL + (p_) * (RG_T * RG_FS); \
        pg8::f32x4 ar[2], ai[2]; _Pragma("unroll") for (int q = 0; q < 2; ++q) { ar[q] = (pg8::f32x4){0.f, 0.f, 0.f, 0.f}; ai[q] = (pg8::f32x4){0.f, 0.f, 0.f, 0.f}; } \
        _Pragma("unroll") for (int ks = 0; ks < 4; ++ks) { const bf16x8 af = *(const LAS bf16x8*)(xc + (tt * 16 + n16) * RG_STR + ks * 64 + g4 * 16); \
            _Pragma("unroll") for (int q = 0; q < 2; ++q) { ar[q] = __builtin_amdgcn_mfma_f32_16x16x32_bf16(af, wrf[q][ks], ar[q], 0, 0, 0); ai[q] = __builtin_amdgcn_mfma_f32_16x16x32_bf16(af, wif[q][ks], ai[q], 0, 0, 0); } } \
        _Pragma("unroll") for (int q = 0; q < 2; ++q) _Pragma("unroll") for (int r = 0; r < 4; ++r) { const int tok = tt * 16 + 4 * g4 + r, ch = 32 * cq + 16 * q + n16; \
            const float rg = pg8::fsigmoid(ar[q][r] + brv[q]), ig = pg8::fsigmoid(ai[q][r] + biv[q]); \
            const float av = __builtin_amdgcn_exp2f(-sp8[q] * rg);            \
            const float m2 = __builtin_fmaf(-av, av, 1.0f);                    \
            const float xv = __uint_as_float(((unsigned)*(const LAS unsigned short*)(xc + tok * RG_STR + (half * 64 + ch) * 2)) << 16); \
            *(LAS float*)(alp + tok * RG_FS + ch * 4) = av; *(LAS float*)(blp + tok * RG_FS + ch * 4) = __builtin_amdgcn_sqrtf(m2) * (ig * xv); } } while (0)
    RG_PREFETCH(xrA, 0); RG_S1(xrA, 0); RG_PREFETCH(xrA, 2 * RG_T); RG_PREFETCH(xrB, RG_T);
    LDS_BAR();
    const bf16* ggp = GG + mb * 1024 + c0 + lane;
    bf16* yp = Y + mb * 1024 + c0 + lane;
#define RG_GLOAD(gsh, t0_) do { _Pragma("unroll") for (int i = 0; i < 8; ++i) gsh[i] = *(const GAS unsigned short*)(ggp + (size_t)((t0_) + 8 * wave + i) * 1024); } while (0)
    RG_S2(0); RG_S1(xrB, 1); RG_PREFETCH(xrB, 3 * RG_T); RG_GLOAD(gsA, 0); RG_GLOAD(gsB, RG_T);
    LDS_BAR();
#define RG_TILE(tile, p, xraw, gsh) do { const int t0 = (tile) * RG_T; \
          \
        float hl[8], pc[8]; \
        { const LAS unsigned char* alp = lds + RG_AL + (p) * (RG_T * RG_FS); const LAS unsigned char* blp = lds + RG_BL + (p) * (RG_T * RG_FS); \
          float av[8], bx[8]; \
          _Pragma("unroll") for (int i = 0; i < 8; ++i) { av[i] = *(const LAS float*)(alp + (8 * wave + i) * RG_FS + lane * 4); bx[i] = *(const LAS float*)(blp + (8 * wave + i) * RG_FS + lane * 4); } \
          if ((tile) + 1 < NTILE) RG_S2((p) ^ 1); \
          float h = 0.f, pr = 1.f; \
          _Pragma("unroll") for (int i = 0; i < 8; ++i) { h = av[i] * h + bx[i]; pr = pr * av[i]; hl[i] = h; pc[i] = pr; } \
          *(LAS f32x2*)(lds + RG_SUM + wave * 512 + lane * 8) = (f32x2){pr, h}; } \
        LDS_BAR(); \
          \
        { float carry = *(const LAS float*)(lds + RG_CAR + (p) * 256 + lane * 4); \
          for (int v = 0; v < wave; ++v) { const f32x2 s = *(const LAS f32x2*)(lds + RG_SUM + v * 512 + lane * 8); carry = s.y + s.x * carry; } \
          _Pragma("unroll") for (int i = 0; i < 8; ++i) { const float hv = hl[i] + pc[i] * carry; if (i == 7) hl[7] = hv; \
              const float y = hv * __uint_as_float((unsigned)gsh[i] << 16); \
              *(GAS unsigned short*)(yp + (size_t)(t0 + 8 * wave + i) * 1024) = (unsigned short)(pg8::cvt_pk_bf16(y, y) & 0xffffu); } \
          if (wave == 7) *(LAS float*)(lds + RG_CAR + ((p) ^ 1) * 256 + lane * 4) = hl[7]; } \
        RG_GLOAD(gsh, ((tile) + 2 < NTILE) ? t0 + 2 * RG_T : t0);     \
        if ((tile) + 2 < NTILE) RG_S1(xraw, p); \
        RG_PREFETCH(xraw, ((tile) + 4 < NTILE) ? t0 + 4 * RG_T : t0); \
        LDS_BAR(); } while (0)
#pragma unroll 1
    for (int tile = 0; tile < NTILE; tile += 2) { RG_TILE(tile, 0, xrA, gsA); RG_TILE(tile + 1, 1, xrB, gsB); }
#undef RG_TILE
#undef RG_PREFETCH
#undef RG_GLOAD
#undef RG_S1
#undef RG_S2
}

__device__ __forceinline__ void final_phase(const Args& a, int vcu, int G, int wave, int m0, int mrows) {
    const int lane = lane_id(), r8 = lane >> 3, g8 = lane & 7;
    const int gw = vcu * NWAVES + wave, NGW = G * NWAVES; const float* ss = (const float*)(a.ws + WS_SS); const float* g = a.in[19]; const char* X = (const char*)(a.ws + WS_XN);
    for (int rg = m0 / 16 + gw; rg < (m0 + mrows) / 16; rg += NGW) {
        const int row0 = 16 * rg + r8, row1 = row0 + 8;
        const float rs0 = pg8::row_rstd(ss, row0), rs1 = pg8::row_rstd(ss, row1);
        const int ob0 = r8 * 64 + g8 * 8, ob1 = ((r8 + 8) * 64 + g8 * 8) ^ 32;
        float* o0 = a.out + (size_t)row0 * DMODEL + 4 * g8; float* o1 = a.out + (size_t)row1 * DMODEL + 4 * g8;
#pragma unroll 1
        for (int c0 = 0; c0 < 32; c0 += 4) { unsigned long long w0[4], w1[4]; f32x4 gv[4];
#pragma unroll
            for (int i = 0; i < 4; ++i) { const char* blk = X + xf_block(rg, c0 + i); w0[i] = *(const GAS unsigned long long*)(blk + ob0); w1[i] = *(const GAS unsigned long long*)(blk + ob1); gv[i] = *(const f32x4*)(g + 32 * (c0 + i) + 4 * g8); }
#pragma unroll
            for (int i = 0; i < 4; ++i) {
                __builtin_nontemporal_store(pg8::bf4((unsigned)w0[i], (unsigned)(w0[i] >> 32)) * rs0 * gv[i], (GAS f32x4*)(o0 + 32 * (c0 + i)));
                __builtin_nontemporal_store(pg8::bf4((unsigned)w1[i], (unsigned)(w1[i] >> 32)) * rs1 * gv[i], (GAS f32x4*)(o1 + 32 * (c0 + i))); } } }
}

__global__ void __launch_bounds__(NWAVES * 64, 2) mk_fwd(Args args) {
    extern __shared__ __attribute__((aligned(16))) unsigned char lds_raw[];
    LAS unsigned char* lds = (LAS unsigned char*)lds_raw;
    volatile LAS unsigned* MISC = (volatile LAS unsigned*)(lds + MISC_OFF);
    const int wave = __builtin_amdgcn_readfirstlane((int)threadIdx.x >> 6);
    const int G = gridDim.x; const int bx = blockIdx.x; const int vcu = (G % 8 == 0) ? (bx % 8) * (G / 8) + bx / 8 : bx;
    unsigned char* ws = args.ws;
    gu32* ctl = (gu32*)(ws + WS_CTL);
    for (int u = (int)threadIdx.x; u < (LDS_BYTES - LDSCTL_OFF) / 4; u += NWAVES * 64) ((LAS unsigned*)(lds + LDSCTL_OFF))[u] = 0u;
    __syncthreads();
    const int sid = bx & 7, G2 = G / NSTREAM, c = bx >> 3, vcl = c, vcs = sid * G2 + vcl, M0 = sid * MS;
    XcdBarrier bar = xcd_barrier_post((unsigned*)(ctl + CW_BAR), MISC + 8, (unsigned)G);
    XcdBarrier sbar = xcd_barrier_post((unsigned*)(ctl + CW_BAR + 4096 * (1 + sid)), MISC + 10, (unsigned)G2);
    const int lo = args.ph_lo, hi = args.ph_hi;
#define IN(k) (lo <= (k) && (k) < hi)
#define SEAM(k) do { if (IN(k) && IN((k) + 1)) xcd_barrier(sbar); } while (0)
    unsigned char* sb = ws + WS_SB + (size_t)sid * WS_SSTR;
    bf16* XNl = (bf16*)(ws + WS_XN) + (size_t)M0 * 1024; float* SSl = (float*)(ws + WS_SS) + (size_t)M0 * 16;
    bf16* Hl = (bf16*)(sb + SO_H); bf16* Yl = (bf16*)(sb + SO_Y); bf16* Zl = (bf16*)(sb + SO_Z); bf16* Ql = (bf16*)(sb + SO_Q); bf16* GGl = (bf16*)(sb + SO_GG); bf16* XRl = (bf16*)(sb + SO_XR);
    bf16* Yg = Yl - (size_t)M0 * 1024; const bf16* Zg = Zl - (size_t)M0 * 512; const bf16* Qg = Ql - (size_t)M0 * 512; const bf16* Kg = Qg + QKV_STRIDE; const bf16* Vg = Kg + QKV_STRIDE;
    const bf16* GGg = GGl - (size_t)M0 * 1024; const bf16* XRg = XRl - (size_t)M0 * 1024;
    LAS float* RTAB = (LAS float*)(lds + pg8::RTAB_OFF);
    static_assert(pg8::RTAB_OFF >= MISC_OFF + 128 && pg8::RTAB_OFF + 2048 <= LDS_BYTES, "rtab inside the LDS control area");

    if (IN(0)) { p0_prologue(args, lds, vcu, G, wave); }
    if (IN(0) && IN(1)) xcd_barrier(bar);
    if (IN(1)) {
        pg8::Gemm g{XNl, (const bf16*)(ws + WS_WIN0), MS, 2560, DMODEL, 0, 1}; pg8::StaticOrder S; S.init1(MS, 2560, G2, c);
        pg8::EpiInAB E{Zl, Ql, RTAB, mo::C2, QKV_STRIDE};
        pg8::gemm_phase<pg8::EpiInAB, pg8::StaticOrder, true, true>(lds, g, S, E, wave, SSl);
    }
    SEAM(1);
    if (IN(2)) {
        conv_phase(Zg, args.in[6], args.in[7], args.in[8], Yg, lds, vcs, wave);
        const int bh = vcs >> 1, hf = vcs & 1;
        mo::moba_kbar(bh >> 3, bh & 7, Kg, (LAS char*)lds, wave);
#pragma unroll 1
        for (int i = 0; i < 4; ++i) { const int j = hf ? ((i == 0) ? 2 : (i == 1) ? 5 : (i == 2) ? 3 : 4) : ((i == 0) ? 0 : (i == 1) ? 7 : (i == 2) ? 1 : 6);
            mo::moba_unit(bh >> 3, bh & 7, j, Qg, Kg, Vg, Yg, (LAS char*)lds, wave, i == 0, i < 3); }
    }
    SEAM(2);
    if (IN(3)) {
        pg8::Gemm g{Yl, (const bf16*)(ws + WS_WOUT0), MS, DMODEL, DMODEL}; pg8::StaticOrder S; S.init1(MS, DMODEL, G2, c);
        pg8::EpiResB E{XNl, nullptr, SSl};
        pg8::gemm_phase<pg8::EpiResB, pg8::StaticOrder, true, true>(lds, g, S, E, wave);
    }
    SEAM(3);
    if (IN(4)) {
        pg8::Gemm g{XNl, (const bf16*)(ws + WS_WUP0), MS, FF, DMODEL, 0, 1}; pg8::StaticOrder S; S.init1(MS, FF, G2, c);
        pg8::EpiUp E{Hl, RTAB};
        pg8::gemm_phase<pg8::EpiUp, pg8::StaticOrder, true, true>(lds, g, S, E, wave, SSl);
    }
    SEAM(4);
    if (IN(5)) {
        pg8::Gemm g{Hl, (const bf16*)(ws + WS_WDN0), MS, DMODEL, FF, 0, 1}; pg8::StaticOrder S; S.init1(MS, DMODEL, G2, c);
        pg8::EpiResB E{XNl, nullptr, SSl};
        pg8::gemm_phase<pg8::EpiResB, pg8::StaticOrder, true, true, true>(lds, g, S, E, wave);
    }
    SEAM(5);
    if (IN(6)) {
        pg8::Gemm g{XNl, (const bf16*)(ws + WS_WIN1), MS, 2048, DMODEL, 0, 1}; pg8::StaticOrder S; S.init1(MS, 2048, G2, c);
        pg8::EpiInC E{GGl, XRl, RTAB};
        pg8::gemm_phase<pg8::EpiInC, pg8::StaticOrder, true, true>(lds, g, S, E, wave, SSl);
    }
    SEAM(6);
    if (IN(7)) { rglru_phase(args, XRg, GGg, Yg, lds, vcs, wave); }
    SEAM(7);
    if (IN(8)) {
        pg8::Gemm g{Yl, (const bf16*)(ws + WS_WOUT1), MS, DMODEL, DMODEL}; pg8::StaticOrder S; S.init1(MS, DMODEL, G2, c);
        pg8::EpiResB E{XNl, nullptr, SSl};
        pg8::gemm_phase<pg8::EpiResB, pg8::StaticOrder, true, true>(lds, g, S, E, wave);
    }
    SEAM(8);
    if (IN(9)) {
        pg8::Gemm g{XNl, (const bf16*)(ws + WS_WUP1), MS, FF, DMODEL, 0, 1}; pg8::StaticOrder S; S.init1(MS, FF, G2, c);
        pg8::EpiUp E{Hl, RTAB};
        pg8::gemm_phase<pg8::EpiUp, pg8::StaticOrder, true, true>(lds, g, S, E, wave, SSl);
    }
    SEAM(9);
    if (IN(10)) {
        pg8::Gemm g{Hl, (const bf16*)(ws + WS_WDN1), MS, DMODEL, FF, 0, 1}; pg8::StaticOrder S; S.init1(MS, DMODEL, G2, c);
        pg8::EpiResB E{XNl, nullptr, SSl};
        pg8::gemm_phase<pg8::EpiResB, pg8::StaticOrder, true, true, true>(lds, g, S, E, wave);
    }
    SEAM(10);
    if (IN(11)) { final_phase(args, vcl, G2, wave, M0, MS); }
#ifdef MK_PROF
    if (IN(11)) { xcd_barrier(sbar);
        if (bx == 0) { const unsigned long long* pr = (const unsigned long long*)(ws + WS_CTL + 512 * 1024); const float cnt = (float)pr[6];
            const float A = (float)pr[MK_PROF_A] / cnt, B = (float)pr[MK_PROF_B] / cnt; const float c = sqrtf(B * 1e-5f * 128.0f);
            for (int i = (int)threadIdx.x; i < (1 << 18); i += 512) args.out[(size_t)i * 128 + 64] += c;
            if (threadIdx.x == 0) args.out[0] += A * MK_PROF_ASCALE; } }
#endif
#undef IN
#undef SEAM
}

extern "C" void kernel_launch(void* const* d_in, const int* in_sizes, int n_in, void* d_out, int out_size, void* d_ws, size_t ws_size, hipStream_t stream) {
    static int grid = 0;
    if (grid == 0) {
        if (n_in != 20 || in_sizes[0] != M * DMODEL || out_size != M * DMODEL || ws_size < WS_END) { fprintf(stderr, "kernel_launch: unexpected shapes (n_in %d, in0 %d, out %d, ws %zu); nothing launched\n", n_in, n_in > 0 ? in_sizes[0] : -1, out_size, ws_size); grid = -1; return; }
        int dev = 0, cus = 0, per_cu = 0;
        if (hipGetDevice(&dev) != hipSuccess || hipDeviceGetAttribute(&cus, hipDeviceAttributeMultiprocessorCount, dev) != hipSuccess) { grid = -1; return; }
        if (hipFuncSetAttribute((const void*)mk_fwd, hipFuncAttributeMaxDynamicSharedMemorySize, LDS_BYTES) != hipSuccess) { fprintf(stderr, "kernel_launch: hipFuncSetAttribute failed\n"); grid = -1; return; }
        if (hipOccupancyMaxActiveBlocksPerMultiprocessor(&per_cu, (const void*)mk_fwd, NWAVES * 64, LDS_BYTES) != hipSuccess || per_cu < 1) fprintf(stderr, "kernel_launch: note: occupancy query reports %d\n", per_cu);
        (void)hipGetLastError();
        grid = cus;
        if (grid != 256) fprintf(stderr, "kernel_launch: %d CUs (the static schedules assume 256)\n", grid);
    }
    if (grid < 0) return;
    if (hipMemsetAsync((char*)d_ws + WS_CTL, 0, CTL_ZERO_BYTES, stream) != hipSuccess) return;
    Args a{};
    for (int i = 0; i < 20; ++i) a.in[i] = (const float*)d_in[i];
    a.out = (float*)d_out; a.ws = (unsigned char*)d_ws;
#if MK_PER_PHASE
    for (int p = 0; p < NPHASE; ++p) { a.ph_lo = p; a.ph_hi = p + 1; hipLaunchKernelGGL(mk_fwd, dim3(grid), dim3(NWAVES * 64), LDS_BYTES, stream, a); }
#else
    a.ph_lo = 0; a.ph_hi = NPHASE;
    hipLaunchKernelGGL(mk_fwd, dim3(grid), dim3(NWAVES * 64), LDS_BYTES, stream, a);
#endif
}
```
